# Optimizing an MI355X kernel written in HIP

```python
import jax, jax.numpy as jnp
from jax import lax
import numpy as np

D_MODEL = 1024
BATCH = 8
SEQ = 4096
DEPTH = 1
DEC_BATCH = 8
DEC_SEQ = 32
PAST_LEN = 4096

CHUNK = 64
EPS = 1e-6
GLA_HEADS = 4
GLA_DK = 128
GLA_DV = 256
GLA_RANK = 16
GLA_TAU = 16.0
SWA_HEADS = 16
SWA_KV_HEADS = 2
SWA_HD = 64
SWA_GROUP = SWA_HEADS // SWA_KV_HEADS
WINDOW = 128
WIN_CHUNKS = WINDOW // CHUNK
D_FF = 2816

GLA_QK_W = GLA_HEADS * GLA_DK
GLA_V_W = GLA_HEADS * GLA_DV
SWA_Q_W = SWA_HEADS * SWA_HD
SWA_KV_W = SWA_KV_HEADS * SWA_HD
SPLITS = (GLA_QK_W, GLA_QK_W, GLA_V_W, GLA_V_W, GLA_RANK,
          SWA_Q_W, SWA_KV_W, SWA_KV_W, D_MODEL, D_MODEL)
IN_W = sum(SPLITS)

kernel_name = "hybrid_gla_swa_macaron_stream_step"


def rmsnorm(x, g):
    xf = x.astype(jnp.float32)
    y = xf * lax.rsqrt(jnp.mean(xf * xf, axis=-1, keepdims=True) + EPS)
    return (y * g.astype(jnp.float32)).astype(x.dtype)


def half_swiglu(x, norm_g, w_in, w_out):
    h = rmsnorm(x, norm_g)
    gate, up = jnp.split(h @ w_in, 2, axis=-1)
    return x + 0.5 * ((jax.nn.silu(gate) * up) @ w_out)


def in_projection(h, w_in):
    idx, off = [], 0
    for s in SPLITS[:-1]:
        off += s
        idx.append(off)
    return jnp.split(h @ w_in, idx, axis=-1)


def gla_features(q, k, v, glr, w_gate_up, b_gate):
    B, T, _ = q.shape
    def heads(a, d):
        return a.reshape(B, T, GLA_HEADS, d).transpose(0, 2, 1, 3)
    q = heads(q, GLA_DK) * (GLA_DK ** -0.5)
    k = heads(k, GLA_DK)
    v = heads(v, GLA_DV)
    logit = (glr @ w_gate_up + b_gate).astype(jnp.float32)
    log_alpha = heads(jax.nn.log_sigmoid(logit) / GLA_TAU, GLA_DK)
    return q, k, v, log_alpha


def gla_block(S, q, k, v, la):
    q, k, v = (a.astype(jnp.float32) for a in (q, k, v))
    L = q.shape[2]
    b = jnp.cumsum(la, axis=2)
    causal = jnp.arange(L)[:, None] >= jnp.arange(L)[None, :]
    diff = b[:, :, :, None, :] - b[:, :, None, :, :]
    decay = jnp.exp(jnp.where(causal[None, None, :, :, None], diff, -jnp.inf))
    A = jnp.einsum('bhtd,bhsd,bhtsd->bhts', q, k, decay)
    o = A @ v + jnp.einsum('bhtd,bhde->bhte', q * jnp.exp(b), S)
    bL = b[:, :, -1:, :]
    S_new = jnp.exp(bL[:, :, 0, :])[..., None] * S + \
        jnp.einsum('bhsd,bhse->bhde', k * jnp.exp(bL - b), v)
    return S_new, o


def gla_prompt(q, k, v, la):
    B, H, S, _ = q.shape
    nc = S // CHUNK
    def blocks(a):
        return a.reshape(B, H, nc, CHUNK, a.shape[-1]).transpose(2, 0, 1, 3, 4)
    S0 = jnp.zeros((B, H, GLA_DK, GLA_DV), jnp.float32)
    S_fin, o = lax.scan(lambda s, c: gla_block(s, *c), S0,
                        (blocks(q), blocks(k), blocks(v), blocks(la)))
    o = o.transpose(1, 2, 0, 3, 4).reshape(B, H, S, GLA_DV)
    return o, S_fin


def sink_softmax(s, sinks):
    sk = sinks.astype(jnp.float32).reshape(SWA_KV_HEADS, SWA_GROUP)[:, :, None, None]
    m = jnp.maximum(jnp.max(s, axis=-1, keepdims=True), sk)
    p = jnp.exp(s - m)
    return p / (jnp.sum(p, axis=-1, keepdims=True) + jnp.exp(sk - m))


def swa_prompt(q, k, v, sinks):
    B, S, _ = q.shape
    nc = S // CHUNK
    nk = (WIN_CHUNKS + 1) * CHUNK
    pad = WIN_CHUNKS * CHUNK
    q = q.reshape(B, nc, CHUNK, SWA_KV_HEADS, SWA_GROUP, SWA_HD)
    k = k.reshape(B, S, SWA_KV_HEADS, SWA_HD)
    v = v.reshape(B, S, SWA_KV_HEADS, SWA_HD)
    def band(a):
        ap = jnp.pad(a, ((0, 0), (pad, 0), (0, 0), (0, 0)))
        ap = ap.reshape(B, nc + WIN_CHUNKS, CHUNK, SWA_KV_HEADS, SWA_HD)
        return jnp.concatenate([ap[:, i:i + nc] for i in range(WIN_CHUNKS + 1)], axis=2)
    kb, vb = band(k), band(v)
    key_pos = (jnp.arange(nc) * CHUNK)[:, None] - pad + jnp.arange(nk)[None, :]
    valid = key_pos >= 0
    s = jnp.einsum('bcqkgd,bcjkd->bckgqj', q, kb).astype(jnp.float32) * (SWA_HD ** -0.5)
    s = jnp.where(valid[None, :, None, None, None, :], s, -jnp.inf)
    p = sink_softmax(s, sinks)
    o = jnp.einsum('bckgqj,bcjkd->bcqkgd', p.astype(vb.dtype), vb).reshape(B, S, SWA_Q_W)
    return o, k[:, -WINDOW:], v[:, -WINDOW:]


def swa_sample(q, k, v, sinks, cache_k, cache_v):
    B, T, _ = q.shape
    q = q.reshape(B, T, SWA_KV_HEADS, SWA_GROUP, SWA_HD)
    k_all = jnp.concatenate([cache_k.astype(k.dtype), k.reshape(B, T, SWA_KV_HEADS, SWA_HD)], axis=1)
    v_all = jnp.concatenate([cache_v.astype(v.dtype), v.reshape(B, T, SWA_KV_HEADS, SWA_HD)], axis=1)
    s = jnp.einsum('bqkgd,bjkd->bkgqj', q, k_all).astype(jnp.float32) * (SWA_HD ** -0.5)
    p = sink_softmax(s, sinks)
    o = jnp.einsum('bkgqj,bjkd->bqkgd', p.astype(v_all.dtype), v_all).reshape(B, T, SWA_Q_W)
    n = cache_k.shape[1]
    return o, k_all[:, -n:], v_all[:, -n:]


def token_mixing(x, norm_g, w_in, w_gate_up, b_gate, gla_norm_g, sinks,
                 w_br_gla, w_br_swa, w_out, state_gla=None, cache_k=None, cache_v=None):
    B, T, _ = x.shape
    h = rmsnorm(x, norm_g)
    gq, gk, gv, gr, glr, sq, sk, sv, gate_gla, gate_swa = in_projection(h, w_in)
    q, k, v, la = gla_features(gq, gk, gv, glr, w_gate_up, b_gate)
    if state_gla is None:
        o_gla, s_gla = gla_prompt(q, k, v, la)
    else:
        s_gla, o_gla = gla_block(state_gla.astype(jnp.float32), q, k, v, la)
    o_gla = rmsnorm(o_gla, gla_norm_g).astype(h.dtype)
    o_gla = o_gla.transpose(0, 2, 1, 3).reshape(B, T, GLA_V_W) * jax.nn.silu(gr)
    if cache_k is None:
        o_swa, k_keep, v_keep = swa_prompt(sq, sk, sv, sinks)
    else:
        o_swa, k_keep, v_keep = swa_sample(sq, sk, sv, sinks, cache_k, cache_v)
    merged = jax.nn.sigmoid(gate_gla) * (o_gla @ w_br_gla) + jax.nn.sigmoid(gate_swa) * (o_swa @ w_br_swa)
    return x + merged @ w_out, s_gla, k_keep, v_keep


def macaron_layer(x, ffn1, mix, ffn2, state_gla=None, cache_k=None, cache_v=None):
    x = half_swiglu(x, *ffn1)
    x, s_gla, k_keep, v_keep = token_mixing(x, *mix, state_gla=state_gla, cache_k=cache_k, cache_v=cache_v)
    x = half_swiglu(x, *ffn2)
    return x, s_gla, k_keep, v_keep


def setup_inputs(seed: int = 0) -> dict:
    key = jax.random.key(seed)
    ks = jax.random.split(key, 24)
    f32 = jnp.float32
    def nrm(k, shape, scale):
        return jax.random.normal(k, shape, f32) * scale
    L = DEPTH
    return {
        "x_prompt": nrm(ks[0], (BATCH, SEQ, D_MODEL), 1.0),
        "x_sample": nrm(ks[1], (DEC_BATCH, DEC_SEQ, D_MODEL), 1.0),
        "state_gla": nrm(ks[2], (L, DEC_BATCH, GLA_HEADS, GLA_DK, GLA_DV), 1.0),
        "cache_swa_k": nrm(ks[3], (L, DEC_BATCH, WINDOW, SWA_KV_HEADS, SWA_HD), 1.0),
        "cache_swa_v": nrm(ks[4], (L, DEC_BATCH, WINDOW, SWA_KV_HEADS, SWA_HD), 1.0),
        "norm_ffn1": 1.0 + nrm(ks[5], (L, D_MODEL), 0.02),
        "w_ffn1_in": nrm(ks[6], (L, D_MODEL, 2 * D_FF), D_MODEL ** -0.5),
        "w_ffn1_out": nrm(ks[7], (L, D_FF, D_MODEL), D_FF ** -0.5),
        "norm_mix": 1.0 + nrm(ks[8], (L, D_MODEL), 0.02),
        "w_in": nrm(ks[9], (L, D_MODEL, IN_W), D_MODEL ** -0.5),
        "w_gla_gate_up": nrm(ks[10], (L, GLA_RANK, GLA_QK_W), GLA_RANK ** -0.5),
        "b_gla_gate": nrm(ks[11], (L, GLA_QK_W), 0.1),
        "gla_norm": 1.0 + nrm(ks[12], (L, GLA_DV), 0.02),
        "swa_sinks": nrm(ks[13], (L, SWA_HEADS), 0.5),
        "w_branch_gla": nrm(ks[14], (L, GLA_V_W, D_MODEL), GLA_V_W ** -0.5),
        "w_branch_swa": nrm(ks[15], (L, SWA_Q_W, D_MODEL), SWA_Q_W ** -0.5),
        "w_out": nrm(ks[16], (L, D_MODEL, D_MODEL), D_MODEL ** -0.5),
        "norm_ffn2": 1.0 + nrm(ks[17], (L, D_MODEL), 0.02),
        "w_ffn2_in": nrm(ks[18], (L, D_MODEL, 2 * D_FF), D_MODEL ** -0.5),
        "w_ffn2_out": nrm(ks[19], (L, D_FF, D_MODEL), D_FF ** -0.5),
        "norm_final": 1.0 + nrm(ks[20], (D_MODEL,), 0.02),
    }


def reference(x_prompt, x_sample, state_gla, cache_swa_k, cache_swa_v,
              norm_ffn1, w_ffn1_in, w_ffn1_out, norm_mix, w_in, w_gla_gate_up, b_gla_gate,
              gla_norm, swa_sinks, w_branch_gla, w_branch_swa, w_out,
              norm_ffn2, w_ffn2_in, w_ffn2_out, norm_final):
    yp, ys = x_prompt, x_sample
    sg_p, sk_p, sv_p, sg_s, sk_s, sv_s = [], [], [], [], [], []
    for l in range(DEPTH):
        ffn1 = (norm_ffn1[l], w_ffn1_in[l], w_ffn1_out[l])
        mix = (norm_mix[l], w_in[l], w_gla_gate_up[l], b_gla_gate[l], gla_norm[l], swa_sinks[l],
               w_branch_gla[l], w_branch_swa[l], w_out[l])
        ffn2 = (norm_ffn2[l], w_ffn2_in[l], w_ffn2_out[l])
        yp, g_p, k_p, v_p = macaron_layer(yp, ffn1, mix, ffn2)
        ys, g_s, k_s, v_s = macaron_layer(ys, ffn1, mix, ffn2, state_gla[l], cache_swa_k[l], cache_swa_v[l])
        sg_p.append(g_p); sk_p.append(k_p); sv_p.append(v_p)
        sg_s.append(g_s); sk_s.append(k_s); sv_s.append(v_s)
    y_prompt = rmsnorm(yp, norm_final)
    y_sample = rmsnorm(ys, norm_final)
    return (y_prompt, y_sample,
            jnp.stack(sg_p), jnp.stack(sk_p), jnp.stack(sv_p),
            jnp.stack(sg_s), jnp.stack(sk_s), jnp.stack(sv_s))
```

```cpp
#include <hip/hip_runtime.h>
#include <hip/hip_cooperative_groups.h>
#include <cstdio>
#include <cstdint>
namespace cg = cooperative_groups;


constexpr int D = 1024, NB = 8, SEQ = 4096, DEC_T = 32;
constexpr int MP = NB * SEQ, MS = NB * DEC_T, M = MP + MS;
constexpr int FF = 2816;
constexpr int GH = 4, GDK = 128, GDV = 256, GRANK = 16;
constexpr int SH = 16, SKV = 2, SHD = 64, WINDOW = 128;
constexpr float EPS = 1e-6f;
constexpr float LOG2E = 1.4426950408889634f;
constexpr int NA = 18 * 256;
constexpr int NBP = 8 * 256;
constexpr int S_GQ = 0, S_GK = 512, S_GV = 1024, S_GR = 2048, S_GLR = 3072, S_SQ = 3088, S_SK = 4112, S_SV = 4240, S_GG = 4368, S_GS = 5392, IN_W = 6416;

constexpr size_t O_Y = 0;
constexpr size_t O_SGP = (size_t)M * D;
constexpr size_t O_CKP = O_SGP + (size_t)NB * GH * GDK * GDV;
constexpr size_t O_CVP = O_CKP + (size_t)NB * WINDOW * SKV * SHD;
constexpr size_t O_SGS = O_CVP + (size_t)NB * WINDOW * SKV * SHD;
constexpr size_t O_CKS = O_SGS + (size_t)NB * GH * GDK * GDV;
constexpr size_t O_CVS = O_CKS + (size_t)NB * WINDOW * SKV * SHD;
constexpr size_t O_END = O_CVS + (size_t)NB * WINDOW * SKV * SHD;

constexpr size_t MiB = 1u << 20;
constexpr size_t R1 = (size_t)M * D * 2;
constexpr size_t WS_CTL = 0;
constexpr size_t WS_W1T = 1 * MiB;
constexpr size_t WS_W1OT = WS_W1T + (size_t)2 * FF * D * 2;
constexpr size_t WS_WAT = WS_W1OT + (size_t)D * FF * 2;
constexpr size_t WS_WBT = WS_WAT + (size_t)NA * D * 2;
constexpr size_t WS_WBRT = WS_WBT + (size_t)NBP * D * 2;
constexpr size_t WS_WOUTT = WS_WBRT + (size_t)D * 2 * D * 2;
constexpr size_t WS_W2T = WS_WOUTT + (size_t)D * D * 2;
constexpr size_t WS_W2OT = WS_W2T + (size_t)2 * FF * D * 2;
constexpr size_t WS_SSQ0 = WS_W2OT + (size_t)D * FF * 2;
constexpr size_t SSQ_BYTES = (size_t)M * 16 * 4;
constexpr size_t WS_SSQA = WS_SSQ0 + SSQ_BYTES;
constexpr size_t WS_SSQB = WS_SSQA + SSQ_BYTES;
constexpr int NUNIT_G = NB * 64 * GH + NB * GH;
constexpr size_t SSQS_BYTES = (size_t)MS * 64 * 4;
constexpr size_t WS_SSQ0S = WS_SSQB + SSQ_BYTES, WS_SSQAS = WS_SSQ0S + SSQS_BYTES, WS_SSQBS = WS_SSQAS + SSQS_BYTES;
constexpr size_t WS_GDEC = WS_SSQBS + SSQS_BYTES;
constexpr size_t WS_XB = (WS_GDEC + (size_t)NUNIT_G * 128 * 4 + 4095) & ~(size_t)4095;
constexpr size_t WS_T0 = WS_XB + R1;
constexpr size_t WS_T1 = WS_T0 + R1;
constexpr size_t WS_T2 = WS_T1 + R1;
constexpr size_t WS_T7 = WS_T2 + R1;
constexpr size_t WS_T8 = WS_T7 + R1;
constexpr size_t WS_SKV = WS_T8 + R1;
constexpr size_t WS_ABUF = WS_SKV + (size_t)M * 256 * 2;
constexpr size_t WS_GLR = WS_ABUF + (size_t)M * 256 * 2;
constexpr size_t WS_XSLOT = (WS_GLR + (size_t)M * 16 * 4 + 4095) & ~(size_t)4095;
constexpr size_t WS_END = WS_XSLOT + (size_t)(MP / 256) * 256 * 4 * 4;
constexpr int CW_PAN = 13312, CW_PAN_STRIDE = 16, CW_G3 = 8192;
constexpr size_t WS_ACT = WS_T0;
static_assert((size_t)M * FF * 2 <= 5 * R1, "act overlay");
static_assert(WS_END <= 512 * MiB, "workspace map must fit 512 MiB");

constexpr int RING_BYTES = 131072;
constexpr int PHASE_LDS = 155648;
constexpr int MISC_OFF = PHASE_LDS + 320;
constexpr int LDS_BYTES = 159744;
constexpr int NWAVES = 8;

#define GAS __attribute__((address_space(1)))
#define LAS __attribute__((address_space(3)))
typedef unsigned short bf16;
typedef unsigned v4u __attribute__((ext_vector_type(4)));
typedef unsigned v2u __attribute__((ext_vector_type(2)));
typedef float f32x4 __attribute__((ext_vector_type(4)));
typedef float f32x16 __attribute__((ext_vector_type(16)));
typedef short bf16x8 __attribute__((ext_vector_type(8)));
typedef float f32x2_t __attribute__((ext_vector_type(2)));
typedef __bf16 bf16x2_t __attribute__((ext_vector_type(2)));
#define LDS_WAIT() asm volatile("s_waitcnt lgkmcnt(0)" ::: "memory")
#define VM_WAIT() asm volatile("s_waitcnt vmcnt(0)" ::: "memory")
#define LDS_BAR() do { asm volatile("s_waitcnt lgkmcnt(0)" ::: "memory"); __builtin_amdgcn_s_barrier(); asm volatile("" ::: "memory"); } while (0)
__device__ __forceinline__ unsigned pk2(float lo, float hi) { f32x2_t v = {lo, hi}; bf16x2_t b = __builtin_convertvector(v, bf16x2_t); return __builtin_bit_cast(unsigned, b); }
__device__ __forceinline__ unsigned short f2bf(float f) { return (unsigned short)(pk2(f, 0.f) & 0xffffu); }
__device__ __forceinline__ float bf2f(unsigned short b) { return __uint_as_float((unsigned)b << 16); }
__device__ __forceinline__ float bflo(unsigned w) { return __uint_as_float(w << 16); }
__device__ __forceinline__ float bfhi(unsigned w) { return __uint_as_float(w & 0xffff0000u); }
__device__ __forceinline__ float fast_exp2(float x) { return __builtin_amdgcn_exp2f(x); }
__device__ __forceinline__ float fast_exp(float x) { return __builtin_amdgcn_exp2f(x * LOG2E); }
__device__ __forceinline__ float fast_rcp(float x) { return __builtin_amdgcn_rcpf(x); }
__device__ __forceinline__ float sigmoidf_(float x) { return fast_rcp(1.0f + fast_exp(-x)); }
__device__ __forceinline__ float siluf_(float x) { return x * sigmoidf_(x); }
__device__ __forceinline__ float wave_sum(float v) {
#pragma unroll
    for (int o = 1; o < 64; o <<= 1) v += __shfl_xor(v, o);
    return v;
}
__device__ __forceinline__ void rows_rstd(float (&rs)[2][4], const float* ssqp, int row0, int fq) {
    f32x4 q[2][4];
#pragma unroll
    for (int ai = 0; ai < 2; ++ai)
#pragma unroll
        for (int m = 0; m < 4; ++m) q[ai][m] = *(const f32x4*)(ssqp + (size_t)(row0 + ai * 128 + m * 16) * 16 + fq * 4);
#pragma unroll
    for (int ai = 0; ai < 2; ++ai)
#pragma unroll
        for (int m = 0; m < 4; ++m) { float s = (q[ai][m].x + q[ai][m].y) + (q[ai][m].z + q[ai][m].w); s += __shfl_xor(s, 16); s += __shfl_xor(s, 32); rs[ai][m] = __builtin_amdgcn_rsqf(s * (1.0f / D) + EPS); }
}
__device__ __forceinline__ float row_rstd(const float* ssqp, int row) {
    const f32x4* p = (const f32x4*)(ssqp + (size_t)row * 16);
    const f32x4 a = p[0], b = p[1], c = p[2], d = p[3];
    const float s = ((a.x + a.y) + (a.z + a.w)) + ((b.x + b.y) + (b.z + b.w)) + ((c.x + c.y) + (c.z + c.w)) + ((d.x + d.y) + (d.z + d.w));
    return __builtin_amdgcn_rsqf(s * (1.0f / D) + EPS);
}

namespace pg8 {
#define PG8_LAS __attribute__((address_space(3)))
typedef unsigned short bf16_t;
typedef unsigned u32x4 __attribute__((ext_vector_type(4)));
constexpr int BM = 256, BK = 64, HALF = 128, HTB = HALF * BK * 2, STAGE_BYTES = 8 * HTB, NXCD = 8, WGM = 8;
__host__ __device__ __forceinline__ int lds_byte(int r, int c) { const int st = (r >> 4) * 2 + (c >> 5), rr = r & 15, cc = c & 31, ob = rr * 64 + cc * 2; return st * 1024 + (ob ^ (((ob >> 9) & 1) << 5)); }
__host__ __device__ __forceinline__ void stage_rc(int b, int& R, int& C) { const int st = b / 1024, sb = b % 1024, swz = sb ^ (((sb >> 9) & 1) << 5); R = (st >> 1) * 16 + swz / 64; C = (st & 1) * 32 + (swz % 64) / 2; }
__host__ __device__ __forceinline__ int perm32(int rho) { const int n = rho >> 4, i = rho & 15; return 8 * (i >> 2) + 4 * n + (i & 3); }

struct Unit { int pm, pn, sub; };
struct Gemm { const bf16_t* A0; const bf16_t* A1; const bf16_t* Bt; int lda, ldb, K, nsub; };

struct StaticOrder {
    int nM, nN, nwg, G, c, nsub;
    __device__ void init(int nM_, int nN_, int nsub_, int G_, int c_) { nM = nM_; nN = nN_; nwg = nM * nN; G = G_; c = c_; nsub = nsub_; }
    __device__ bool next(int i, Unit& u) const {
        const int ti = i / nsub; u.sub = i - ti * nsub;
        const long L = (long)ti * G + c; if (L >= nwg) return false;
        int wgid = (int)L; { const int q = nwg / NXCD, r = nwg % NXCD, xcd = wgid % NXCD, off = wgid / NXCD; wgid = (xcd < r ? xcd * (q + 1) : r * (q + 1) + (xcd - r) * q) + off; }
        const int nig = WGM * nN, gid = wgid / nig, fm = gid * WGM, gsz = (nM - fm) < WGM ? (nM - fm) : WGM;
        u.pm = fm + ((wgid % nig) % gsz); u.pn = (wgid % nig) / gsz; return true;
    }
};

typedef f32x4 Acc[2][2][4][2];

struct EpiSwiglu {
    static constexpr bool PERM = true, FUSED = false;
    bf16_t* O; const float* ssqp;
    __device__ __forceinline__ bool keep(const Unit&) const { return false; }
    __device__ __forceinline__ void operator()(Acc& acc, const Unit& u, int wr, int wc, int fr, int fq) const {
        const int row0 = u.pm * BM + wr * 64 + fr, col0 = u.pn * HALF + wc * 32 + 8 * fq;
        float rsa[2][4]; rows_rstd(rsa, ssqp, row0, fq);
#pragma unroll
        for (int ai = 0; ai < 2; ++ai)
#pragma unroll
            for (int m = 0; m < 4; ++m) {
                const int row = row0 + ai * HALF + m * 16; const float rs = rsa[ai][m];
                float o[8];
#pragma unroll
                for (int n = 0; n < 2; ++n)
#pragma unroll
                    for (int j = 0; j < 4; ++j) { const float g = acc[ai][0][m][n][j] * rs, up = acc[ai][1][m][n][j] * rs; o[n * 4 + j] = siluf_(g) * up; }
                u32x4 w; w.x = pk2(o[0], o[1]); w.y = pk2(o[2], o[3]); w.z = pk2(o[4], o[5]); w.w = pk2(o[6], o[7]);
                *(u32x4*)(O + (size_t)row * FF + col0) = w;
            }
    }
};
template <bool RES_BF16> struct EpiResid {
    static constexpr bool PERM = true, FUSED = false;
    const float* res_f32; bf16_t* XBo; float* ssqp; float alpha;
    __device__ __forceinline__ bool keep(const Unit&) const { return false; }
    __device__ __forceinline__ void operator()(Acc& acc, const Unit& u, int wr, int wc, int fr, int fq) const {
        const int col0 = u.pn * BM + wc * 32 + 8 * fq;
#pragma unroll
        for (int ai = 0; ai < 2; ++ai)
#pragma unroll
            for (int m = 0; m < 4; ++m) {
                const int row = u.pm * BM + ai * HALF + wr * 64 + m * 16 + fr;
                float ss = 0.f;
#pragma unroll
                for (int bj = 0; bj < 2; ++bj) {
                    const size_t off = (size_t)row * D + col0 + bj * HALF;
                    f32x4 r0, r1;
                    if (RES_BF16) { const u32x4 rb = *(const u32x4*)(XBo + off); r0 = (f32x4){bflo(rb.x), bfhi(rb.x), bflo(rb.y), bfhi(rb.y)}; r1 = (f32x4){bflo(rb.z), bfhi(rb.z), bflo(rb.w), bfhi(rb.w)}; }
                    else { r0 = *(const f32x4*)(res_f32 + off); r1 = *(const f32x4*)(res_f32 + off + 4); }
                    const f32x4 v0 = r0 + acc[ai][bj][m][0] * alpha, v1 = r1 + acc[ai][bj][m][1] * alpha;
                    u32x4 w; w.x = pk2(v0[0], v0[1]); w.y = pk2(v0[2], v0[3]); w.z = pk2(v1[0], v1[1]); w.w = pk2(v1[2], v1[3]); *(u32x4*)(XBo + off) = w;
                    ss += (v0[0] * v0[0] + v0[1] * v0[1]) + (v0[2] * v0[2] + v0[3] * v0[3]) + (v1[0] * v1[0] + v1[1] * v1[1]) + (v1[2] * v1[2] + v1[3] * v1[3]);
                }
                ss += __shfl_xor(ss, 16); ss += __shfl_xor(ss, 32);
                if (ssqp && fq == 0) ssqp[(size_t)row * 16 + u.pn * 4 + wc] = ss;
                if (m & 1) asm volatile("" ::: "memory");
            }
    }
};
struct EpiProjA {
    static constexpr bool PERM = true, FUSED = false;
    bf16_t *QK, *V, *SQ, *GR, *SKVb; float* GLR; float* out; const float* ssqp;
    __device__ __forceinline__ bool keep(const Unit&) const { return false; }
    __device__ __forceinline__ void operator()(Acc& acc, const Unit& u, int wr, int wc, int fr, int fq) const {
        const int pn = u.pn;
        bf16_t* dst; int ld = D, cbase; float scale = 1.f; int mode = 0;
        if (pn < 4) { dst = QK; cbase = pn * BM; if (pn < 2) scale = 0.08838834764831845f; }
        else if (pn < 8) { dst = V; cbase = (pn - 4) * BM; }
        else if (pn < 12) { dst = SQ; cbase = (pn - 8) * BM; scale = 0.125f * LOG2E; }
        else if (pn < 16) { dst = GR; cbase = (pn - 12) * BM; mode = 1; }
        else if (pn == 16) { dst = SKVb; ld = 256; cbase = 0; mode = 2; }
        else { dst = SKVb; cbase = 0; mode = 3; }
        float rsa[2][4]; rows_rstd(rsa, ssqp, u.pm * BM + wr * 64 + fr, fq);
#pragma unroll
        for (int ai = 0; ai < 2; ++ai)
#pragma unroll
            for (int m = 0; m < 4; ++m) {
                const int row = u.pm * BM + ai * HALF + wr * 64 + m * 16 + fr; const float rs = rsa[ai][m] * scale;
#pragma unroll
                for (int bj = 0; bj < 2; ++bj) {
                    const int within = bj * HALF + wc * 32 + 8 * fq;
                    f32x4 v0 = acc[ai][bj][m][0] * rs, v1 = acc[ai][bj][m][1] * rs;
                    if (mode == 3) { if (within < GRANK) { *(f32x4*)(GLR + (size_t)row * 16 + within) = v0; *(f32x4*)(GLR + (size_t)row * 16 + within + 4) = v1; } continue; }
                    if (mode == 1) {
#pragma unroll
                        for (int j = 0; j < 4; ++j) { v0[j] = siluf_(v0[j]); v1[j] = siluf_(v1[j]); }
                    }
                    u32x4 w; w.x = pk2(v0[0], v0[1]); w.y = pk2(v0[2], v0[3]); w.z = pk2(v1[0], v1[1]); w.w = pk2(v1[2], v1[3]);
                    *(u32x4*)(dst + (size_t)row * ld + cbase + within) = w;
                    if (mode == 2) {
                        float* cp = nullptr;
                        if (u.pm >= MP / BM) { const int rs_ = row - MP, bs = rs_ >> 5, t = rs_ & 31; cp = out + (bj == 0 ? O_CKS : O_CVS) + ((size_t)(bs * WINDOW + 96 + t)) * 128 + (within & 127); }
                        else if ((u.pm & 15) == 15 && ai == 1) { const int b = row >> 12, t = row & 4095; cp = out + (bj == 0 ? O_CKP : O_CVP) + ((size_t)(b * WINDOW + (t - (SEQ - WINDOW)))) * 128 + (within & 127); }
                        if (cp) { *(f32x4*)cp = v0; *(f32x4*)(cp + 4) = v1; }
                    }
                }
            }
    }
};
struct EpiProjB {
    static constexpr bool PERM = true, FUSED = false;
    bf16_t *R, *SS; const float* ssqp;
    __device__ __forceinline__ bool keep(const Unit&) const { return false; }
    __device__ __forceinline__ void operator()(Acc& acc, const Unit& u, int wr, int wc, int fr, int fq) const {
        const int row0 = u.pm * BM + wr * 64 + fr, col0 = u.pn * HALF + wc * 32 + 8 * fq;
        float rsa[2][4]; rows_rstd(rsa, ssqp, row0, fq);
#pragma unroll
        for (int ai = 0; ai < 2; ++ai)
#pragma unroll
            for (int m = 0; m < 4; ++m) {
                const int row = row0 + ai * HALF + m * 16; const float rs = rsa[ai][m];
                float r[8], ss[8];
#pragma unroll
                for (int n = 0; n < 2; ++n)
#pragma unroll
                    for (int j = 0; j < 4; ++j) { const float eg = fast_exp(-acc[ai][0][m][n][j] * rs), es = fast_exp(-acc[ai][1][m][n][j] * rs);
                        ss[n * 4 + j] = fast_rcp(1.0f + es); r[n * 4 + j] = (1.0f + es) * fast_rcp(1.0f + eg); }
                u32x4 w; w.x = pk2(r[0], r[1]); w.y = pk2(r[2], r[3]); w.z = pk2(r[4], r[5]); w.w = pk2(r[6], r[7]);
                *(u32x4*)(R + (size_t)row * D + col0) = w;
                w.x = pk2(ss[0], ss[1]); w.y = pk2(ss[2], ss[3]); w.z = pk2(ss[4], ss[5]); w.w = pk2(ss[6], ss[7]);
                *(u32x4*)(SS + (size_t)row * D + col0) = w;
            }
    }
};
struct EpiBranch {
    static constexpr bool PERM = true, FUSED = false;
    const bf16_t *R, *SS; bf16_t* O;
    __device__ __forceinline__ bool keep(const Unit& u) const { return u.sub == 0; }
    __device__ __forceinline__ void operator()(Acc& acc, const Unit& u, int wr, int wc, int fr, int fq) const {
        const int col0 = u.pn * BM + wc * 32 + 8 * fq;
        const bf16_t* G = u.sub == 0 ? R : SS;
#pragma unroll
        for (int ai = 0; ai < 2; ++ai)
#pragma unroll
            for (int m = 0; m < 4; ++m) {
                const int row = u.pm * BM + ai * HALF + wr * 64 + m * 16 + fr;
#pragma unroll
                for (int bj = 0; bj < 2; ++bj) {
                    const size_t off = (size_t)row * D + col0 + bj * HALF;
                    const u32x4 s = *(const u32x4*)(G + off);
                    const float gv[8] = {bflo(s.x), bfhi(s.x), bflo(s.y), bfhi(s.y), bflo(s.z), bfhi(s.z), bflo(s.w), bfhi(s.w)};
                    if (u.sub == 0) {
#pragma unroll
                        for (int j = 0; j < 4; ++j) { acc[ai][bj][m][0][j] *= gv[j]; acc[ai][bj][m][1][j] *= gv[4 + j]; }
                    } else {
                        float o[8];
#pragma unroll
                        for (int j = 0; j < 4; ++j) { o[j] = acc[ai][bj][m][0][j] * gv[j]; o[4 + j] = acc[ai][bj][m][1][j] * gv[4 + j]; }
                        u32x4 w; w.x = pk2(o[0], o[1]); w.y = pk2(o[2], o[3]); w.z = pk2(o[4], o[5]); w.w = pk2(o[6], o[7]);
                        *(u32x4*)(O + off) = w;
                    }
                }
            }
    }
};
constexpr int EX_OFF = 131072;
struct EpiFinal {
    static constexpr bool PERM = true, FUSED = true;
    const bf16_t* XBr; float* Y; const float* gfin; unsigned* xslot; unsigned* cnt; float alpha;
    __device__ __forceinline__ bool keep(const Unit&) const { return false; }
    __device__ __forceinline__ void fused(Acc& acc, const Unit& u, int wr, int wc, int fr, int fq, PG8_LAS unsigned char* lds, int wid, int lane) const {
        PG8_LAS float* P = (PG8_LAS float*)(lds + EX_OFF); PG8_LAS float* Sx = (PG8_LAS float*)(lds + EX_OFF + 4096);
        const int col0 = u.pn * BM + wc * 32 + 8 * fq;
#pragma unroll
        for (int ai = 0; ai < 2; ++ai)
#pragma unroll
            for (int m = 0; m < 4; ++m) {
                const int lr = ai * HALF + wr * 64 + m * 16 + fr; const size_t grow = (size_t)(u.pm * BM + lr) * D;
                float ss = 0.f;
#pragma unroll
                for (int bj = 0; bj < 2; ++bj) {
                    const u32x4 rb = *(const u32x4*)(XBr + grow + col0 + bj * HALF);
                    const f32x4 r0 = {bflo(rb.x), bfhi(rb.x), bflo(rb.y), bfhi(rb.y)}, r1 = {bflo(rb.z), bfhi(rb.z), bflo(rb.w), bfhi(rb.w)};
                    const f32x4 v0 = r0 + acc[ai][bj][m][0] * alpha, v1 = r1 + acc[ai][bj][m][1] * alpha;
                    acc[ai][bj][m][0] = v0; acc[ai][bj][m][1] = v1;
                    ss += (v0[0] * v0[0] + v0[1] * v0[1]) + (v0[2] * v0[2] + v0[3] * v0[3]) + (v1[0] * v1[0] + v1[1] * v1[1]) + (v1[2] * v1[2] + v1[3] * v1[3]);
                }
                ss += __shfl_xor(ss, 16); ss += __shfl_xor(ss, 32);
                if (fq == 0) P[lr * 4 + wc] = ss;
                if (m & 1) asm volatile("" ::: "memory");
            }
        asm volatile("s_waitcnt lgkmcnt(0)" ::: "memory"); __builtin_amdgcn_s_barrier(); asm volatile("" ::: "memory");
        const int row = wid * 32 + (lane & 31);
        if (lane < 32) {
            const float s4 = (P[row * 4 + 0] + P[row * 4 + 1]) + (P[row * 4 + 2] + P[row * 4 + 3]);
            __hip_atomic_store(xslot + ((size_t)(u.pm * BM + row) * 4 + u.pn), __float_as_uint(s4), __ATOMIC_RELAXED, __HIP_MEMORY_SCOPE_AGENT);
        }
        asm volatile("s_waitcnt vmcnt(0)" ::: "memory");
        if (lane == 0) __hip_atomic_fetch_add(cnt + CW_PAN_STRIDE * u.pm, 1u, __ATOMIC_RELAXED, __HIP_MEMORY_SCOPE_AGENT);
        if (wid == 0) {
            unsigned spins = 0;
            while ((unsigned)__builtin_amdgcn_readfirstlane((int)__hip_atomic_load(cnt + CW_PAN_STRIDE * u.pm, __ATOMIC_RELAXED, __HIP_MEMORY_SCOPE_AGENT)) < 32u) { __builtin_amdgcn_s_sleep(2); if (++spins > (1u << 24)) break; }
            __builtin_amdgcn_fence(__ATOMIC_ACQUIRE, "agent");
        }
        asm volatile("s_waitcnt vmcnt(0) lgkmcnt(0)" ::: "memory"); __builtin_amdgcn_s_barrier(); asm volatile("" ::: "memory");
        if (lane < 32) {
            const unsigned* sl = xslot + (size_t)(u.pm * BM + row) * 4; float t = 0.f;
#pragma unroll
            for (int q = 0; q < 4; ++q) t += __uint_as_float(__hip_atomic_load(sl + q, __ATOMIC_RELAXED, __HIP_MEMORY_SCOPE_AGENT));
            Sx[row] = __builtin_amdgcn_rsqf(t * (1.0f / D) + EPS);
        }
        asm volatile("s_waitcnt lgkmcnt(0)" ::: "memory"); __builtin_amdgcn_s_barrier(); asm volatile("" ::: "memory");
        f32x4 gv[2][2];
#pragma unroll
        for (int bj = 0; bj < 2; ++bj) { gv[bj][0] = *(const f32x4*)(gfin + col0 + bj * HALF); gv[bj][1] = *(const f32x4*)(gfin + col0 + bj * HALF + 4); }
#pragma unroll
        for (int ai = 0; ai < 2; ++ai)
#pragma unroll
            for (int m = 0; m < 4; ++m) {
                const int lr = ai * HALF + wr * 64 + m * 16 + fr; const size_t grow = (size_t)(u.pm * BM + lr) * D; const float rs = Sx[lr];
#pragma unroll
                for (int bj = 0; bj < 2; ++bj) {
                    *(f32x4*)(Y + grow + col0 + bj * HALF) = acc[ai][bj][m][0] * rs * gv[bj][0];
                    *(f32x4*)(Y + grow + col0 + bj * HALF + 4) = acc[ai][bj][m][1] * rs * gv[bj][1];
                }
            }
    }
};

template <class Epi, bool ALIGN_EPI>
__device__ __forceinline__ void gemm_phase(PG8_LAS unsigned char* lds, const Gemm g, const StaticOrder& S, const Epi& E) {
    const int tid = threadIdx.x, wid = __builtin_amdgcn_readfirstlane(tid >> 6), lane = tid & 63, wr = wid >> 2, wc = wid & 3, fr = lane & 15, fq = lane >> 4;
    const int K = g.K, nt = K / BK;
    unsigned voffA[2], voffB[2];
#pragma unroll
    for (int i = 0; i < 2; ++i) { int R, C; stage_rc(tid * 16 + i * 8192, R, C); const int Rb = Epi::PERM ? ((R & ~31) + perm32(R & 31)) : R;
        voffA[i] = (unsigned)(R * g.lda + C) * 2u; voffB[i] = (unsigned)(Rb * g.ldb + C) * 2u; }
    const size_t kstep = (size_t)(BK * 2);
    const size_t hstepA = (size_t)HALF * g.lda * 2, hstepB = (size_t)HALF * g.ldb * 2;
    const size_t tstepA = 2 * hstepA, tstepB = 2 * hstepB;
    const unsigned ldsw = (unsigned)wid * 1024u;
    const int aoff = lds_byte(wr * 64 + fr, fq * 8), boff = lds_byte(wc * 32 + fr, fq * 8);
#define PG8_SA(b, h) (((b) * 2 + (h)) * HTB)
#define PG8_SB(b, h) ((4 + (b) * 2 + (h)) * HTB)
#define PG8_STAGE(bufoff, gbase, voff) do { _Pragma("unroll") for (int _i = 0; _i < 2; ++_i) \
        __builtin_amdgcn_global_load_lds((const unsigned*)((const char*)(gbase) + (voff)[_i]), (PG8_LAS unsigned*)(lds + (bufoff) + ldsw + _i * 8192), 16, 0, 0); } while (0)
#define PG8_LDA(dst, b, h) do { _Pragma("unroll") for (int m = 0; m < 4; ++m) _Pragma("unroll") for (int k = 0; k < 2; ++k) dst[m][k] = *(const PG8_LAS bf16x8*)(lds + PG8_SA(b, h) + aoff + m * 2048 + k * 1024); } while (0)
#define PG8_LDB(dst, b, h) do { _Pragma("unroll") for (int n = 0; n < 2; ++n) _Pragma("unroll") for (int k = 0; k < 2; ++k) dst[n][k] = *(const PG8_LAS bf16x8*)(lds + PG8_SB(b, h) + boff + n * 2048 + k * 1024); } while (0)
#define PG8_MMA(ai, bj, At, Bt) do { __builtin_amdgcn_s_setprio(1); _Pragma("unroll") for (int m = 0; m < 4; ++m) _Pragma("unroll") for (int n = 0; n < 2; ++n) _Pragma("unroll") for (int k = 0; k < 2; ++k) \
        acc[ai][bj][m][n] = __builtin_amdgcn_mfma_f32_16x16x32_bf16(Bt[n][k], At[m][k], acc[ai][bj][m][n], 0, 0, 0); __builtin_amdgcn_s_setprio(0); } while (0)
#define PG8_WAIT_V(n) asm volatile("s_waitcnt vmcnt(" #n ")" ::: "memory")
#define PG8_WAIT_L(n) asm volatile("s_waitcnt lgkmcnt(" #n ")" ::: "memory")
#define PG8_BAR __builtin_amdgcn_s_barrier()
#define PG8_SCHED __builtin_amdgcn_sched_barrier(0)
#define PG8_ABASE(u) ((const char*)((u).sub ? g.A1 : g.A0) + (size_t)(u).pm * tstepA)
#define PG8_BBASE(u) ((const char*)g.Bt + (size_t)(u).pn * tstepB + (size_t)(u).sub * K * 2)
    Unit cur, nxt; int ui = 0;
    if (!S.next(0, cur)) return;
    Acc acc;
#pragma unroll
    for (int a = 0; a < 2; ++a)
#pragma unroll
        for (int b = 0; b < 2; ++b)
#pragma unroll
            for (int m = 0; m < 4; ++m)
#pragma unroll
                for (int n = 0; n < 2; ++n) acc[a][b][m][n] = (f32x4){0.f, 0.f, 0.f, 0.f};
    bf16x8 At[4][2], B0[2][2], B1[2][2];
    const char* cA = PG8_ABASE(cur); const char* cB = PG8_BBASE(cur);
    PG8_STAGE(PG8_SB(0, 0), cB, voffB); PG8_STAGE(PG8_SB(0, 1), cB + hstepB, voffB); PG8_STAGE(PG8_SA(0, 0), cA, voffA); PG8_STAGE(PG8_SA(0, 1), cA + hstepA, voffA);
    if (wr == 1) PG8_BAR;
    PG8_WAIT_V(2); PG8_BAR;
    PG8_STAGE(PG8_SB(1, 0), cB + kstep, voffB); PG8_STAGE(PG8_SA(1, 0), cA + kstep, voffA); PG8_STAGE(PG8_SB(1, 1), cB + hstepB + kstep, voffB);
    PG8_WAIT_V(6); PG8_BAR;
    for (;;) {
        const bool has_next = S.next(ui + 1, nxt);
        const char* nA = has_next ? PG8_ABASE(nxt) : cA; const char* nB = has_next ? PG8_BBASE(nxt) : cB;
        for (int t = 0; t < nt; t += 2) {
            const bool last = (t == nt - 2);
            const char* a1 = cA + (size_t)(t + 1) * kstep;
            const char* a2 = last ? nA : cA + (size_t)(t + 2) * kstep; const char* b2 = last ? nB : cB + (size_t)(t + 2) * kstep;
            const char* a3 = a2 + kstep; const char* b3 = b2 + kstep;
            PG8_LDB(B0, 0, 0); PG8_LDB(B1, 0, 1); PG8_SCHED; PG8_LDA(At, 0, 0); PG8_STAGE(PG8_SA(1, 1), a1 + hstepA, voffA);
            PG8_WAIT_V(8); PG8_WAIT_L(0); PG8_BAR; PG8_MMA(0, 0, At, B0); PG8_MMA(0, 1, At, B1); PG8_BAR; PG8_SCHED;
            PG8_LDA(At, 0, 1); PG8_STAGE(PG8_SB(0, 0), b2, voffB); PG8_STAGE(PG8_SB(0, 1), b2 + hstepB, voffB); PG8_STAGE(PG8_SA(0, 0), a2, voffA);
            PG8_WAIT_V(8); PG8_WAIT_L(0); PG8_BAR; PG8_MMA(1, 0, At, B0); PG8_MMA(1, 1, At, B1); PG8_BAR; PG8_SCHED;
            PG8_LDB(B0, 1, 0); PG8_LDB(B1, 1, 1); PG8_SCHED; PG8_LDA(At, 1, 0); PG8_STAGE(PG8_SA(0, 1), a2 + hstepA, voffA);
            PG8_WAIT_V(8); PG8_WAIT_L(0); PG8_BAR; PG8_MMA(0, 0, At, B0); PG8_MMA(0, 1, At, B1); PG8_BAR; PG8_SCHED;
            PG8_LDA(At, 1, 1); PG8_STAGE(PG8_SB(1, 0), b3, voffB); PG8_STAGE(PG8_SB(1, 1), b3 + hstepB, voffB); PG8_STAGE(PG8_SA(1, 0), a3, voffA);
            PG8_WAIT_V(8); PG8_WAIT_L(0); PG8_BAR; PG8_MMA(1, 0, At, B0); PG8_MMA(1, 1, At, B1); PG8_BAR; PG8_SCHED;
        }
        if constexpr (ALIGN_EPI) { if (wr == 0) PG8_BAR; }
        if constexpr (Epi::FUSED) E.fused(acc, cur, wr, wc, fr, fq, lds, wid, lane); else E(acc, cur, wr, wc, fr, fq);
        if (!has_next) break;
        if (!E.keep(cur)) {
#pragma unroll
            for (int a = 0; a < 2; ++a)
#pragma unroll
                for (int b = 0; b < 2; ++b)
#pragma unroll
                    for (int m = 0; m < 4; ++m)
#pragma unroll
                        for (int n = 0; n < 2; ++n) acc[a][b][m][n] = (f32x4){0.f, 0.f, 0.f, 0.f};
        }
        cur = nxt; cA = nA; cB = nB; ++ui;
        if constexpr (ALIGN_EPI) { if (wr == 1) PG8_BAR; }
    }
    PG8_WAIT_V(0);
    if constexpr (!ALIGN_EPI) { if (wr == 0) PG8_BAR; }
    PG8_BAR;
#undef PG8_SA
#undef PG8_SB
#undef PG8_STAGE
#undef PG8_LDA
#undef PG8_LDB
#undef PG8_MMA
#undef PG8_WAIT_V
#undef PG8_WAIT_L
#undef PG8_BAR
#undef PG8_SCHED
#undef PG8_ABASE
#undef PG8_BBASE
}
}


#define XB_TMO      128
#define XB_XCNT(j)  (256  + 64 * (j))
#define XB_XSUB(j)  (1280 + 64 * (j))
#define XB_XGEN(j)  (2304 + 64 * (j))
#define XB_TOP      3328
#define XB_TOPGEN   3392
#define XCD_BAR_WORDS 3456
#define XB_SPIN_CAP (1u << 22)
__device__ __forceinline__ unsigned xb_ld(unsigned* p)              { return __hip_atomic_load(p, __ATOMIC_RELAXED, __HIP_MEMORY_SCOPE_AGENT); }
__device__ __forceinline__ unsigned xb_add(unsigned* p, unsigned v) { return __hip_atomic_fetch_add(p, v, __ATOMIC_RELAXED, __HIP_MEMORY_SCOPE_AGENT); }
__device__ __forceinline__ unsigned xb_xcc_id() { return (unsigned)__builtin_amdgcn_s_getreg((3 << 11) | 20) & 0xFu; }
#define XB_SPIN(cond, bar) do { unsigned _sp = 0; while (cond) { __builtin_amdgcn_s_sleep(1); \
    if ((++_sp & 255u) == 0u) { if (xb_ld(&(bar)[XB_TMO])) break; if (_sp > XB_SPIN_CAP) { atomicAdd(&(bar)[XB_TMO], 1u); break; } } } } while (0)
struct XcdBarrier { unsigned* bar; unsigned x; volatile LAS unsigned* st; };
__device__ __forceinline__ XcdBarrier xcd_barrier_post(unsigned* bar, volatile LAS unsigned* st) {
    XcdBarrier b; b.bar = bar; b.x = xb_xcc_id(); b.st = st;
    if (threadIdx.x == 0) (void)xb_add(&bar[XB_XCNT(b.x)], 1u);
    return b;
}
__device__ __forceinline__ void xcd_barrier_complete(unsigned* bar, unsigned x, unsigned& nloc, unsigned& nx) {
    const unsigned G = gridDim.x * gridDim.y * gridDim.z;
    unsigned sum, cnt, mine, sp = 0u;
    for (;;) {
        sum = 0u; cnt = 0u; mine = 0u;
#pragma unroll
        for (unsigned j = 0; j < 16; ++j) { const unsigned c = xb_ld(&bar[XB_XCNT(j)]); sum += c; cnt += (c > 0u) ? 1u : 0u; mine = (j == x) ? c : mine; }
        if (sum == G) break;
        __builtin_amdgcn_s_sleep(1);
        if ((++sp & 255u) == 0u) { if (xb_ld(&bar[XB_TMO])) break; if (sp > XB_SPIN_CAP) { atomicAdd(&bar[XB_TMO], 1u); break; } }
    }
    nloc = mine > 0u ? mine : 1u; nx = cnt > 0u ? cnt : 1u;
}
__device__ __forceinline__ void xcd_barrier(const XcdBarrier& b) {
    asm volatile("s_waitcnt vmcnt(0)" ::: "memory");
    __syncthreads();
    if (threadIdx.x == 0) {
        unsigned* bar = b.bar;
        __builtin_amdgcn_s_waitcnt(0);
        unsigned nloc = b.st[0], nx = b.st[1];
        if (nloc == 0u) { xcd_barrier_complete(bar, b.x, nloc, nx); b.st[0] = nloc; b.st[1] = nx; }
        const unsigned old = xb_add(&bar[XB_XSUB(b.x)], 1u);
        const unsigned gen = old / nloc;
        if (old + 1u == (gen + 1u) * nloc) {
            __builtin_amdgcn_fence(__ATOMIC_RELEASE, "agent");
            asm volatile("s_waitcnt vmcnt(0)" ::: "memory");
            const unsigned og = xb_add(&bar[XB_TOP], 1u);
            const unsigned target = (og / nx + 1u) * nx;
            if (og + 1u != target) XB_SPIN(xb_ld(&bar[XB_TOP]) < target, bar);
            xb_add(&bar[XB_XGEN(b.x)], 1u);
            __builtin_amdgcn_fence(__ATOMIC_ACQUIRE, "agent");
            asm volatile("s_waitcnt vmcnt(0)" ::: "memory");
        } else {
            XB_SPIN(xb_ld(&bar[XB_XGEN(b.x)]) == gen, bar);
            __builtin_amdgcn_fence(__ATOMIC_ACQUIRE, "agent");
            asm volatile("s_waitcnt vmcnt(0)" ::: "memory");
        }
    }
    __syncthreads();
}

struct Args { const float* in[21]; float* out; unsigned char* ws; int ph_lo, ph_hi; };
struct Frame {
    LAS unsigned char* lds;
    int tid, lane, wave, vcu, G;
    const float* const* in_unused;
    float* out; unsigned char* ws;
};

__device__ __forceinline__ void p0_item(const float* W, int N, int scol0, int nvalid, const float* gain, int gmask, bf16* WT, int ldk, int koff, int drow0, int k0, LAS float* scr, int lane) {
    const bool al16 = ((scol0 & 3) == 0) && ((N & 3) == 0) && nvalid == 32;
    if (al16) {
        f32x4 v[8];
#pragma unroll
        for (int i = 0; i < 8; ++i) { const int p_ = lane + 64 * i; v[i] = *(const f32x4*)(W + (size_t)(k0 + (p_ >> 3)) * N + scol0 + (p_ & 7) * 4); }
#pragma unroll
        for (int i = 0; i < 8; ++i) { const int p_ = lane + 64 * i, kk = p_ >> 3, c = (p_ & 7) * 4; const float g = gain ? gain[(k0 + kk) & gmask] : 1.0f;
            scr[kk * 33 + c] = v[i][0] * g; scr[kk * 33 + c + 1] = v[i][1] * g; scr[kk * 33 + c + 2] = v[i][2] * g; scr[kk * 33 + c + 3] = v[i][3] * g; }
    } else {
        float v[32];
#pragma unroll
        for (int i = 0; i < 32; ++i) { const int kk = 2 * i + (lane >> 5), c = lane & 31; v[i] = 0.f; if (c < nvalid) v[i] = W[(size_t)(k0 + kk) * N + scol0 + c]; }
#pragma unroll
        for (int i = 0; i < 32; ++i) { const int kk = 2 * i + (lane >> 5), c = lane & 31; scr[kk * 33 + c] = (gain && c < nvalid) ? v[i] * gain[(k0 + kk) & gmask] : v[i]; }
    }
    LDS_WAIT(); asm volatile("" ::: "memory");
    const int c8 = lane & 7;
#pragma unroll
    for (int j = 0; j < 4; ++j) { const int n = (lane >> 3) + 8 * j; const LAS float* s = scr + (8 * c8) * 33 + n;
        v4u o; o.x = pk2(s[0 * 33], s[1 * 33]); o.y = pk2(s[2 * 33], s[3 * 33]); o.z = pk2(s[4 * 33], s[5 * 33]); o.w = pk2(s[6 * 33], s[7 * 33]);
        *(v4u*)(WT + (size_t)(drow0 + n) * ldk + koff + k0 + 8 * c8) = o; }
    LDS_WAIT(); asm volatile("" ::: "memory");
}
__device__ __forceinline__ int map_ffn_in(int blk) { const int tile = blk >> 3, w = blk & 7; return w < 4 ? tile * 128 + w * 32 : FF + tile * 128 + (w - 4) * 32; }
__device__ __forceinline__ int map_proj_a(int blk, int& nvalid) {
    nvalid = 32;
    if (blk < 16) return S_GQ + 32 * blk;
    if (blk < 32) return S_GK + 32 * (blk - 16);
    if (blk < 64) return S_GV + 32 * (blk - 32);
    if (blk < 96) return S_SQ + 32 * (blk - 64);
    if (blk < 128) return S_GR + 32 * (blk - 96);
    if (blk < 132) return S_SK + 32 * (blk - 128);
    if (blk < 136) return S_SV + 32 * (blk - 132);
    if (blk == 136) { nvalid = GRANK; return S_GLR; }
    nvalid = 0; return 0;
}
__device__ __forceinline__ int map_proj_b(int blk) { const int tile = blk >> 3, w = blk & 7; return w < 4 ? S_GG + tile * 128 + w * 32 : S_GS + tile * 128 + (w - 4) * 32; }


constexpr int P0_I1 = (D / 64) * 176, P0_I1O = (FF / 64) * 32, P0_IA = (D / 64) * 144, P0_IB = (D / 64) * 64, P0_IBR = (D / 64) * 32, P0_IO = (D / 64) * 32;
constexpr int P0_NEARLY = P0_I1 + P0_I1O + P0_IA, P0_NLATE = P0_I1 + P0_I1O + P0_IB + 2 * P0_IBR + P0_IO;
__device__ __forceinline__ void p0_weight_item(const Args& a, int idx, LAS float* scr, int lane) {
    unsigned char* ws = a.ws;
    int r;
    if (idx < P0_NEARLY) {
        r = idx;
        if (r < P0_I1) { const int kb = r / 176, blk = r % 176; p0_item(a.in[6], 2 * FF, map_ffn_in(blk), 32, a.in[5], 1023, (bf16*)(ws + WS_W1T), D, 0, blk * 32, kb * 64, scr, lane); return; }
        r -= P0_I1;
        if (r < P0_I1O) { const int kb = r / 32, blk = r % 32; p0_item(a.in[7], D, blk * 32, 32, nullptr, 0, (bf16*)(ws + WS_W1OT), FF, 0, blk * 32, kb * 64, scr, lane); return; }
        r -= P0_I1O;
        { const int kb = r / 144, blk = r % 144; int nv; const int sc = map_proj_a(blk, nv); p0_item(a.in[9], IN_W, sc, nv, a.in[8], 1023, (bf16*)(ws + WS_WAT), D, 0, blk * 32, kb * 64, scr, lane); return; }
    }
    r = idx - P0_NEARLY;
    if (r < P0_I1) { const int kb = r / 176, blk = r % 176; p0_item(a.in[18], 2 * FF, map_ffn_in(blk), 32, a.in[17], 1023, (bf16*)(ws + WS_W2T), D, 0, blk * 32, kb * 64, scr, lane); return; }
    r -= P0_I1;
    if (r < P0_I1O) { const int kb = r / 32, blk = r % 32; p0_item(a.in[19], D, blk * 32, 32, nullptr, 0, (bf16*)(ws + WS_W2OT), FF, 0, blk * 32, kb * 64, scr, lane); return; }
    r -= P0_I1O;
    if (r < P0_IB) { const int kb = r / 64, blk = r % 64; p0_item(a.in[9], IN_W, map_proj_b(blk), 32, a.in[8], 1023, (bf16*)(ws + WS_WBT), D, 0, blk * 32, kb * 64, scr, lane); return; }
    r -= P0_IB;
    if (r < 2 * P0_IBR) { const int which = r / P0_IBR; r -= which * P0_IBR; const int kb = r / 32, blk = r % 32;
        p0_item(a.in[which ? 15 : 14], D, blk * 32, 32, which ? nullptr : a.in[12], 255, (bf16*)(ws + WS_WBRT), 2 * D, which * D, blk * 32, kb * 64, scr, lane); return; }
    r -= 2 * P0_IBR;
    { const int kb = r / 32, blk = r % 32; p0_item(a.in[16], D, blk * 32, 32, nullptr, 0, (bf16*)(ws + WS_WOUTT), D, 0, blk * 32, kb * 64, scr, lane); }
}
__device__ __forceinline__ void p0_prologue(const Args& a, Frame& F) {
    LAS float* scr = (LAS float*)(F.lds + F.wave * 16384);
    const int gw = F.vcu * NWAVES + F.wave, NGW = F.G * NWAVES;
    unsigned char* ws = a.ws;
    for (int it = gw; it < P0_NEARLY; it += NGW) p0_weight_item(a, it, scr, F.lane);
    bf16* XB = (bf16*)(ws + WS_XB); float* ssq0 = (float*)(ws + WS_SSQ0);
    for (int m0 = gw; m0 < M; m0 += 4 * NGW) {
        f32x4 v[4][4];
#pragma unroll
        for (int r = 0; r < 4; ++r) { const int m = m0 + r * NGW;
            if (m < M) { const f32x4* xr = (const f32x4*)(m < MP ? a.in[0] + (size_t)m * D : a.in[1] + (size_t)(m - MP) * D) + F.lane;
#pragma unroll
                for (int j = 0; j < 4; ++j) v[r][j] = xr[64 * j]; } }
#pragma unroll
        for (int r = 0; r < 4; ++r) { const int m = m0 + r * NGW;
            if (m < M) {
                float s = 0.f;
#pragma unroll
                for (int j = 0; j < 4; ++j) s += (v[r][j].x * v[r][j].x + v[r][j].y * v[r][j].y) + (v[r][j].z * v[r][j].z + v[r][j].w * v[r][j].w);
                s = wave_sum(s);
                unsigned long long* o8 = (unsigned long long*)(XB + (size_t)m * D) + F.lane;
#pragma unroll
                for (int j = 0; j < 4; ++j) o8[64 * j] = (unsigned long long)pk2(v[r][j].x, v[r][j].y) | ((unsigned long long)pk2(v[r][j].z, v[r][j].w) << 32);
                if (m < MP) { if (F.lane < 16) ssq0[(size_t)m * 16 + F.lane] = F.lane == 0 ? s : 0.f; }
                else ((float*)(ws + WS_SSQ0S))[(size_t)(m - MP) * 64 + F.lane] = F.lane == 0 ? s : 0.f;
            } }
    }
    const int gt = gw * 64 + F.lane, NGT = NGW * 64;
    for (int i = gt; i < 2 * NB * 96 * 32; i += NGT) {
        const int which = i / (NB * 96 * 32), r = i % (NB * 96 * 32), b = r / (96 * 32), rr = r % (96 * 32);
        const f32x4 v = *((const f32x4*)(a.in[which ? 4 : 3] + ((size_t)b * WINDOW + 32) * 128) + rr);
        *((f32x4*)(a.out + (which ? O_CVS : O_CKS) + (size_t)b * WINDOW * 128) + rr) = v;
    }
}

constexpr int SWA_KLD_B = 144;
constexpr int SWA_VLD_B = 392;
constexpr int SWA_K_OFF = 0, SWA_V_OFF = 192 * SWA_KLD_B;
__device__ __forceinline__ void swa_unit(const Args& a, Frame& F, int seq, int chunk, int kvh) {
    const int tid = F.tid, lane = F.lane, wave = F.wave, r32 = lane & 31, hi = lane >> 5;
    const bool samp = seq >= NB; const int b = samp ? seq - NB : seq;
    bf16* SQ = (bf16*)(a.ws + WS_T2); const bf16* SKVb = (const bf16*)(a.ws + WS_SKV);
    const int rowq0 = samp ? MP + b * DEC_T : b * SEQ + chunk * 64;
    const int ntb = samp ? 1 : 2, nkb = samp ? 5 : 6, kb0 = samp ? 0 : (chunk >= 2 ? 0 : (2 - chunk) * 2);
    const int nkeys = nkb * 32;
    LAS unsigned char* Kl = F.lds + SWA_K_OFF; LAS unsigned char* Vl = F.lds + SWA_V_OFF;
    __syncthreads();
    for (int it = tid; it < nkeys * 8; it += NWAVES * 64) {
        const int key = it >> 3, c8 = it & 7;
        if (key < kb0 * 32) continue;
        v4u kk, vv;
        if (samp && key < WINDOW) {
            const float* ck = a.in[3] + ((size_t)(b * WINDOW + key) * SKV + kvh) * SHD + c8 * 8; const float* cv = a.in[4] + ((size_t)(b * WINDOW + key) * SKV + kvh) * SHD + c8 * 8;
            const f32x4 k0 = *(const f32x4*)ck, k1 = *(const f32x4*)(ck + 4), v0 = *(const f32x4*)cv, v1 = *(const f32x4*)(cv + 4);
            kk.x = pk2(k0[0], k0[1]); kk.y = pk2(k0[2], k0[3]); kk.z = pk2(k1[0], k1[1]); kk.w = pk2(k1[2], k1[3]);
            vv.x = pk2(v0[0], v0[1]); vv.y = pk2(v0[2], v0[3]); vv.z = pk2(v1[0], v1[1]); vv.w = pk2(v1[2], v1[3]);
        } else {
            const int mrow = samp ? MP + b * DEC_T + (key - WINDOW) : b * SEQ + (chunk - 2) * 64 + key;
            kk = *(const v4u*)(SKVb + (size_t)mrow * 256 + kvh * 64 + c8 * 8); vv = *(const v4u*)(SKVb + (size_t)mrow * 256 + 128 + kvh * 64 + c8 * 8);
        }
        *(LAS v4u*)(Kl + key * SWA_KLD_B + c8 * 16) = kk;
        LAS unsigned short* vt = (LAS unsigned short*)(Vl + (c8 * 8) * SWA_VLD_B + key * 2);
        vt[0 * (SWA_VLD_B / 2)] = (unsigned short)(vv.x & 0xffff); vt[1 * (SWA_VLD_B / 2)] = (unsigned short)(vv.x >> 16);
        vt[2 * (SWA_VLD_B / 2)] = (unsigned short)(vv.y & 0xffff); vt[3 * (SWA_VLD_B / 2)] = (unsigned short)(vv.y >> 16);
        vt[4 * (SWA_VLD_B / 2)] = (unsigned short)(vv.z & 0xffff); vt[5 * (SWA_VLD_B / 2)] = (unsigned short)(vv.z >> 16);
        vt[6 * (SWA_VLD_B / 2)] = (unsigned short)(vv.w & 0xffff); vt[7 * (SWA_VLD_B / 2)] = (unsigned short)(vv.w >> 16);
    }
    __syncthreads();
    const int head = kvh * 8 + wave;
    const float sink2 = a.in[13][head] * LOG2E;
    for (int tb = 0; tb < ntb; ++tb) {
        bf16* qrow = SQ + (size_t)(rowq0 + tb * 32 + r32) * D + head * SHD;
        bf16x8 qf[4];
#pragma unroll
        for (int s = 0; s < 4; ++s) qf[s] = *(const bf16x8*)(qrow + s * 16 + hi * 8);
        f32x16 sacc[6];
#pragma unroll
        for (int kb = 0; kb < 6; ++kb) {
            if (kb >= kb0 && kb < nkb) {
                f32x16 c = {0.f, 0.f, 0.f, 0.f, 0.f, 0.f, 0.f, 0.f, 0.f, 0.f, 0.f, 0.f, 0.f, 0.f, 0.f, 0.f};
#pragma unroll
                for (int s = 0; s < 4; ++s) { const bf16x8 kf = *(const LAS bf16x8*)(Kl + (kb * 32 + r32) * SWA_KLD_B + s * 32 + hi * 16); c = __builtin_amdgcn_mfma_f32_32x32x16_bf16(kf, qf[s], c, 0, 0, 0); }
                sacc[kb] = c;
            }
        }
        float mx = sink2;
#pragma unroll
        for (int kb = 0; kb < 6; ++kb) if (kb >= kb0 && kb < nkb) {
#pragma unroll
            for (int r = 0; r < 16; ++r) mx = fmaxf(mx, sacc[kb][r]); }
        mx = fmaxf(mx, __shfl_xor(mx, 32));
        float l = 0.f;
#pragma unroll
        for (int kb = 0; kb < 6; ++kb) if (kb >= kb0 && kb < nkb) {
#pragma unroll
            for (int r = 0; r < 16; ++r) { const float p = fast_exp2(sacc[kb][r] - mx); sacc[kb][r] = p; l += p; } }
        l += __shfl_xor(l, 32); l += fast_exp2(sink2 - mx);
        f32x16 o[2];
#pragma unroll
        for (int db = 0; db < 2; ++db) o[db] = (f32x16){0.f, 0.f, 0.f, 0.f, 0.f, 0.f, 0.f, 0.f, 0.f, 0.f, 0.f, 0.f, 0.f, 0.f, 0.f, 0.f};
#pragma unroll
        for (int kb = 0; kb < 6; ++kb) if (kb >= kb0 && kb < nkb) {
#pragma unroll
            for (int s2 = 0; s2 < 2; ++s2) {
                v4u pw; pw.x = pk2(sacc[kb][8 * s2 + 0], sacc[kb][8 * s2 + 1]); pw.y = pk2(sacc[kb][8 * s2 + 2], sacc[kb][8 * s2 + 3]);
                pw.z = pk2(sacc[kb][8 * s2 + 4], sacc[kb][8 * s2 + 5]); pw.w = pk2(sacc[kb][8 * s2 + 6], sacc[kb][8 * s2 + 7]);
                const bf16x8 pb = __builtin_bit_cast(bf16x8, pw);
#pragma unroll
                for (int db = 0; db < 2; ++db) {
                    const LAS unsigned char* vp = Vl + (db * 32 + r32) * SWA_VLD_B + (kb * 32 + s2 * 16 + 4 * hi) * 2;
                    const v2u lo = *(const LAS v2u*)vp, hi8 = *(const LAS v2u*)(vp + 16);
                    v4u av; av.x = lo.x; av.y = lo.y; av.z = hi8.x; av.w = hi8.y;
                    o[db] = __builtin_amdgcn_mfma_f32_32x32x16_bf16(__builtin_bit_cast(bf16x8, av), pb, o[db], 0, 0, 0);
                }
            }
        }
        const float inv = fast_rcp(l);
#pragma unroll
        for (int db = 0; db < 2; ++db)
#pragma unroll
            for (int g4 = 0; g4 < 4; ++g4) {
                v2u w; w.x = pk2(o[db][4 * g4 + 0] * inv, o[db][4 * g4 + 1] * inv); w.y = pk2(o[db][4 * g4 + 2] * inv, o[db][4 * g4 + 3] * inv);
                *(v2u*)(qrow + db * 32 + 8 * g4 + 4 * hi) = w;
            }
    }
}

struct SwaRegs { v4u kk[3], vv[3]; };
__device__ __forceinline__ void swa_p_load(SwaRegs& R, const Args& a, int u, int tid) {
    const int b = u >> 7, chunk = (u >> 1) & 63, kvh = u & 1;
    const bf16* SKVb = (const bf16*)(a.ws + WS_SKV);
    const char* base = (const char*)(SKVb + ((size_t)b * SEQ + (size_t)(chunk - 2) * 64) * 256 + kvh * 64);
#pragma unroll
    for (int i = 0; i < 3; ++i) {
        const int it = tid + 512 * i, key = it >> 3, c8 = it & 7;
        R.kk[i] = (v4u){0u, 0u, 0u, 0u}; R.vv[i] = (v4u){0u, 0u, 0u, 0u};
        if (key + (chunk - 2) * 64 >= 0) { R.kk[i] = *(const v4u*)(base + (size_t)key * 512 + c8 * 16); R.vv[i] = *(const v4u*)(base + (size_t)key * 512 + 256 + c8 * 16); }
    }
}
__device__ __forceinline__ void swa_p_compute(SwaRegs& R, const Args& a, Frame& F, int u) {
    const int tid = F.tid, lane = F.lane, wave = F.wave, r32 = lane & 31, hi = lane >> 5;
    const int b = u >> 7, chunk = (u >> 1) & 63, kvh = u & 1;
    bf16* SQ = (bf16*)(a.ws + WS_T2);
    const int rowq0 = b * SEQ + chunk * 64, kb0 = chunk >= 2 ? 0 : (2 - chunk) * 2;
    LAS unsigned char* Kl = F.lds + SWA_K_OFF; LAS unsigned char* Vl = F.lds + SWA_V_OFF;
    const int head = kvh * 8 + wave;
    bf16* qrow0 = SQ + (size_t)(rowq0 + r32) * D + head * SHD;
    bf16x8 qf[2][4];
#pragma unroll
    for (int s = 0; s < 4; ++s) qf[0][s] = *(const bf16x8*)(qrow0 + s * 16 + hi * 8);
    const float sink2 = a.in[13][head] * LOG2E;
    LDS_BAR();
#pragma unroll
    for (int i = 0; i < 3; ++i) {
        const int it = tid + 512 * i, key = it >> 3, c8 = it & 7;
        *(LAS v4u*)(Kl + key * SWA_KLD_B + c8 * 16) = R.kk[i];
        LAS unsigned short* vt = (LAS unsigned short*)(Vl + (c8 * 8) * SWA_VLD_B + key * 2);
        const unsigned w_[4] = {R.vv[i].x, R.vv[i].y, R.vv[i].z, R.vv[i].w};
#pragma unroll
        for (int q = 0; q < 4; ++q) { vt[(2 * q) * (SWA_VLD_B / 2)] = (unsigned short)(w_[q] & 0xffffu); vt[(2 * q + 1) * (SWA_VLD_B / 2)] = (unsigned short)(w_[q] >> 16); }
    }
    LDS_BAR();
#pragma unroll
    for (int tb = 0; tb < 2; ++tb) {
        bf16* qrow = qrow0 + (size_t)tb * 32 * D;
        f32x16 sacc[6];
#pragma unroll
        for (int kb = 0; kb < 6; ++kb) {
            if (kb >= kb0) {
                f32x16 c = {0.f, 0.f, 0.f, 0.f, 0.f, 0.f, 0.f, 0.f, 0.f, 0.f, 0.f, 0.f, 0.f, 0.f, 0.f, 0.f};
                bf16x8 kf[4];
#pragma unroll
                for (int s = 0; s < 4; ++s) kf[s] = *(const LAS bf16x8*)(Kl + (kb * 32 + r32) * SWA_KLD_B + s * 32 + hi * 16);
#pragma unroll
                for (int s = 0; s < 4; ++s) c = __builtin_amdgcn_mfma_f32_32x32x16_bf16(kf[s], qf[tb][s], c, 0, 0, 0);
                sacc[kb] = c;
            }
        }
        if (tb == 0) {
#pragma unroll
            for (int s = 0; s < 4; ++s) qf[1][s] = *(const bf16x8*)(qrow0 + (size_t)32 * D + s * 16 + hi * 8);
        }
        float mx = sink2;
#pragma unroll
        for (int kb = 0; kb < 6; ++kb) if (kb >= kb0) {
#pragma unroll
            for (int r = 0; r < 16; ++r) mx = fmaxf(mx, sacc[kb][r]); }
        mx = fmaxf(mx, __shfl_xor(mx, 32));
        float l = 0.f;
#pragma unroll
        for (int kb = 0; kb < 6; ++kb) if (kb >= kb0) {
#pragma unroll
            for (int r = 0; r < 16; ++r) { const float p = fast_exp2(sacc[kb][r] - mx); sacc[kb][r] = p; l += p; } }
        l += __shfl_xor(l, 32); l += fast_exp2(sink2 - mx);
        f32x16 o[2];
#pragma unroll
        for (int db = 0; db < 2; ++db) o[db] = (f32x16){0.f, 0.f, 0.f, 0.f, 0.f, 0.f, 0.f, 0.f, 0.f, 0.f, 0.f, 0.f, 0.f, 0.f, 0.f, 0.f};
#pragma unroll
        for (int kb = 0; kb < 6; ++kb) if (kb >= kb0) {
            v2u vlo[2][2], vhi[2][2];
#pragma unroll
            for (int s2 = 0; s2 < 2; ++s2)
#pragma unroll
                for (int db = 0; db < 2; ++db) {
                    const LAS unsigned char* vp = Vl + (db * 32 + r32) * SWA_VLD_B + (kb * 32 + s2 * 16 + 4 * hi) * 2;
                    vlo[s2][db] = *(const LAS v2u*)vp; vhi[s2][db] = *(const LAS v2u*)(vp + 16);
                }
            bf16x8 pb[2];
#pragma unroll
            for (int s2 = 0; s2 < 2; ++s2) {
                v4u pw; pw.x = pk2(sacc[kb][8 * s2 + 0], sacc[kb][8 * s2 + 1]); pw.y = pk2(sacc[kb][8 * s2 + 2], sacc[kb][8 * s2 + 3]);
                pw.z = pk2(sacc[kb][8 * s2 + 4], sacc[kb][8 * s2 + 5]); pw.w = pk2(sacc[kb][8 * s2 + 6], sacc[kb][8 * s2 + 7]);
                pb[s2] = __builtin_bit_cast(bf16x8, pw);
            }
            asm volatile("s_waitcnt lgkmcnt(0)" ::: "memory"); __builtin_amdgcn_sched_barrier(0);
#pragma unroll
            for (int s2 = 0; s2 < 2; ++s2)
#pragma unroll
                for (int db = 0; db < 2; ++db) {
                    v4u av; av.x = vlo[s2][db].x; av.y = vlo[s2][db].y; av.z = vhi[s2][db].x; av.w = vhi[s2][db].y;
                    o[db] = __builtin_amdgcn_mfma_f32_32x32x16_bf16(__builtin_bit_cast(bf16x8, av), pb[s2], o[db], 0, 0, 0);
                }
            __builtin_amdgcn_sched_barrier(0);
        }
        const float inv = fast_rcp(l);
#pragma unroll
        for (int db = 0; db < 2; ++db)
#pragma unroll
            for (int g4 = 0; g4 < 4; ++g4) {
                v2u w; w.x = pk2(o[db][4 * g4 + 0] * inv, o[db][4 * g4 + 1] * inv); w.y = pk2(o[db][4 * g4 + 2] * inv, o[db][4 * g4 + 3] * inv);
                *(v2u*)(qrow + db * 32 + 8 * g4 + 4 * hi) = w;
            }
    }
}

constexpr int G1_GLR_OFF = 0, G1_TOT_OFF = 4096, G1_Q_OFF = 6144, G1_LD_B = 272, G1_K_OFF = G1_Q_OFF + 64 * G1_LD_B;
struct G1Regs { v4u qraw[2], kraw[2]; f32x4 gl; };
__device__ __forceinline__ void g1_load(G1Regs& R, const Args& a, int seq, int chunk, int h, int tid) {
    const bool samp = seq >= NB; const int b = samp ? seq - NB : seq;
    const int row0 = samp ? MP + b * DEC_T : b * SEQ + chunk * 64, L = samp ? DEC_T : 64;
    const bf16* QK = (const bf16*)(a.ws + WS_T0); const float* GLR = (const float*)(a.ws + WS_GLR);
#pragma unroll
    for (int j = 0; j < 2; ++j) { const int idx = tid + 512 * j, t = idx >> 4, c16 = idx & 15;
        R.qraw[j] = (v4u){0u, 0u, 0u, 0u}; R.kraw[j] = (v4u){0u, 0u, 0u, 0u};
        if (t < L) { const bf16* src = QK + (size_t)(row0 + t) * D + h * 128 + c16 * 8; R.qraw[j] = *(const v4u*)src; R.kraw[j] = *(const v4u*)(src + 512); } }
    R.gl = (f32x4){0.f, 0.f, 0.f, 0.f};
    if (tid < 256) { const int t = tid >> 2, c4 = tid & 3; if (t < L) R.gl = *(const f32x4*)(GLR + (size_t)(row0 + t) * 16 + c4 * 4); }
}
__device__ __forceinline__ void g1_compute(G1Regs& R, const float (&w)[16], float bias, const Args& a, Frame& F, int seq, int chunk, int h) {
    const int tid = F.tid, lane = F.lane, wave = F.wave, fr = lane & 15, fq = lane >> 4;
    const bool samp = seq >= NB; const int b = samp ? seq - NB : seq;
    const int row0 = samp ? MP + b * DEC_T : b * SEQ + chunk * 64, L = samp ? DEC_T : 64;
    const int uid = samp ? NB * 64 * GH + b * GH + h : (b * 64 + chunk) * GH + h;
    bf16* QK = (bf16*)(a.ws + WS_T0); bf16* KT = (bf16*)(a.ws + WS_T7); bf16* ABUF = (bf16*)(a.ws + WS_ABUF);
    float* gdec = (float*)(a.ws + WS_GDEC);
    LAS float* glr_l = (LAS float*)(F.lds + G1_GLR_OFF); LAS float* tot = (LAS float*)(F.lds + G1_TOT_OFF);
    LAS unsigned char* ql = F.lds + G1_Q_OFF; LAS unsigned char* kl = F.lds + G1_K_OFF;
    const int d = tid & 127, strip = tid >> 7, t0 = strip * 16;
    LDS_BAR();
#pragma unroll
    for (int j = 0; j < 2; ++j) { const int idx = tid + 512 * j, t = idx >> 4, c16 = idx & 15; *(LAS v4u*)(ql + t * G1_LD_B + c16 * 16) = R.qraw[j]; *(LAS v4u*)(kl + t * G1_LD_B + c16 * 16) = R.kraw[j]; }
    if (tid < 256) *(LAS f32x4*)(glr_l + (tid >> 2) * 16 + (tid & 3) * 4) = R.gl;
    LDS_BAR();
    float bc[16]; float run = 0.f;
#pragma unroll
    for (int i = 0; i < 16; ++i) {
        const int t = t0 + i; float lg = bias;
#pragma unroll
        for (int r4 = 0; r4 < 4; ++r4) { const f32x4 gv = *(const LAS f32x4*)(glr_l + t * 16 + r4 * 4); lg += gv[0] * w[r4 * 4] + gv[1] * w[r4 * 4 + 1] + gv[2] * w[r4 * 4 + 2] + gv[3] * w[r4 * 4 + 3]; }
        const float ls = fminf(lg, 0.f) - __logf(1.0f + __expf(-fabsf(lg)));
        run += (t < L) ? ls * (1.0f / 16.0f) : 0.f; bc[i] = run;
    }
    tot[strip * 128 + d] = run;
    LDS_BAR();
    float off = 0.f, bL = 0.f;
#pragma unroll
    for (int s = 0; s < 4; ++s) { const float tv = tot[s * 128 + d]; bL += tv; if (s < strip) off += tv; }
    unsigned short kp[16];
    const float ebL = __expf(bL);
#pragma unroll
    for (int i = 0; i < 16; ++i) {
        const int t = t0 + i; const float bt = bc[i] + off;
        LAS unsigned short* qe = (LAS unsigned short*)(ql + t * G1_LD_B + d * 2); LAS unsigned short* ke = (LAS unsigned short*)(kl + t * G1_LD_B + d * 2);
        const float q = bf2f(*qe), k = bf2f(*ke);
        const float eb = __expf(bt), ebi = fast_rcp(eb);
        kp[i] = f2bf(k * (ebL * ebi));
        *qe = f2bf(q * eb); *ke = f2bf(k * ebi);
    }
    { v4u o0, o1; o0.x = kp[0] | ((unsigned)kp[1] << 16); o0.y = kp[2] | ((unsigned)kp[3] << 16); o0.z = kp[4] | ((unsigned)kp[5] << 16); o0.w = kp[6] | ((unsigned)kp[7] << 16);
      o1.x = kp[8] | ((unsigned)kp[9] << 16); o1.y = kp[10] | ((unsigned)kp[11] << 16); o1.z = kp[12] | ((unsigned)kp[13] << 16); o1.w = kp[14] | ((unsigned)kp[15] << 16);
      v4u* kd = (v4u*)(KT + ((size_t)uid * 128 + d) * 64 + t0); kd[0] = o0; kd[1] = o1; }
    if (strip == 0) gdec[(size_t)uid * 128 + d] = ebL;
    LDS_BAR();
#pragma unroll
    for (int j = 0; j < 2; ++j) { const int idx = tid + 512 * j, t = idx >> 4, c16 = idx & 15;
        if (t < L) *(v4u*)(QK + (size_t)(row0 + t) * D + h * 128 + c16 * 8) = *(const LAS v4u*)(ql + t * G1_LD_B + c16 * 16); }
    const int sb = wave >> 1;
    bf16x8 kf[4];
#pragma unroll
    for (int kd = 0; kd < 4; ++kd) kf[kd] = *(const LAS bf16x8*)(kl + (sb * 16 + fr) * G1_LD_B + (kd * 32 + 8 * fq) * 2);
#pragma unroll
    for (int x = 0; x < 2; ++x) {
        const int tb = 2 * (wave & 1) + x;
        f32x4 c = {0.f, 0.f, 0.f, 0.f};
#pragma unroll
        for (int kd = 0; kd < 4; ++kd) { const bf16x8 qf = *(const LAS bf16x8*)(ql + (tb * 16 + fr) * G1_LD_B + (kd * 32 + 8 * fq) * 2); c = __builtin_amdgcn_mfma_f32_16x16x32_bf16(kf[kd], qf, c, 0, 0, 0); }
        const int t = tb * 16 + fr, s0 = sb * 16 + 4 * fq;
        float v[4];
#pragma unroll
        for (int j = 0; j < 4; ++j) v[j] = (t >= s0 + j) ? c[j] : 0.f;
        if (t < L) { v2u o; o.x = pk2(v[0], v[1]); o.y = pk2(v[2], v[3]); *(v2u*)(ABUF + (size_t)(row0 + t) * 256 + h * 64 + s0) = o; }
    }
}

constexpr int H2_A_OFF = 0, H2_A_LD = 160, H2_Q_OFF = 64 * H2_A_LD, H2_Q_LD = 288, H2_KT_OFF = H2_Q_OFF + 64 * H2_Q_LD, H2_KT_LD = 160, H2_VT_OFF = H2_KT_OFF + 128 * H2_KT_LD, H2_VT_LD = 160,
              H2_ST_OFF = H2_VT_OFF + 64 * H2_VT_LD, H2_ST_LD = 288, H2_END = H2_ST_OFF + 64 * H2_ST_LD;
constexpr int H2_BUF = 77824;
static_assert(H2_END <= H2_BUF && 2 * H2_BUF <= PHASE_LDS, "G2 LDS map");
struct H2Regs { v4u a; v4u q[2]; v4u kt[2]; v4u v; f32x4 g4; };
struct H2Off { unsigned a, q, k, v, g, o; };
template <bool SAMP> __device__ __forceinline__ void h2_load(H2Regs& R, const Args& a, const H2Off& O, int row0, int uid, int h, int es, int tid, int lane) {
    const char* bA = (const char*)(a.ws + WS_ABUF) + ((size_t)row0 * 256 + h * 64) * 2;
    const char* bQ = (const char*)(a.ws + WS_T0) + ((size_t)row0 * D + h * 128) * 2;
    const char* bK = (const char*)(a.ws + WS_T7) + (size_t)uid * 16384;
    const char* bV = (const char*)(a.ws + WS_T1) + ((size_t)row0 * D + h * 256 + es * 64) * 2;
    const char* bG = (const char*)(a.ws + WS_GDEC) + (size_t)uid * 512;
    const v4u z = {0u, 0u, 0u, 0u};
    R.a = z; if (!SAMP || (tid >> 3) < DEC_T) R.a = *(const v4u*)(bA + O.a);
#pragma unroll
    for (int j = 0; j < 2; ++j) { R.q[j] = z; if (!SAMP || j == 0) R.q[j] = *(const v4u*)(bQ + O.q + j * 65536); }
#pragma unroll
    for (int j = 0; j < 2; ++j) R.kt[j] = *(const v4u*)(bK + O.k + j * 8192);
    R.v = z; if (!SAMP || lane < DEC_T) R.v = *(const v4u*)(bV + O.v);
    R.g4 = *(const f32x4*)(bG + O.g);
}
__device__ __forceinline__ void h2_stage(const H2Regs& R, LAS unsigned char* lds, int tid, int lane, int wave) {
    { const int t = tid >> 3, ch = tid & 7; *(LAS v4u*)(lds + H2_A_OFF + t * H2_A_LD + ch * 16) = R.a; }
#pragma unroll
    for (int j = 0; j < 2; ++j) { const int p = tid + 512 * j; *(LAS v4u*)(lds + H2_Q_OFF + (p >> 4) * H2_Q_LD + (p & 15) * 16) = R.q[j]; *(LAS v4u*)(lds + H2_KT_OFF + (p >> 3) * H2_KT_LD + (p & 7) * 16) = R.kt[j]; }
    { LAS unsigned short* vt = (LAS unsigned short*)(lds + H2_VT_OFF + (wave * 8) * H2_VT_LD + lane * 2); const unsigned w_[4] = {R.v.x, R.v.y, R.v.z, R.v.w};
#pragma unroll
      for (int i = 0; i < 4; ++i) { vt[(2 * i) * (H2_VT_LD / 2)] = (unsigned short)(w_[i] & 0xffffu); vt[(2 * i + 1) * (H2_VT_LD / 2)] = (unsigned short)(w_[i] >> 16); } }
}
template <bool SAMP> __device__ __forceinline__ void g2_item(const Args& a, Frame& F, int bh, int es) {
    const int tid = F.tid, lane = F.lane, wave = F.wave, fr = lane & 15, fq = lane >> 4;
    constexpr int nch = SAMP ? 1 : 64; const int b = bh >> 2, h = bh & 3;
    const int tb = wave >> 1, eb0 = (wave & 1) * 2;
    bf16* OG = (bf16*)(a.ws + WS_T1);
    LAS unsigned char* lds0 = F.lds;
    H2Off OF; OF.a = (unsigned)((tid >> 3) * 512 + (tid & 7) * 16); OF.q = (unsigned)((tid >> 4) * 2048 + (tid & 15) * 16); OF.k = (unsigned)(tid * 16);
    OF.v = (unsigned)(lane * 2048 + wave * 16); OF.g = (unsigned)((16 * wave + 4 * fq) * 4); OF.o = (unsigned)(((tb * 16 + fr) * D + eb0 * 16 + 4 * fq) * 2);
    f32x4 S[4];
#pragma unroll
    for (int eb = 0; eb < 4; ++eb)
#pragma unroll
        for (int r = 0; r < 4; ++r) S[eb][r] = SAMP ? a.in[2][((size_t)bh * 128 + 16 * wave + 4 * fq + r) * 256 + es * 64 + eb * 16 + fr] : 0.f;
    H2Regs R0, R1, R2;
#define H2_LOADC(R, cc) do { const int c_ = (cc) < nch ? (cc) : nch - 1; \
        h2_load<SAMP>(R, a, OF, SAMP ? MP + b * DEC_T : b * SEQ + c_ * 64, SAMP ? NB * 64 * GH + bh : (b * 64 + c_) * GH + h, h, es, tid, lane); } while (0)
#define H2_STEP(R, NXT, cc, PAR) do { \
        const int row0 = SAMP ? MP + b * DEC_T : b * SEQ + (cc) * 64; \
        LAS unsigned char* lds = lds0 + (PAR) * H2_BUF; \
        asm volatile("" : "+v"(R.a), "+v"(R.q[0]), "+v"(R.q[1]), "+v"(R.kt[0]), "+v"(R.kt[1]), "+v"(R.v), "+v"(R.g4)); \
        h2_stage(R, lds, tid, lane, wave); \
        const f32x4 g4 = R.g4; \
        _Pragma("unroll") for (int eb = 0; eb < 4; ++eb) { v2u o; o.x = pk2(S[eb][0], S[eb][1]); o.y = pk2(S[eb][2], S[eb][3]); *(LAS v2u*)(lds + H2_ST_OFF + (eb * 16 + fr) * H2_ST_LD + (16 * wave + 4 * fq) * 2) = o; } \
        LDS_BAR(); \
        if (!SAMP) H2_LOADC(NXT, (cc) + 2); \
        { bf16x8 afr[2], qfr[4], vo[2][2], sf[2][4]; \
          _Pragma("unroll") for (int ks = 0; ks < 2; ++ks) afr[ks] = *(const LAS bf16x8*)(lds + H2_A_OFF + (tb * 16 + fr) * H2_A_LD + ks * 64 + fq * 16); \
          _Pragma("unroll") for (int kd = 0; kd < 4; ++kd) qfr[kd] = *(const LAS bf16x8*)(lds + H2_Q_OFF + (tb * 16 + fr) * H2_Q_LD + kd * 64 + fq * 16); \
          _Pragma("unroll") for (int j = 0; j < 2; ++j) { \
              _Pragma("unroll") for (int ks = 0; ks < 2; ++ks) vo[j][ks] = *(const LAS bf16x8*)(lds + H2_VT_OFF + ((eb0 + j) * 16 + fr) * H2_VT_LD + ks * 64 + fq * 16); \
              _Pragma("unroll") for (int kd = 0; kd < 4; ++kd) sf[j][kd] = *(const LAS bf16x8*)(lds + H2_ST_OFF + ((eb0 + j) * 16 + fr) * H2_ST_LD + kd * 64 + fq * 16); } \
          asm volatile("s_waitcnt lgkmcnt(0)" ::: "memory"); __builtin_amdgcn_sched_barrier(0); \
          f32x4 acc0 = {0.f, 0.f, 0.f, 0.f}, acc1 = {0.f, 0.f, 0.f, 0.f}; \
          _Pragma("unroll") for (int ks = 0; ks < 2; ++ks) { acc0 = __builtin_amdgcn_mfma_f32_16x16x32_bf16(vo[0][ks], afr[ks], acc0, 0, 0, 0); acc1 = __builtin_amdgcn_mfma_f32_16x16x32_bf16(vo[1][ks], afr[ks], acc1, 0, 0, 0); } \
          _Pragma("unroll") for (int kd = 0; kd < 4; ++kd) { acc0 = __builtin_amdgcn_mfma_f32_16x16x32_bf16(sf[0][kd], qfr[kd], acc0, 0, 0, 0); acc1 = __builtin_amdgcn_mfma_f32_16x16x32_bf16(sf[1][kd], qfr[kd], acc1, 0, 0, 0); } \
          __builtin_amdgcn_sched_barrier(0); \
          bf16x8 kfr[2], vb[4][2]; \
          _Pragma("unroll") for (int ks = 0; ks < 2; ++ks) kfr[ks] = *(const LAS bf16x8*)(lds + H2_KT_OFF + (16 * wave + fr) * H2_KT_LD + ks * 64 + fq * 16); \
          _Pragma("unroll") for (int eb = 0; eb < 4; ++eb) _Pragma("unroll") for (int ks = 0; ks < 2; ++ks) vb[eb][ks] = *(const LAS bf16x8*)(lds + H2_VT_OFF + (eb * 16 + fr) * H2_VT_LD + ks * 64 + fq * 16); \
          _Pragma("unroll") for (int eb = 0; eb < 4; ++eb) S[eb] = S[eb] * g4; \
          asm volatile("s_waitcnt lgkmcnt(0)" ::: "memory"); __builtin_amdgcn_sched_barrier(0); \
          _Pragma("unroll") for (int ks = 0; ks < 2; ++ks) _Pragma("unroll") for (int eb = 0; eb < 4; ++eb) S[eb] = __builtin_amdgcn_mfma_f32_16x16x32_bf16(kfr[ks], vb[eb][ks], S[eb], 0, 0, 0); \
          if (!SAMP || tb < 2) { v2u o; o.x = pk2(acc0[0], acc0[1]); o.y = pk2(acc0[2], acc0[3]); *(v2u*)((char*)OG + ((size_t)row0 * D + h * 256 + es * 64) * 2 + OF.o) = o; \
                                 o.x = pk2(acc1[0], acc1[1]); o.y = pk2(acc1[2], acc1[3]); *(v2u*)((char*)OG + ((size_t)row0 * D + h * 256 + es * 64) * 2 + OF.o + 32) = o; } } \
    } while (0)
    H2_LOADC(R0, 0); if (!SAMP) H2_LOADC(R1, 1);
    LDS_BAR();
    if (SAMP) { H2_STEP(R0, R2, 0, 0); }
    else {
        H2_STEP(R0, R2, 0, 0); H2_STEP(R1, R0, 1, 1);
        for (int c = 2; c < 62; c += 6) { H2_STEP(R2, R1, c, 0); H2_STEP(R0, R2, c + 1, 1); H2_STEP(R1, R0, c + 2, 0); H2_STEP(R2, R1, c + 3, 1); H2_STEP(R0, R2, c + 4, 0); H2_STEP(R1, R0, c + 5, 1); }
        H2_STEP(R2, R1, 62, 0); H2_STEP(R0, R2, 63, 1);
    }
#undef H2_STEP
#undef H2_LOADC
    float* so = a.out + (SAMP ? O_SGS : O_SGP);
#pragma unroll
    for (int eb = 0; eb < 4; ++eb)
#pragma unroll
        for (int r = 0; r < 4; ++r) so[((size_t)bh * 128 + 16 * wave + 4 * fq + r) * 256 + es * 64 + eb * 16 + fr] = S[eb][r];
}

template <int NACC> __device__ __forceinline__ void sg_kloop(f32x4 (&c)[NACC], const bf16* ap, const bf16* (&bp)[NACC], int K) {
#pragma unroll 8
    for (int k0 = 0; k0 < K; k0 += 32) {
        const bf16x8 a = *(const bf16x8*)(ap + k0);
#pragma unroll
        for (int i = 0; i < NACC; ++i) { const bf16x8 b = *(const bf16x8*)(bp[i] + k0); c[i] = __builtin_amdgcn_mfma_f32_16x16x32_bf16(b, a, c[i], 0, 0, 0); }
    }
}
__device__ __forceinline__ float sg_rstd(const float* ssqs, int lr, int fq) {
    const f32x4* p = (const f32x4*)(ssqs + (size_t)lr * 64 + fq * 16);
    const f32x4 a = p[0], b = p[1], c = p[2], d = p[3];
    float s = ((a.x + a.y) + (a.z + a.w)) + ((b.x + b.y) + (b.z + b.w)) + ((c.x + c.y) + (c.z + c.w)) + ((d.x + d.y) + (d.z + d.w));
    s += __shfl_xor(s, 16); s += __shfl_xor(s, 32);
    return __builtin_amdgcn_rsqf(s * (1.0f / D) + EPS);
}
__device__ __forceinline__ void sg_swiglu(const Args& a, Frame& F, const bf16* Wt, const float* ssqs) {
    const int gw = F.vcu * NWAVES + F.wave, NGW = F.G * NWAVES, fr = F.lane & 15, fq = F.lane >> 4;
    const bf16* XB = (const bf16*)(a.ws + WS_XB); bf16* ACT = (bf16*)(a.ws + WS_ACT);
    LAS f32x4* xch = (LAS f32x4*)F.lds;
    for (int it = gw; it < 2 * 16 * (FF / 16); it += NGW) {
        const int id = it >> 1, kh = it & 1;
        const int mb = id & 15, jb = id >> 4, g0 = 16 * jb, lr = mb * 16 + fr, m = MP + lr;
        const int grow = 256 * (g0 >> 7) + (g0 & 127);
        const bf16* bp[2] = {Wt + (size_t)(grow + fr) * D + kh * (D / 2) + 8 * fq, Wt + (size_t)(grow + 128 + fr) * D + kh * (D / 2) + 8 * fq};
        f32x4 c[2] = {{0.f, 0.f, 0.f, 0.f}, {0.f, 0.f, 0.f, 0.f}};
        sg_kloop<2>(c, XB + (size_t)m * D + kh * (D / 2) + 8 * fq, bp, D / 2);
        __syncthreads();
        if (kh) { xch[(F.wave >> 1) * 128 + F.lane] = c[0]; xch[(F.wave >> 1) * 128 + 64 + F.lane] = c[1]; }
        __syncthreads();
        if (!kh) {
            c[0] += xch[(F.wave >> 1) * 128 + F.lane]; c[1] += xch[(F.wave >> 1) * 128 + 64 + F.lane];
            const float rs = sg_rstd(ssqs, lr, fq);
            float o[4];
#pragma unroll
            for (int j = 0; j < 4; ++j) o[j] = siluf_(c[0][j] * rs) * (c[1][j] * rs);
            v2u w; w.x = pk2(o[0], o[1]); w.y = pk2(o[2], o[3]);
            *(v2u*)(ACT + (size_t)m * FF + g0 + 4 * fq) = w;
        }
    }
}
__device__ __forceinline__ void sg_resid(const Args& a, Frame& F, const bf16* A, int lda, const bf16* Wt, int K, const float* res_f32, float alpha, float* ssqs_out) {
    const int gw = F.vcu * NWAVES + F.wave, NGW = F.G * NWAVES, fr = F.lane & 15, fq = F.lane >> 4;
    bf16* XB = (bf16*)(a.ws + WS_XB);
    LAS f32x4* xch = (LAS f32x4*)F.lds;
    const int Kh = K >> 1;
    for (int it = gw; it < 2 * 16 * (D / 16); it += NGW) {
        const int id = it >> 1, kh = it & 1;
        const int mb = id & 15, nb = id >> 4, lr = mb * 16 + fr, m = MP + lr, n0 = 16 * nb + 4 * fq;
        const bf16* bp[1] = {Wt + (size_t)(16 * nb + fr) * K + kh * Kh + 8 * fq};
        f32x4 c[1] = {{0.f, 0.f, 0.f, 0.f}};
        sg_kloop<1>(c, A + (size_t)m * lda + kh * Kh + 8 * fq, bp, Kh);
        __syncthreads();
        if (kh) xch[(F.wave >> 1) * 64 + F.lane] = c[0];
        __syncthreads();
        if (!kh) {
            c[0] += xch[(F.wave >> 1) * 64 + F.lane];
            f32x4 r;
            if (res_f32) r = *(const f32x4*)(res_f32 + (size_t)lr * D + n0);
            else { const v2u rb = *(const v2u*)(XB + (size_t)m * D + n0); r = (f32x4){bflo(rb.x), bfhi(rb.x), bflo(rb.y), bfhi(rb.y)}; }
            const f32x4 v = r + c[0] * alpha;
            { v2u w; w.x = pk2(v[0], v[1]); w.y = pk2(v[2], v[3]); *(v2u*)(XB + (size_t)m * D + n0) = w; }
            if (ssqs_out) { float ss = (v[0] * v[0] + v[1] * v[1]) + (v[2] * v[2] + v[3] * v[3]); ss += __shfl_xor(ss, 16); ss += __shfl_xor(ss, 32); if (fq == 0) ssqs_out[(size_t)lr * 64 + nb] = ss; }
        }
    }
}
__device__ __forceinline__ void sg_proj(const Args& a, Frame& F) {
    const int gw = F.vcu * NWAVES + F.wave, NGW = F.G * NWAVES, fr = F.lane & 15, fq = F.lane >> 4;
    unsigned char* ws = a.ws;
    const bf16* XB = (const bf16*)(ws + WS_XB); const bf16* Wt = (const bf16*)(ws + WS_WAT); const float* ssqs = (const float*)(ws + WS_SSQAS);
    const int ntile = 16 * ((NA - 240) / 16);
    LAS f32x4* xch = (LAS f32x4*)F.lds;
    for (int it = gw; it < 2 * ntile; it += NGW) {
        const int id = it >> 1, kh = it & 1;
        const int mb = id & 15, nb = id >> 4, lr = mb * 16 + fr, m = MP + lr, n0 = 16 * nb, nq = n0 + 4 * fq;
        const bf16* bp[1] = {Wt + (size_t)(n0 + fr) * D + kh * (D / 2) + 8 * fq};
        f32x4 c[1] = {{0.f, 0.f, 0.f, 0.f}};
        sg_kloop<1>(c, XB + (size_t)m * D + kh * (D / 2) + 8 * fq, bp, D / 2);
        __syncthreads();
        if (kh) xch[(F.wave >> 1) * 64 + F.lane] = c[0];
        __syncthreads();
        if (kh) continue;
        c[0] += xch[(F.wave >> 1) * 64 + F.lane];
        const float rs = sg_rstd(ssqs, lr, fq);
        f32x4 v = c[0] * rs;
        if (n0 >= 4352) {
            *(f32x4*)((float*)(ws + WS_GLR) + (size_t)m * 16 + 4 * fq) = v;
        } else if (n0 >= 4096) {
            v2u w; w.x = pk2(v[0], v[1]); w.y = pk2(v[2], v[3]);
            *(v2u*)((bf16*)(ws + WS_SKV) + (size_t)m * 256 + (nq - 4096)) = w;
            const int bs = lr >> 5, t = lr & 31;
            *(f32x4*)(a.out + (nq < 4224 ? O_CKS : O_CVS) + ((size_t)(bs * WINDOW + 96 + t)) * 128 + ((nq - 4096) & 127)) = v;
        } else {
            bf16* dst; int col;
            if (n0 < 1024) { dst = (bf16*)(ws + WS_T0); col = nq; if (n0 < 512) v = v * 0.08838834764831845f; }
            else if (n0 < 2048) { dst = (bf16*)(ws + WS_T1); col = nq - 1024; }
            else if (n0 < 3072) { dst = (bf16*)(ws + WS_T2); col = nq - 2048; v = v * (0.125f * LOG2E); }
            else { dst = (bf16*)(ws + WS_T8); col = nq - 3072;
#pragma unroll
                for (int j = 0; j < 4; ++j) v[j] = siluf_(v[j]); }
            v2u w; w.x = pk2(v[0], v[1]); w.y = pk2(v[2], v[3]);
            *(v2u*)(dst + (size_t)m * D + col) = w;
        }
    }
}
__device__ __forceinline__ void sg_gates(const Args& a, Frame& F) {
    const int gw = F.vcu * NWAVES + F.wave, NGW = F.G * NWAVES, fr = F.lane & 15, fq = F.lane >> 4;
    unsigned char* ws = a.ws;
    const bf16* XB = (const bf16*)(ws + WS_XB); const bf16* Wt = (const bf16*)(ws + WS_WBT); const float* ssqs = (const float*)(ws + WS_SSQAS);
    bf16* R = (bf16*)(ws + WS_T0); bf16* SS = (bf16*)(ws + WS_T7);
    LAS f32x4* xch = (LAS f32x4*)F.lds;
    for (int it = gw; it < 2 * 16 * (D / 16); it += NGW) {
        const int id = it >> 1, kh = it & 1;
        const int mb = id & 15, nb = id >> 4, n0 = 16 * nb, lr = mb * 16 + fr, m = MP + lr;
        const int grow = 256 * (n0 >> 7) + (n0 & 127);
        const bf16* bp[2] = {Wt + (size_t)(grow + fr) * D + kh * (D / 2) + 8 * fq, Wt + (size_t)(grow + 128 + fr) * D + kh * (D / 2) + 8 * fq};
        f32x4 c[2] = {{0.f, 0.f, 0.f, 0.f}, {0.f, 0.f, 0.f, 0.f}};
        sg_kloop<2>(c, XB + (size_t)m * D + kh * (D / 2) + 8 * fq, bp, D / 2);
        __syncthreads();
        if (kh) { xch[(F.wave >> 1) * 128 + F.lane] = c[0]; xch[(F.wave >> 1) * 128 + 64 + F.lane] = c[1]; }
        __syncthreads();
        if (kh) continue;
        c[0] += xch[(F.wave >> 1) * 128 + F.lane]; c[1] += xch[(F.wave >> 1) * 128 + 64 + F.lane];
        const float rs = sg_rstd(ssqs, lr, fq);
        float r[4], ss[4];
#pragma unroll
        for (int j = 0; j < 4; ++j) { const float eg = fast_exp(-c[0][j] * rs), es = fast_exp(-c[1][j] * rs); ss[j] = fast_rcp(1.0f + es); r[j] = (1.0f + es) * fast_rcp(1.0f + eg); }
        v2u w; w.x = pk2(r[0], r[1]); w.y = pk2(r[2], r[3]); *(v2u*)(R + (size_t)m * D + n0 + 4 * fq) = w;
        w.x = pk2(ss[0], ss[1]); w.y = pk2(ss[2], ss[3]); *(v2u*)(SS + (size_t)m * D + n0 + 4 * fq) = w;
    }
}
__device__ __forceinline__ void sg_branch(const Args& a, Frame& F) {
    const int gw = F.vcu * NWAVES + F.wave, NGW = F.G * NWAVES, fr = F.lane & 15, fq = F.lane >> 4;
    unsigned char* ws = a.ws;
    const bf16* Wt = (const bf16*)(ws + WS_WBRT);
    const bf16* GG = (const bf16*)(ws + WS_T0); const bf16* GS = (const bf16*)(ws + WS_T7); bf16* O = (bf16*)(ws + WS_T8);
    LAS f32x4* xch = (LAS f32x4*)F.lds;
    for (int it = gw; it < 2 * 16 * (D / 16); it += NGW) {
        const int id = it >> 1, kh = it & 1;
        const int mb = id & 15, nb = id >> 4, m = MP + mb * 16 + fr, n0 = 16 * nb + 4 * fq;
        const bf16* Asrc = (const bf16*)(ws + (kh ? WS_T2 : WS_T1));
        const bf16* bp[1] = {Wt + (size_t)(16 * nb + fr) * (2 * D) + kh * D + 8 * fq};
        f32x4 c[1] = {{0.f, 0.f, 0.f, 0.f}};
        sg_kloop<1>(c, Asrc + (size_t)m * D + 8 * fq, bp, D);
        __syncthreads();
        if (kh) xch[(F.wave >> 1) * 64 + F.lane] = c[0];
        __syncthreads();
        if (!kh) {
            const f32x4 cb = xch[(F.wave >> 1) * 64 + F.lane];
            const v2u g = *(const v2u*)(GG + (size_t)m * D + n0), sv = *(const v2u*)(GS + (size_t)m * D + n0);
            const float rr[4] = {bflo(g.x), bfhi(g.x), bflo(g.y), bfhi(g.y)}, ss[4] = {bflo(sv.x), bfhi(sv.x), bflo(sv.y), bfhi(sv.y)};
            v2u w; w.x = pk2((c[0][0] * rr[0] + cb[0]) * ss[0], (c[0][1] * rr[1] + cb[1]) * ss[1]); w.y = pk2((c[0][2] * rr[2] + cb[2]) * ss[2], (c[0][3] * rr[3] + cb[3]) * ss[3]);
            *(v2u*)(O + (size_t)m * D + n0) = w;
        }
    }
}

__device__ __forceinline__ void g3_rows4(bf16* OG, const bf16* GR, int lane, int m0, int mstride, int mend) {
    v4u ov[4][2], gv4[4][2];
#pragma unroll
    for (int r = 0; r < 4; ++r) { const int m = m0 + r * mstride; if (m < mend) {
        ov[r][0] = *(const v4u*)(OG + (size_t)m * D + 16 * lane); ov[r][1] = *(const v4u*)(OG + (size_t)m * D + 16 * lane + 8);
        gv4[r][0] = *(const v4u*)(GR + (size_t)m * D + 16 * lane); gv4[r][1] = *(const v4u*)(GR + (size_t)m * D + 16 * lane + 8); } }
#pragma unroll
    for (int r = 0; r < 4; ++r) { const int m = m0 + r * mstride; if (m < mend) {
        const v4u o0 = ov[r][0], o1 = ov[r][1], g0 = gv4[r][0], g1 = gv4[r][1];
        float ovf[16] = {bflo(o0.x), bfhi(o0.x), bflo(o0.y), bfhi(o0.y), bflo(o0.z), bfhi(o0.z), bflo(o0.w), bfhi(o0.w), bflo(o1.x), bfhi(o1.x), bflo(o1.y), bfhi(o1.y), bflo(o1.z), bfhi(o1.z), bflo(o1.w), bfhi(o1.w)};
        const float gvf[16] = {bflo(g0.x), bfhi(g0.x), bflo(g0.y), bfhi(g0.y), bflo(g0.z), bfhi(g0.z), bflo(g0.w), bfhi(g0.w), bflo(g1.x), bfhi(g1.x), bflo(g1.y), bfhi(g1.y), bflo(g1.z), bfhi(g1.z), bflo(g1.w), bfhi(g1.w)};
        float ss = 0.f;
#pragma unroll
        for (int j = 0; j < 16; ++j) ss += ovf[j] * ovf[j];
        ss += __shfl_xor(ss, 1); ss += __shfl_xor(ss, 2); ss += __shfl_xor(ss, 4); ss += __shfl_xor(ss, 8);
        const float rs = __builtin_amdgcn_rsqf(ss * (1.0f / GDV) + EPS);
#pragma unroll
        for (int j = 0; j < 16; ++j) ovf[j] = ovf[j] * rs * gvf[j];
        v4u w0, w1;
        w0.x = pk2(ovf[0], ovf[1]); w0.y = pk2(ovf[2], ovf[3]); w0.z = pk2(ovf[4], ovf[5]); w0.w = pk2(ovf[6], ovf[7]);
        w1.x = pk2(ovf[8], ovf[9]); w1.y = pk2(ovf[10], ovf[11]); w1.z = pk2(ovf[12], ovf[13]); w1.w = pk2(ovf[14], ovf[15]);
        *(v4u*)(OG + (size_t)m * D + 16 * lane) = w0; *(v4u*)(OG + (size_t)m * D + 16 * lane + 8) = w1; } }
}

template <int K> __device__ __forceinline__ void run_phase(const Args& args, LAS unsigned char* ldsp) {
    Frame F;
    { int t = threadIdx.x; asm volatile("" : "+v"(t)); F.tid = t; }
    F.lds = ldsp; F.lane = F.tid & 63; F.wave = __builtin_amdgcn_readfirstlane(F.tid >> 6);
    F.G = gridDim.x; { const int bx = blockIdx.x; F.vcu = (F.G % 8 == 0) ? (bx % 8) * (F.G / 8) + bx / 8 : bx; }
    F.out = args.out; F.ws = args.ws;
    unsigned char* ws = args.ws;
    const int gw = F.vcu * NWAVES + F.wave, NGW = F.G * NWAVES;
    bf16* XB = (bf16*)(ws + WS_XB); bf16* ACT = (bf16*)(ws + WS_ACT);
    float* X = args.out + O_Y;
    (void)gw; (void)NGW; (void)XB; (void)ACT; (void)X;
    if constexpr (K == 0) { p0_prologue(args, F); }
    if constexpr (K == 1) {
        pg8::Gemm g{XB, XB, (const bf16*)(ws + WS_W1T), D, D, D, 1}; pg8::StaticOrder S; S.init(MP / 256, 2 * FF / 256, 1, F.G, (int)blockIdx.x);
        pg8::EpiSwiglu E{ACT, (const float*)(ws + WS_SSQ0)};
        pg8::gemm_phase<pg8::EpiSwiglu, true>(F.lds, g, S, E);
        sg_swiglu(args, F, (const bf16*)(ws + WS_W1T), (const float*)(ws + WS_SSQ0S));
    }
    if constexpr (K == 2) {
        pg8::Gemm g{ACT, ACT, (const bf16*)(ws + WS_W1OT), FF, FF, FF, 1}; pg8::StaticOrder S; S.init(MP / 256, D / 256, 1, F.G, (int)blockIdx.x);
        pg8::EpiResid<true> E{nullptr, XB, (float*)(ws + WS_SSQA), 0.5f};
        pg8::gemm_phase<pg8::EpiResid<true>, true>(F.lds, g, S, E);
        sg_resid(args, F, ACT, FF, (const bf16*)(ws + WS_W1OT), FF, nullptr, 0.5f, (float*)(ws + WS_SSQAS));
    }
    if constexpr (K == 3) {
        pg8::Gemm g{XB, XB, (const bf16*)(ws + WS_WAT), D, D, D, 1}; pg8::StaticOrder S; S.init(MP / 256, NA / 256, 1, F.G, (int)blockIdx.x);
        pg8::EpiProjA E{(bf16*)(ws + WS_T0), (bf16*)(ws + WS_T1), (bf16*)(ws + WS_T2), (bf16*)(ws + WS_T8), (bf16*)(ws + WS_SKV), (float*)(ws + WS_GLR), args.out, (const float*)(ws + WS_SSQA)};
        pg8::gemm_phase<pg8::EpiProjA, true>(F.lds, g, S, E);
        sg_proj(args, F);
    }
    if constexpr (K == 4) {
#define G1_SEQ(u) ((u) < NB * 64 * GH ? (u) >> 8 : NB + (((u) - NB * 64 * GH) >> 2))
#define G1_CHK(u) ((u) < NB * 64 * GH ? ((u) >> 2) & 63 : 0)
        const int hh = F.vcu & 3, dcol = F.tid & 127;
        float w[16];
#pragma unroll
        for (int r = 0; r < 16; ++r) w[r] = args.in[10][r * 512 + hh * 128 + dcol];
        const float bias = args.in[11][hh * 128 + dcol];
        G1Regs RA, RB;
        int u = F.vcu;
        if (u < NUNIT_G) g1_load(RA, args, G1_SEQ(u), G1_CHK(u), hh, F.tid);
        while (u < NUNIT_G) {
            const int u1 = u + F.G; if (u1 < NUNIT_G) g1_load(RB, args, G1_SEQ(u1), G1_CHK(u1), hh, F.tid);
            g1_compute(RA, w, bias, args, F, G1_SEQ(u), G1_CHK(u), hh);
            if (u1 >= NUNIT_G) break;
            const int u2 = u1 + F.G; if (u2 < NUNIT_G) g1_load(RA, args, G1_SEQ(u2), G1_CHK(u2), hh, F.tid);
            g1_compute(RB, w, bias, args, F, G1_SEQ(u1), G1_CHK(u1), hh);
            u = u2;
        }
#undef G1_SEQ
#undef G1_CHK
    }
    if constexpr (K == 5) {
        const int nh = F.G >> 1;
        constexpr int NSWA_P = NB * 64 * SKV, NSWA_S = NB * SKV;
        if ((F.vcu & 1) == 0) {
            for (int it = F.vcu >> 1; it < NB * GH * 4; it += nh) { g2_item<false>(args, F, it >> 2, it & 3); g2_item<true>(args, F, it >> 2, it & 3); }
        } else {
            for (int us = F.vcu >> 1; us < NSWA_S; us += nh) swa_unit(args, F, NB + (us >> 1), 0, us & 1);
        }
    }
    if constexpr (K == 12) {
        constexpr int NSWA_P = NB * 64 * SKV;
        unsigned* qhead = (unsigned*)(ws + WS_CTL) + 12288;
        volatile LAS unsigned* qslot = (volatile LAS unsigned*)(F.lds + MISC_OFF) + 16;
        unsigned t0 = 0, t1 = 0;
        if (F.tid == 0) { t0 = __hip_atomic_fetch_add(qhead, 1u, __ATOMIC_RELAXED, __HIP_MEMORY_SCOPE_AGENT); t1 = __hip_atomic_fetch_add(qhead, 1u, __ATOMIC_RELAXED, __HIP_MEMORY_SCOPE_AGENT); qslot[0] = t0; qslot[1] = t1; }
        __syncthreads();
        int u = (int)qslot[0], u1 = (int)qslot[1];
        SwaRegs RA, RB;
        if (u < NSWA_P) swa_p_load(RA, args, u, F.tid);
        while (u < NSWA_P) {
            unsigned tn = 0;
            if (F.tid == 0) tn = __hip_atomic_fetch_add(qhead, 1u, __ATOMIC_RELAXED, __HIP_MEMORY_SCOPE_AGENT);
            if (u1 < NSWA_P) swa_p_load(RB, args, u1, F.tid);
            swa_p_compute(RA, args, F, u);
            if (F.tid == 0) qslot[2] = tn;
            LDS_BAR();
            const int u2 = (int)qslot[2];
            if (u1 >= NSWA_P) break;
            if (F.tid == 0) tn = __hip_atomic_fetch_add(qhead, 1u, __ATOMIC_RELAXED, __HIP_MEMORY_SCOPE_AGENT);
            if (u2 < NSWA_P) swa_p_load(RA, args, u2, F.tid);
            swa_p_compute(RB, args, F, u1);
            if (F.tid == 0) qslot[3] = tn;
            LDS_BAR();
            u = u2; u1 = (int)qslot[3];
        }
        if (F.vcu & 1) {
            LDS_BAR();
            LAS float* scr = (LAS float*)(F.lds + F.wave * 16384);
            for (int l = (F.vcu >> 1) * NWAVES + F.wave; l < P0_NLATE; l += (F.G >> 1) * NWAVES) p0_weight_item(args, P0_NEARLY + l, scr, F.lane);
        }
    }
    if constexpr (K == 6) {
        for (int m0 = MP + gw; m0 < M; m0 += 4 * NGW) g3_rows4((bf16*)(ws + WS_T1), (const bf16*)(ws + WS_T8), F.lane, m0, NGW, M);
        __syncthreads();
        pg8::Gemm g{XB, XB, (const bf16*)(ws + WS_WBT), D, D, D, 1}; pg8::StaticOrder S; S.init(MP / 256, NBP / 256, 1, F.G, (int)blockIdx.x);
        pg8::EpiProjB E{(bf16*)(ws + WS_T0), (bf16*)(ws + WS_T7), (const float*)(ws + WS_SSQA)};
        pg8::gemm_phase<pg8::EpiProjB, true>(F.lds, g, S, E);
        sg_gates(args, F);
    }
    if constexpr (K == 7) {
        pg8::Gemm g{(const bf16*)(ws + WS_T1), (const bf16*)(ws + WS_T2), (const bf16*)(ws + WS_WBRT), D, 2 * D, D, 2}; pg8::StaticOrder S; S.init(MP / 256, D / 256, 2, F.G, (int)blockIdx.x);
        { pg8::Unit u0, u1; const bool has0 = S.next(0, u0), has1 = S.next(2, u1);
          if (has0) {
              for (int k = 0; k < 2; ++k) { const int base = u0.pm * 256 + u0.pn * 64 + F.wave * 8 + 4 * k; g3_rows4((bf16*)(ws + WS_T1), (const bf16*)(ws + WS_T8), F.lane, base, 1, base + 4); }
              if (has1) for (int k = 0; k < 2; ++k) { const int base = u1.pm * 256 + u1.pn * 64 + F.wave * 8 + 4 * k; g3_rows4((bf16*)(ws + WS_T1), (const bf16*)(ws + WS_T8), F.lane, base, 1, base + 4); }
              asm volatile("s_waitcnt vmcnt(0)" ::: "memory");
              __syncthreads();
              if (F.tid == 0) {
                  unsigned* cnt = (unsigned*)(ws + WS_CTL) + CW_G3 + CW_PAN_STRIDE * u0.pm;
                  __builtin_amdgcn_fence(__ATOMIC_RELEASE, "agent");
                  asm volatile("s_waitcnt vmcnt(0)" ::: "memory");
                  __hip_atomic_fetch_add(cnt, 1u, __ATOMIC_RELAXED, __HIP_MEMORY_SCOPE_AGENT);
                  unsigned spins = 0;
                  while (__hip_atomic_load(cnt, __ATOMIC_RELAXED, __HIP_MEMORY_SCOPE_AGENT) < 4u) { __builtin_amdgcn_s_sleep(2); if (++spins > (1u << 24)) break; }
                  __builtin_amdgcn_fence(__ATOMIC_ACQUIRE, "agent");
                  asm volatile("s_waitcnt vmcnt(0)" ::: "memory");
              }
              __syncthreads();
          } }
        pg8::EpiBranch E{(const bf16*)(ws + WS_T0), (const bf16*)(ws + WS_T7), (bf16*)(ws + WS_T8)};
        pg8::gemm_phase<pg8::EpiBranch, true>(F.lds, g, S, E);
        sg_branch(args, F);
    }
    if constexpr (K == 8) {
        pg8::Gemm g{(const bf16*)(ws + WS_T8), (const bf16*)(ws + WS_T8), (const bf16*)(ws + WS_WOUTT), D, D, D, 1}; pg8::StaticOrder S; S.init(MP / 256, D / 256, 1, F.G, (int)blockIdx.x);
        pg8::EpiResid<true> E{nullptr, XB, (float*)(ws + WS_SSQB), 1.0f};
        pg8::gemm_phase<pg8::EpiResid<true>, true>(F.lds, g, S, E);
        sg_resid(args, F, (const bf16*)(ws + WS_T8), D, (const bf16*)(ws + WS_WOUTT), D, nullptr, 1.0f, (float*)(ws + WS_SSQBS));
    }
    if constexpr (K == 9) {
        pg8::Gemm g{XB, XB, (const bf16*)(ws + WS_W2T), D, D, D, 1}; pg8::StaticOrder S; S.init(MP / 256, 2 * FF / 256, 1, F.G, (int)blockIdx.x);
        pg8::EpiSwiglu E{ACT, (const float*)(ws + WS_SSQB)};
        pg8::gemm_phase<pg8::EpiSwiglu, true>(F.lds, g, S, E);
        sg_swiglu(args, F, (const bf16*)(ws + WS_W2T), (const float*)(ws + WS_SSQBS));
    }
    if constexpr (K == 10) {
        pg8::Gemm g{ACT, ACT, (const bf16*)(ws + WS_W2OT), FF, FF, FF, 1}; pg8::StaticOrder S; S.init(MP / 256, D / 256, 1, F.G, (int)blockIdx.x);
        pg8::EpiFinal E{XB, X, args.in[20], (unsigned*)(ws + WS_XSLOT), (unsigned*)(ws + WS_CTL) + CW_PAN, 0.5f};
        pg8::gemm_phase<pg8::EpiFinal, true>(F.lds, g, S, E);
        sg_resid(args, F, ACT, FF, (const bf16*)(ws + WS_W2OT), FF, nullptr, 0.5f, nullptr);
    }
    if constexpr (K == 11) {
        const f32x4* gf = (const f32x4*)args.in[20];
        f32x4 g4[4];
#pragma unroll
        for (int q = 0; q < 4; ++q) g4[q] = gf[4 * F.lane + q];
        for (int m0 = MP + gw; m0 < M; m0 += 4 * NGW) {
            v4u xv[4][2];
#pragma unroll
            for (int r = 0; r < 4; ++r) { const int m = m0 + r * NGW; if (m < M) { xv[r][0] = *(const v4u*)(XB + (size_t)m * D + 16 * F.lane); xv[r][1] = *(const v4u*)(XB + (size_t)m * D + 16 * F.lane + 8); } }
#pragma unroll
            for (int r = 0; r < 4; ++r) { const int m = m0 + r * NGW; if (m < M) {
                const v4u x0 = xv[r][0], x1 = xv[r][1];
                float v[16] = {bflo(x0.x), bfhi(x0.x), bflo(x0.y), bfhi(x0.y), bflo(x0.z), bfhi(x0.z), bflo(x0.w), bfhi(x0.w), bflo(x1.x), bfhi(x1.x), bflo(x1.y), bfhi(x1.y), bflo(x1.z), bfhi(x1.z), bflo(x1.w), bfhi(x1.w)};
                float s2 = 0.f;
#pragma unroll
                for (int j = 0; j < 16; ++j) s2 += v[j] * v[j];
                const float rs = __builtin_amdgcn_rsqf(wave_sum(s2) * (1.0f / D) + EPS);
                f32x4* yr = (f32x4*)(X + (size_t)m * D + 16 * F.lane);
#pragma unroll
                for (int q = 0; q < 4; ++q) yr[q] = (f32x4){v[4 * q] * rs * g4[q][0], v[4 * q + 1] * rs * g4[q][1], v[4 * q + 2] * rs * g4[q][2], v[4 * q + 3] * rs * g4[q][3]}; } }
        }
    }
}

#ifndef MK_SEQ
#define MK_SEQ P(0) S P(1) S P(2) S P(3) S P(4) S P(5) P(12) S P(6) S P(7) S P(8) S P(9) S P(10) S P(11)
#endif
__global__ void __launch_bounds__(NWAVES * 64, 2) mk_fwd(Args args) {
    extern __shared__ __attribute__((aligned(16))) unsigned char lds[];
    LAS unsigned char* ldsp = (LAS unsigned char*)lds;
    volatile LAS unsigned* MISC = (volatile LAS unsigned*)(ldsp + MISC_OFF);
    if (threadIdx.x < 32) MISC[threadIdx.x] = 0u;
    __syncthreads();
    XcdBarrier bar = xcd_barrier_post((unsigned*)(args.ws + WS_CTL) + 4096, MISC + 8);
#define P(k) if (args.ph_hi > (k)) run_phase<k>(args, ldsp);
#define S xcd_barrier(bar);
    MK_SEQ
#undef P
#undef S
}

extern "C" void kernel_launch(void* const* d_in, const int* in_sizes, int n_in, void* d_out, int out_size, void* d_ws, size_t ws_size, hipStream_t stream) {
    static int grid = 0;
    if (grid == 0) {
        if (n_in != 21 || in_sizes[0] != MP * D || (size_t)out_size != O_END || ws_size < WS_END) { fprintf(stderr, "kernel_launch: unexpected shapes (n_in %d in0 %d out %d ws %zu need %zu)\n", n_in, n_in > 0 ? in_sizes[0] : -1, out_size, ws_size, (size_t)WS_END); grid = -1; return; }
        int dev = 0, cus = 0, per_cu = 0;
        if (hipGetDevice(&dev) != hipSuccess || hipDeviceGetAttribute(&cus, hipDeviceAttributeMultiprocessorCount, dev) != hipSuccess) { grid = -1; return; }
        if (hipFuncSetAttribute((const void*)mk_fwd, hipFuncAttributeMaxDynamicSharedMemorySize, LDS_BYTES) != hipSuccess) { fprintf(stderr, "kernel_launch: hipFuncSetAttribute failed\n"); grid = -1; return; }
        if (hipOccupancyMaxActiveBlocksPerMultiprocessor(&per_cu, (const void*)mk_fwd, NWAVES * 64, LDS_BYTES) != hipSuccess || per_cu < 1) { fprintf(stderr, "kernel_launch: occupancy query says %d\n", per_cu); per_cu = 1; }
        (void)hipGetLastError();
        grid = cus;
    }
    if (grid < 0) return;
    Args a{};
    for (int i = 0; i < 21; ++i) a.in[i] = (const float*)d_in[i];
    a.out = (float*)d_out; a.ws = (unsigned char*)d_ws;
    if (hipMemsetAsync((char*)d_ws + WS_CTL, 0, 65536, stream) != hipSuccess) { fprintf(stderr, "kernel_launch: memset failed\n"); return; }
    a.ph_lo = 0; a.ph_hi = 13;
    void* kargs[] = {&a};
    hipError_t e = hipLaunchCooperativeKernel((const void*)mk_fwd, dim3(grid), dim3(NWAVES * 64), kargs, LDS_BYTES, stream);
    if (e != hipSuccess) fprintf(stderr, "kernel_launch: cooperative launch failed: %s\n", hipGetErrorString(e));
}
```

```cpp
#include <hip/hip_runtime.h>
#include <hip/hip_cooperative_groups.h>
#include <cstdio>
#include <cstdint>
namespace cg = cooperative_groups;


constexpr int D = 1024, NB = 8, SEQ = 4096, DEC_T = 32;
constexpr int MP = NB * SEQ, MS = NB * DEC_T, M = MP + MS;
constexpr int FF = 2816;
constexpr int GH = 4, GDK = 128, GDV = 256, GRANK = 16;
constexpr int SH = 16, SKV = 2, SHD = 64, WINDOW = 128;
constexpr float EPS = 1e-6f;
constexpr float LOG2E = 1.4426950408889634f;
constexpr int NA = 18 * 256;
constexpr int NBP = 8 * 256;
constexpr int S_GQ = 0, S_GK = 512, S_GV = 1024, S_GR = 2048, S_GLR = 3072, S_SQ = 3088, S_SK = 4112, S_SV = 4240, S_GG = 4368, S_GS = 5392, IN_W = 6416;

constexpr size_t O_Y = 0;
constexpr size_t O_SGP = (size_t)M * D;
constexpr size_t O_CKP = O_SGP + (size_t)NB * GH * GDK * GDV;
constexpr size_t O_CVP = O_CKP + (size_t)NB * WINDOW * SKV * SHD;
constexpr size_t O_SGS = O_CVP + (size_t)NB * WINDOW * SKV * SHD;
constexpr size_t O_CKS = O_SGS + (size_t)NB * GH * GDK * GDV;
constexpr size_t O_CVS = O_CKS + (size_t)NB * WINDOW * SKV * SHD;
constexpr size_t O_END = O_CVS + (size_t)NB * WINDOW * SKV * SHD;

constexpr size_t MiB = 1u << 20;
constexpr size_t R1 = (size_t)M * D * 2;
constexpr size_t WS_CTL = 0;
constexpr size_t WS_W1T = 1 * MiB;
constexpr size_t WS_W1OT = WS_W1T + (size_t)2 * FF * D * 2;
constexpr size_t WS_WAT = WS_W1OT + (size_t)D * FF * 2;
constexpr size_t WS_WBT = WS_WAT + (size_t)NA * D * 2;
constexpr size_t WS_WBRT = WS_WBT + (size_t)NBP * D * 2;
constexpr size_t WS_WOUTT = WS_WBRT + (size_t)D * 2 * D * 2;
constexpr size_t WS_W2T = WS_WOUTT + (size_t)D * D * 2;
constexpr size_t WS_W2OT = WS_W2T + (size_t)2 * FF * D * 2;
constexpr size_t WS_SSQ0 = WS_W2OT + (size_t)D * FF * 2;
constexpr size_t SSQ_BYTES = (size_t)M * 16 * 4;
constexpr size_t WS_SSQA = WS_SSQ0 + SSQ_BYTES;
constexpr size_t WS_SSQB = WS_SSQA + SSQ_BYTES;
constexpr int NUNIT_G = NB * 64 * GH + NB * GH;
constexpr size_t SSQS_BYTES = (size_t)MS * 64 * 4;
constexpr size_t WS_SSQ0S = WS_SSQB + SSQ_BYTES, WS_SSQAS = WS_SSQ0S + SSQS_BYTES, WS_SSQBS = WS_SSQAS + SSQS_BYTES;
constexpr size_t WS_GDEC = WS_SSQBS + SSQS_BYTES;
constexpr size_t WS_XB = (WS_GDEC + (size_t)NUNIT_G * 128 * 4 + 4095) & ~(size_t)4095;
constexpr size_t WS_T0 = WS_XB + R1;
constexpr size_t WS_T1 = WS_T0 + R1;
constexpr size_t WS_T2 = WS_T1 + R1;
constexpr size_t WS_T7 = WS_T2 + R1;
constexpr size_t WS_T8 = WS_T7 + R1;
constexpr size_t WS_SKV = WS_T8 + R1;
constexpr size_t WS_ABUF = WS_SKV + (size_t)M * 256 * 2;
constexpr size_t WS_GLR = WS_ABUF + (size_t)M * 256 * 2;
constexpr size_t WS_XSLOT = (WS_GLR + (size_t)M * 16 * 4 + 4095) & ~(size_t)4095;
constexpr size_t WS_END = WS_XSLOT + (size_t)(MP / 256) * 256 * 4 * 4;
constexpr int CW_PAN = 13312, CW_PAN_STRIDE = 16;
constexpr size_t WS_ACT = WS_T0;
static_assert((size_t)M * FF * 2 <= 5 * R1, "act overlay");
static_assert(WS_END <= 512 * MiB, "workspace map must fit 512 MiB");

constexpr int RING_BYTES = 131072;
constexpr int PHASE_LDS = 155648;
constexpr int MISC_OFF = PHASE_LDS + 320;
constexpr int LDS_BYTES = 159744;
constexpr int NWAVES = 8;

#define GAS __attribute__((address_space(1)))
#define LAS __attribute__((address_space(3)))
typedef unsigned short bf16;
typedef unsigned v4u __attribute__((ext_vector_type(4)));
typedef unsigned v2u __attribute__((ext_vector_type(2)));
typedef float f32x4 __attribute__((ext_vector_type(4)));
typedef float f32x16 __attribute__((ext_vector_type(16)));
typedef short bf16x8 __attribute__((ext_vector_type(8)));
typedef float f32x2_t __attribute__((ext_vector_type(2)));
typedef __bf16 bf16x2_t __attribute__((ext_vector_type(2)));
#define LDS_WAIT() asm volatile("s_waitcnt lgkmcnt(0)" ::: "memory")
#define VM_WAIT() asm volatile("s_waitcnt vmcnt(0)" ::: "memory")
#define LDS_BAR() do { asm volatile("s_waitcnt lgkmcnt(0)" ::: "memory"); __builtin_amdgcn_s_barrier(); asm volatile("" ::: "memory"); } while (0)
__device__ __forceinline__ unsigned pk2(float lo, float hi) { f32x2_t v = {lo, hi}; bf16x2_t b = __builtin_convertvector(v, bf16x2_t); return __builtin_bit_cast(unsigned, b); }
__device__ __forceinline__ unsigned short f2bf(float f) { return (unsigned short)(pk2(f, 0.f) & 0xffffu); }
__device__ __forceinline__ float bf2f(unsigned short b) { return __uint_as_float((unsigned)b << 16); }
__device__ __forceinline__ float bflo(unsigned w) { return __uint_as_float(w << 16); }
__device__ __forceinline__ float bfhi(unsigned w) { return __uint_as_float(w & 0xffff0000u); }
__device__ __forceinline__ float fast_exp2(float x) { return __builtin_amdgcn_exp2f(x); }
__device__ __forceinline__ float fast_exp(float x) { return __builtin_amdgcn_exp2f(x * LOG2E); }
__device__ __forceinline__ float fast_rcp(float x) { return __builtin_amdgcn_rcpf(x); }
__device__ __forceinline__ float sigmoidf_(float x) { return fast_rcp(1.0f + fast_exp(-x)); }
__device__ __forceinline__ float siluf_(float x) { return x * sigmoidf_(x); }
__device__ __forceinline__ float wave_sum(float v) {
#pragma unroll
    for (int o = 1; o < 64; o <<= 1) v += __shfl_xor(v, o);
    return v;
}
__device__ __forceinline__ void rows_rstd(float (&rs)[2][4], const float* ssqp, int row0, int fq) {
    f32x4 q[2][4];
#pragma unroll
    for (int ai = 0; ai < 2; ++ai)
#pragma unroll
        for (int m = 0; m < 4; ++m) q[ai][m] = *(const f32x4*)(ssqp + (size_t)(row0 + ai * 128 + m * 16) * 16 + fq * 4);
#pragma unroll
    for (int ai = 0; ai < 2; ++ai)
#pragma unroll
        for (int m = 0; m < 4; ++m) { float s = (q[ai][m].x + q[ai][m].y) + (q[ai][m].z + q[ai][m].w); s += __shfl_xor(s, 16); s += __shfl_xor(s, 32); rs[ai][m] = __builtin_amdgcn_rsqf(s * (1.0f / D) + EPS); }
}
__device__ __forceinline__ float row_rstd(const float* ssqp, int row) {
    const f32x4* p = (const f32x4*)(ssqp + (size_t)row * 16);
    const f32x4 a = p[0], b = p[1], c = p[2], d = p[3];
    const float s = ((a.x + a.y) + (a.z + a.w)) + ((b.x + b.y) + (b.z + b.w)) + ((c.x + c.y) + (c.z + c.w)) + ((d.x + d.y) + (d.z + d.w));
    return __builtin_amdgcn_rsqf(s * (1.0f / D) + EPS);
}

namespace pg8 {
#define PG8_LAS __attribute__((address_space(3)))
typedef unsigned short bf16_t;
typedef unsigned u32x4 __attribute__((ext_vector_type(4)));
constexpr int BM = 256, BK = 64, HALF = 128, HTB = HALF * BK * 2, STAGE_BYTES = 8 * HTB, NXCD = 8, WGM = 8;
__host__ __device__ __forceinline__ int lds_byte(int r, int c) { const int st = (r >> 4) * 2 + (c >> 5), rr = r & 15, cc = c & 31, ob = rr * 64 + cc * 2; return st * 1024 + (ob ^ (((ob >> 9) & 1) << 5)); }
__host__ __device__ __forceinline__ void stage_rc(int b, int& R, int& C) { const int st = b / 1024, sb = b % 1024, swz = sb ^ (((sb >> 9) & 1) << 5); R = (st >> 1) * 16 + swz / 64; C = (st & 1) * 32 + (swz % 64) / 2; }
__host__ __device__ __forceinline__ int perm32(int rho) { const int n = rho >> 4, i = rho & 15; return 8 * (i >> 2) + 4 * n + (i & 3); }

struct Unit { int pm, pn, sub; };
struct Gemm { const bf16_t* A0; const bf16_t* A1; const bf16_t* Bt; int lda, ldb, K, nsub; };

struct StaticOrder {
    int nM, nN, nwg, G, c, nsub;
    __device__ void init(int nM_, int nN_, int nsub_, int G_, int c_) { nM = nM_; nN = nN_; nwg = nM * nN; G = G_; c = c_; nsub = nsub_; }
    __device__ bool next(int i, Unit& u) const {
        const int ti = i / nsub; u.sub = i - ti * nsub;
        const long L = (long)ti * G + c; if (L >= nwg) return false;
        int wgid = (int)L; { const int q = nwg / NXCD, r = nwg % NXCD, xcd = wgid % NXCD, off = wgid / NXCD; wgid = (xcd < r ? xcd * (q + 1) : r * (q + 1) + (xcd - r) * q) + off; }
        const int nig = WGM * nN, gid = wgid / nig, fm = gid * WGM, gsz = (nM - fm) < WGM ? (nM - fm) : WGM;
        u.pm = fm + ((wgid % nig) % gsz); u.pn = (wgid % nig) / gsz; return true;
    }
};

typedef f32x4 Acc[2][2][4][2];

struct EpiSwiglu {
    static constexpr bool PERM = true, FUSED = false;
    bf16_t* O; const float* ssqp;
    __device__ __forceinline__ bool keep(const Unit&) const { return false; }
    __device__ __forceinline__ void operator()(Acc& acc, const Unit& u, int wr, int wc, int fr, int fq) const {
        const int row0 = u.pm * BM + wr * 64 + fr, col0 = u.pn * HALF + wc * 32 + 8 * fq;
        float rsa[2][4]; rows_rstd(rsa, ssqp, row0, fq);
#pragma unroll
        for (int ai = 0; ai < 2; ++ai)
#pragma unroll
            for (int m = 0; m < 4; ++m) {
                const int row = row0 + ai * HALF + m * 16; const float rs = rsa[ai][m];
                float o[8];
#pragma unroll
                for (int n = 0; n < 2; ++n)
#pragma unroll
                    for (int j = 0; j < 4; ++j) { const float g = acc[ai][0][m][n][j] * rs, up = acc[ai][1][m][n][j] * rs; o[n * 4 + j] = siluf_(g) * up; }
                u32x4 w; w.x = pk2(o[0], o[1]); w.y = pk2(o[2], o[3]); w.z = pk2(o[4], o[5]); w.w = pk2(o[6], o[7]);
                *(u32x4*)(O + (size_t)row * FF + col0) = w;
            }
    }
};
template <bool RES_BF16> struct EpiResid {
    static constexpr bool PERM = true, FUSED = false;
    const float* res_f32; bf16_t* XBo; float* ssqp; float alpha;
    __device__ __forceinline__ bool keep(const Unit&) const { return false; }
    __device__ __forceinline__ void operator()(Acc& acc, const Unit& u, int wr, int wc, int fr, int fq) const {
        const int col0 = u.pn * BM + wc * 32 + 8 * fq;
        const char* rbase = (const char*)XBo + (size_t)u.pm * BM * D * 2; const unsigned loff = (unsigned)((wr * 64 + fr) * D + col0) * 2u;
        u32x4 rb[2][4][2];
        if (RES_BF16) {
#pragma unroll
            for (int ai = 0; ai < 2; ++ai)
#pragma unroll
                for (int m = 0; m < 4; ++m)
#pragma unroll
                    for (int bj = 0; bj < 2; ++bj) rb[ai][m][bj] = *(const u32x4*)(rbase + (size_t)((ai * HALF + m * 16) * D + bj * HALF) * 2 + loff);
        }
#pragma unroll
        for (int ai = 0; ai < 2; ++ai)
#pragma unroll
            for (int m = 0; m < 4; ++m) {
                const int row = u.pm * BM + ai * HALF + wr * 64 + m * 16 + fr;
                float ss = 0.f;
#pragma unroll
                for (int bj = 0; bj < 2; ++bj) {
                    const size_t off = (size_t)row * D + col0 + bj * HALF;
                    f32x4 r0, r1;
                    if (RES_BF16) { const u32x4 q = rb[ai][m][bj]; r0 = (f32x4){bflo(q.x), bfhi(q.x), bflo(q.y), bfhi(q.y)}; r1 = (f32x4){bflo(q.z), bfhi(q.z), bflo(q.w), bfhi(q.w)}; }
                    else { r0 = *(const f32x4*)(res_f32 + off); r1 = *(const f32x4*)(res_f32 + off + 4); }
                    const f32x4 v0 = r0 + acc[ai][bj][m][0] * alpha, v1 = r1 + acc[ai][bj][m][1] * alpha;
                    u32x4 w; w.x = pk2(v0[0], v0[1]); w.y = pk2(v0[2], v0[3]); w.z = pk2(v1[0], v1[1]); w.w = pk2(v1[2], v1[3]);
                    *(u32x4*)((char*)rbase + (size_t)((ai * HALF + m * 16) * D + bj * HALF) * 2 + loff) = w;
                    ss += (v0[0] * v0[0] + v0[1] * v0[1]) + (v0[2] * v0[2] + v0[3] * v0[3]) + (v1[0] * v1[0] + v1[1] * v1[1]) + (v1[2] * v1[2] + v1[3] * v1[3]);
                }
                ss += __shfl_xor(ss, 16); ss += __shfl_xor(ss, 32);
                if (ssqp && fq == 0) ssqp[(size_t)row * 16 + u.pn * 4 + wc] = ss;
                if (!RES_BF16 && (m & 1)) asm volatile("" ::: "memory");
            }
    }
};
struct EpiProjA {
    static constexpr bool PERM = true, FUSED = false;
    bf16_t *QK, *V, *SQ, *GR, *SKVb; float* GLR; float* out; const float* ssqp;
    __device__ __forceinline__ bool keep(const Unit&) const { return false; }
    __device__ __forceinline__ void operator()(Acc& acc, const Unit& u, int wr, int wc, int fr, int fq) const {
        const int pn = u.pn;
        bf16_t* dst; int ld = D, cbase; float scale = 1.f; int mode = 0;
        if (pn < 4) { dst = QK; cbase = pn * BM; if (pn < 2) scale = 0.08838834764831845f; }
        else if (pn < 8) { dst = V; cbase = (pn - 4) * BM; }
        else if (pn < 12) { dst = SQ; cbase = (pn - 8) * BM; scale = 0.125f * LOG2E; }
        else if (pn < 16) { dst = GR; cbase = (pn - 12) * BM; mode = 1; }
        else if (pn == 16) { dst = SKVb; ld = 256; cbase = 0; mode = 2; }
        else { dst = SKVb; cbase = 0; mode = 3; }
        float rsa[2][4]; rows_rstd(rsa, ssqp, u.pm * BM + wr * 64 + fr, fq);
#pragma unroll
        for (int ai = 0; ai < 2; ++ai)
#pragma unroll
            for (int m = 0; m < 4; ++m) {
                const int row = u.pm * BM + ai * HALF + wr * 64 + m * 16 + fr; const float rs = rsa[ai][m] * scale;
#pragma unroll
                for (int bj = 0; bj < 2; ++bj) {
                    const int within = bj * HALF + wc * 32 + 8 * fq;
                    f32x4 v0 = acc[ai][bj][m][0] * rs, v1 = acc[ai][bj][m][1] * rs;
                    if (mode == 3) { if (within < GRANK) { *(f32x4*)(GLR + (size_t)row * 16 + within) = v0; *(f32x4*)(GLR + (size_t)row * 16 + within + 4) = v1; } continue; }
                    if (mode == 1) {
#pragma unroll
                        for (int j = 0; j < 4; ++j) { v0[j] = siluf_(v0[j]); v1[j] = siluf_(v1[j]); }
                    }
                    u32x4 w; w.x = pk2(v0[0], v0[1]); w.y = pk2(v0[2], v0[3]); w.z = pk2(v1[0], v1[1]); w.w = pk2(v1[2], v1[3]);
                    *(u32x4*)(dst + (size_t)row * ld + cbase + within) = w;
                    if (mode == 2) {
                        float* cp = nullptr;
                        if (u.pm >= MP / BM) { const int rs_ = row - MP, bs = rs_ >> 5, t = rs_ & 31; cp = out + (bj == 0 ? O_CKS : O_CVS) + ((size_t)(bs * WINDOW + 96 + t)) * 128 + (within & 127); }
                        else if ((u.pm & 15) == 15 && ai == 1) { const int b = row >> 12, t = row & 4095; cp = out + (bj == 0 ? O_CKP : O_CVP) + ((size_t)(b * WINDOW + (t - (SEQ - WINDOW)))) * 128 + (within & 127); }
                        if (cp) { *(f32x4*)cp = v0; *(f32x4*)(cp + 4) = v1; }
                    }
                }
            }
    }
};
struct EpiProjB {
    static constexpr bool PERM = true, FUSED = false;
    bf16_t *R, *SS; const float* ssqp;
    __device__ __forceinline__ bool keep(const Unit&) const { return false; }
    __device__ __forceinline__ void operator()(Acc& acc, const Unit& u, int wr, int wc, int fr, int fq) const {
        const int row0 = u.pm * BM + wr * 64 + fr, col0 = u.pn * HALF + wc * 32 + 8 * fq;
        float rsa[2][4]; rows_rstd(rsa, ssqp, row0, fq);
#pragma unroll
        for (int ai = 0; ai < 2; ++ai)
#pragma unroll
            for (int m = 0; m < 4; ++m) {
                const int row = row0 + ai * HALF + m * 16; const float rs = rsa[ai][m];
                float r[8], ss[8];
#pragma unroll
                for (int n = 0; n < 2; ++n)
#pragma unroll
                    for (int j = 0; j < 4; ++j) { const float eg = fast_exp(-acc[ai][0][m][n][j] * rs), es = fast_exp(-acc[ai][1][m][n][j] * rs);
                        ss[n * 4 + j] = fast_rcp(1.0f + es); r[n * 4 + j] = (1.0f + es) * fast_rcp(1.0f + eg); }
                u32x4 w; w.x = pk2(r[0], r[1]); w.y = pk2(r[2], r[3]); w.z = pk2(r[4], r[5]); w.w = pk2(r[6], r[7]);
                *(u32x4*)(R + (size_t)row * D + col0) = w;
                w.x = pk2(ss[0], ss[1]); w.y = pk2(ss[2], ss[3]); w.z = pk2(ss[4], ss[5]); w.w = pk2(ss[6], ss[7]);
                *(u32x4*)(SS + (size_t)row * D + col0) = w;
            }
    }
};
struct EpiBranch {
    static constexpr bool PERM = true, FUSED = false;
    const bf16_t *R, *SS; bf16_t* O;
    __device__ __forceinline__ bool keep(const Unit& u) const { return u.sub == 0; }
    __device__ __forceinline__ void operator()(Acc& acc, const Unit& u, int wr, int wc, int fr, int fq) const {
        const int col0 = u.pn * BM + wc * 32 + 8 * fq;
        const bf16_t* G = u.sub == 0 ? R : SS;
        const size_t tbase = (size_t)u.pm * BM * D * 2; const unsigned loff = (unsigned)((wr * 64 + fr) * D + col0) * 2u;
        const char* gbase = (const char*)G + tbase; char* obase = (char*)O + tbase;
        u32x4 gq[2][4][2];
#pragma unroll
        for (int ai = 0; ai < 2; ++ai)
#pragma unroll
            for (int m = 0; m < 4; ++m)
#pragma unroll
                for (int bj = 0; bj < 2; ++bj) gq[ai][m][bj] = *(const u32x4*)(gbase + (size_t)((ai * HALF + m * 16) * D + bj * HALF) * 2 + loff);
#pragma unroll
        for (int ai = 0; ai < 2; ++ai)
#pragma unroll
            for (int m = 0; m < 4; ++m) {
#pragma unroll
                for (int bj = 0; bj < 2; ++bj) {
                    const u32x4 s = gq[ai][m][bj];
                    const float gv[8] = {bflo(s.x), bfhi(s.x), bflo(s.y), bfhi(s.y), bflo(s.z), bfhi(s.z), bflo(s.w), bfhi(s.w)};
                    if (u.sub == 0) {
#pragma unroll
                        for (int j = 0; j < 4; ++j) { acc[ai][bj][m][0][j] *= gv[j]; acc[ai][bj][m][1][j] *= gv[4 + j]; }
                    } else {
                        float o[8];
#pragma unroll
                        for (int j = 0; j < 4; ++j) { o[j] = acc[ai][bj][m][0][j] * gv[j]; o[4 + j] = acc[ai][bj][m][1][j] * gv[4 + j]; }
                        u32x4 w; w.x = pk2(o[0], o[1]); w.y = pk2(o[2], o[3]); w.z = pk2(o[4], o[5]); w.w = pk2(o[6], o[7]);
                        *(u32x4*)(obase + (size_t)((ai * HALF + m * 16) * D + bj * HALF) * 2 + loff) = w;
                    }
                }
            }
    }
};
constexpr int EX_OFF = 131072;
struct EpiFinal {
    static constexpr bool PERM = true, FUSED = true;
    const bf16_t* XBr; float* Y; const float* gfin; unsigned* xslot; unsigned* cnt; float alpha;
    __device__ __forceinline__ bool keep(const Unit&) const { return false; }
    __device__ __forceinline__ void fused(Acc& acc, const Unit& u, int wr, int wc, int fr, int fq, PG8_LAS unsigned char* lds, int wid, int lane) const {
        PG8_LAS float* P = (PG8_LAS float*)(lds + EX_OFF); PG8_LAS float* Sx = (PG8_LAS float*)(lds + EX_OFF + 4096);
        const int col0 = u.pn * BM + wc * 32 + 8 * fq;
        const char* rbase = (const char*)XBr + (size_t)u.pm * BM * D * 2; const unsigned loff = (unsigned)((wr * 64 + fr) * D + col0) * 2u;
        u32x4 rq[2][4][2];
#pragma unroll
        for (int ai = 0; ai < 2; ++ai)
#pragma unroll
            for (int m = 0; m < 4; ++m)
#pragma unroll
                for (int bj = 0; bj < 2; ++bj) rq[ai][m][bj] = *(const u32x4*)(rbase + (size_t)((ai * HALF + m * 16) * D + bj * HALF) * 2 + loff);
#pragma unroll
        for (int ai = 0; ai < 2; ++ai)
#pragma unroll
            for (int m = 0; m < 4; ++m) {
                const int lr = ai * HALF + wr * 64 + m * 16 + fr;
                float ss = 0.f;
#pragma unroll
                for (int bj = 0; bj < 2; ++bj) {
                    const u32x4 rb = rq[ai][m][bj];
                    const f32x4 r0 = {bflo(rb.x), bfhi(rb.x), bflo(rb.y), bfhi(rb.y)}, r1 = {bflo(rb.z), bfhi(rb.z), bflo(rb.w), bfhi(rb.w)};
                    const f32x4 v0 = r0 + acc[ai][bj][m][0] * alpha, v1 = r1 + acc[ai][bj][m][1] * alpha;
                    acc[ai][bj][m][0] = v0; acc[ai][bj][m][1] = v1;
                    ss += (v0[0] * v0[0] + v0[1] * v0[1]) + (v0[2] * v0[2] + v0[3] * v0[3]) + (v1[0] * v1[0] + v1[1] * v1[1]) + (v1[2] * v1[2] + v1[3] * v1[3]);
                }
                ss += __shfl_xor(ss, 16); ss += __shfl_xor(ss, 32);
                if (fq == 0) P[lr * 4 + wc] = ss;
            }
        asm volatile("s_waitcnt lgkmcnt(0)" ::: "memory"); __builtin_amdgcn_s_barrier(); asm volatile("" ::: "memory");
        const int row = wid * 32 + (lane & 31);
        if (lane < 32) {
            const float s4 = (P[row * 4 + 0] + P[row * 4 + 1]) + (P[row * 4 + 2] + P[row * 4 + 3]);
            __hip_atomic_store(xslot + ((size_t)(u.pm * BM + row) * 4 + u.pn), __float_as_uint(s4), __ATOMIC_RELAXED, __HIP_MEMORY_SCOPE_AGENT);
        }
        asm volatile("s_waitcnt vmcnt(0)" ::: "memory");
        if (lane == 0) __hip_atomic_fetch_add(cnt + CW_PAN_STRIDE * u.pm, 1u, __ATOMIC_RELAXED, __HIP_MEMORY_SCOPE_AGENT);
        if (wid == 0) {
            unsigned spins = 0;
            while ((unsigned)__builtin_amdgcn_readfirstlane((int)__hip_atomic_load(cnt + CW_PAN_STRIDE * u.pm, __ATOMIC_RELAXED, __HIP_MEMORY_SCOPE_AGENT)) < 32u) { __builtin_amdgcn_s_sleep(2); if (++spins > (1u << 24)) break; }
            __builtin_amdgcn_fence(__ATOMIC_ACQUIRE, "agent");
        }
        asm volatile("s_waitcnt vmcnt(0) lgkmcnt(0)" ::: "memory"); __builtin_amdgcn_s_barrier(); asm volatile("" ::: "memory");
        if (lane < 32) {
            const unsigned* sl = xslot + (size_t)(u.pm * BM + row) * 4; float t = 0.f;
#pragma unroll
            for (int q = 0; q < 4; ++q) t += __uint_as_float(__hip_atomic_load(sl + q, __ATOMIC_RELAXED, __HIP_MEMORY_SCOPE_AGENT));
            Sx[row] = __builtin_amdgcn_rsqf(t * (1.0f / D) + EPS);
        }
        asm volatile("s_waitcnt lgkmcnt(0)" ::: "memory"); __builtin_amdgcn_s_barrier(); asm volatile("" ::: "memory");
        f32x4 gv[2][2];
#pragma unroll
        for (int bj = 0; bj < 2; ++bj) { gv[bj][0] = *(const f32x4*)(gfin + col0 + bj * HALF); gv[bj][1] = *(const f32x4*)(gfin + col0 + bj * HALF + 4); }
#pragma unroll
        for (int ai = 0; ai < 2; ++ai)
#pragma unroll
            for (int m = 0; m < 4; ++m) {
                const int lr = ai * HALF + wr * 64 + m * 16 + fr; const size_t grow = (size_t)(u.pm * BM + lr) * D; const float rs = Sx[lr];
#pragma unroll
                for (int bj = 0; bj < 2; ++bj) {
                    *(f32x4*)(Y + grow + col0 + bj * HALF) = acc[ai][bj][m][0] * rs * gv[bj][0];
                    *(f32x4*)(Y + grow + col0 + bj * HALF + 4) = acc[ai][bj][m][1] * rs * gv[bj][1];
                }
            }
    }
};

template <class Epi, bool ALIGN_EPI>
__device__ __forceinline__ void gemm_phase(PG8_LAS unsigned char* lds, const Gemm g, const StaticOrder& S, const Epi& E) {
    const int tid = threadIdx.x, wid = __builtin_amdgcn_readfirstlane(tid >> 6), lane = tid & 63, wr = wid >> 2, wc = wid & 3, fr = lane & 15, fq = lane >> 4;
    const int K = g.K, nt = K / BK;
    unsigned voffA[2], voffB[2];
#pragma unroll
    for (int i = 0; i < 2; ++i) { int R, C; stage_rc(tid * 16 + i * 8192, R, C); const int Rb = Epi::PERM ? ((R & ~31) + perm32(R & 31)) : R;
        voffA[i] = (unsigned)(R * g.lda + C) * 2u; voffB[i] = (unsigned)(Rb * g.ldb + C) * 2u; }
    const size_t kstep = (size_t)(BK * 2);
    const size_t hstepA = (size_t)HALF * g.lda * 2, hstepB = (size_t)HALF * g.ldb * 2;
    const size_t tstepA = 2 * hstepA, tstepB = 2 * hstepB;
    const unsigned ldsw = (unsigned)wid * 1024u;
    const int aoff = lds_byte(wr * 64 + fr, fq * 8), boff = lds_byte(wc * 32 + fr, fq * 8);
#define PG8_SA(b, h) (((b) * 2 + (h)) * HTB)
#define PG8_SB(b, h) ((4 + (b) * 2 + (h)) * HTB)
#define PG8_STAGE(bufoff, gbase, voff) do { _Pragma("unroll") for (int _i = 0; _i < 2; ++_i) \
        __builtin_amdgcn_global_load_lds((const unsigned*)((const char*)(gbase) + (voff)[_i]), (PG8_LAS unsigned*)(lds + (bufoff) + ldsw + _i * 8192), 16, 0, 0); } while (0)
#define PG8_LDA(dst, b, h) do { _Pragma("unroll") for (int m = 0; m < 4; ++m) _Pragma("unroll") for (int k = 0; k < 2; ++k) dst[m][k] = *(const PG8_LAS bf16x8*)(lds + PG8_SA(b, h) + aoff + m * 2048 + k * 1024); } while (0)
#define PG8_LDB(dst, b, h) do { _Pragma("unroll") for (int n = 0; n < 2; ++n) _Pragma("unroll") for (int k = 0; k < 2; ++k) dst[n][k] = *(const PG8_LAS bf16x8*)(lds + PG8_SB(b, h) + boff + n * 2048 + k * 1024); } while (0)
#define PG8_MMA(ai, bj, At, Bt) do { __builtin_amdgcn_s_setprio(1); _Pragma("unroll") for (int m = 0; m < 4; ++m) _Pragma("unroll") for (int n = 0; n < 2; ++n) _Pragma("unroll") for (int k = 0; k < 2; ++k) \
        acc[ai][bj][m][n] = __builtin_amdgcn_mfma_f32_16x16x32_bf16(Bt[n][k], At[m][k], acc[ai][bj][m][n], 0, 0, 0); __builtin_amdgcn_s_setprio(0); } while (0)
#define PG8_WAIT_V(n) asm volatile("s_waitcnt vmcnt(" #n ")" ::: "memory")
#define PG8_WAIT_L(n) asm volatile("s_waitcnt lgkmcnt(" #n ")" ::: "memory")
#define PG8_BAR __builtin_amdgcn_s_barrier()
#define PG8_SCHED __builtin_amdgcn_sched_barrier(0)
#define PG8_ABASE(u) ((const char*)((u).sub ? g.A1 : g.A0) + (size_t)(u).pm * tstepA)
#define PG8_BBASE(u) ((const char*)g.Bt + (size_t)(u).pn * tstepB + (size_t)(u).sub * K * 2)
    Unit cur, nxt; int ui = 0;
    if (!S.next(0, cur)) return;
    Acc acc;
#pragma unroll
    for (int a = 0; a < 2; ++a)
#pragma unroll
        for (int b = 0; b < 2; ++b)
#pragma unroll
            for (int m = 0; m < 4; ++m)
#pragma unroll
                for (int n = 0; n < 2; ++n) acc[a][b][m][n] = (f32x4){0.f, 0.f, 0.f, 0.f};
    bf16x8 At[4][2], B0[2][2], B1[2][2];
    const char* cA = PG8_ABASE(cur); const char* cB = PG8_BBASE(cur);
    PG8_STAGE(PG8_SB(0, 0), cB, voffB); PG8_STAGE(PG8_SB(0, 1), cB + hstepB, voffB); PG8_STAGE(PG8_SA(0, 0), cA, voffA); PG8_STAGE(PG8_SA(0, 1), cA + hstepA, voffA);
    if (wr == 1) PG8_BAR;
    PG8_WAIT_V(2); PG8_BAR;
    PG8_STAGE(PG8_SB(1, 0), cB + kstep, voffB); PG8_STAGE(PG8_SA(1, 0), cA + kstep, voffA); PG8_STAGE(PG8_SB(1, 1), cB + hstepB + kstep, voffB);
    PG8_WAIT_V(6); PG8_BAR;
    for (;;) {
        const bool has_next = S.next(ui + 1, nxt);
        const char* nA = has_next ? PG8_ABASE(nxt) : cA; const char* nB = has_next ? PG8_BBASE(nxt) : cB;
        for (int t = 0; t < nt; t += 2) {
            const bool last = (t == nt - 2);
            const char* a1 = cA + (size_t)(t + 1) * kstep;
            const char* a2 = last ? nA : cA + (size_t)(t + 2) * kstep; const char* b2 = last ? nB : cB + (size_t)(t + 2) * kstep;
            const char* a3 = a2 + kstep; const char* b3 = b2 + kstep;
            PG8_LDB(B0, 0, 0); PG8_LDB(B1, 0, 1); PG8_SCHED; PG8_LDA(At, 0, 0); PG8_STAGE(PG8_SA(1, 1), a1 + hstepA, voffA);
            PG8_WAIT_V(8); PG8_WAIT_L(0); PG8_BAR; PG8_MMA(0, 0, At, B0); PG8_MMA(0, 1, At, B1); PG8_BAR; PG8_SCHED;
            PG8_LDA(At, 0, 1); PG8_STAGE(PG8_SB(0, 0), b2, voffB); PG8_STAGE(PG8_SB(0, 1), b2 + hstepB, voffB); PG8_STAGE(PG8_SA(0, 0), a2, voffA);
            PG8_WAIT_V(8); PG8_WAIT_L(0); PG8_BAR; PG8_MMA(1, 0, At, B0); PG8_MMA(1, 1, At, B1); PG8_BAR; PG8_SCHED;
            PG8_LDB(B0, 1, 0); PG8_LDB(B1, 1, 1); PG8_SCHED; PG8_LDA(At, 1, 0); PG8_STAGE(PG8_SA(0, 1), a2 + hstepA, voffA);
            PG8_WAIT_V(8); PG8_WAIT_L(0); PG8_BAR; PG8_MMA(0, 0, At, B0); PG8_MMA(0, 1, At, B1); PG8_BAR; PG8_SCHED;
            PG8_LDA(At, 1, 1); PG8_STAGE(PG8_SB(1, 0), b3, voffB); PG8_STAGE(PG8_SB(1, 1), b3 + hstepB, voffB); PG8_STAGE(PG8_SA(1, 0), a3, voffA);
            PG8_WAIT_V(8); PG8_WAIT_L(0); PG8_BAR; PG8_MMA(1, 0, At, B0); PG8_MMA(1, 1, At, B1); PG8_BAR; PG8_SCHED;
        }
        if constexpr (ALIGN_EPI) { if (wr == 0) PG8_BAR; }
        if constexpr (Epi::FUSED) E.fused(acc, cur, wr, wc, fr, fq, lds, wid, lane); else E(acc, cur, wr, wc, fr, fq);
        if (!has_next) break;
        if (!E.keep(cur)) {
#pragma unroll
            for (int a = 0; a < 2; ++a)
#pragma unroll
                for (int b = 0; b < 2; ++b)
#pragma unroll
                    for (int m = 0; m < 4; ++m)
#pragma unroll
                        for (int n = 0; n < 2; ++n) acc[a][b][m][n] = (f32x4){0.f, 0.f, 0.f, 0.f};
        }
        cur = nxt; cA = nA; cB = nB; ++ui;
        if constexpr (ALIGN_EPI) { if (wr == 1) PG8_BAR; }
    }
    PG8_WAIT_V(0);
    if constexpr (!ALIGN_EPI) { if (wr == 0) PG8_BAR; }
    PG8_BAR;
#undef PG8_SA
#undef PG8_SB
#undef PG8_STAGE
#undef PG8_LDA
#undef PG8_LDB
#undef PG8_MMA
#undef PG8_WAIT_V
#undef PG8_WAIT_L
#undef PG8_BAR
#undef PG8_SCHED
#undef PG8_ABASE
#undef PG8_BBASE
}
}


#define XB_TMO      128
#define XB_XCNT(j)  (256  + 64 * (j))
#define XB_XSUB(j)  (1280 + 64 * (j))
#define XB_XGEN(j)  (2304 + 64 * (j))
#define XB_TOP      3328
#define XB_TOPGEN   3392
#define XCD_BAR_WORDS 3456
#define XB_SPIN_CAP (1u << 22)
__device__ __forceinline__ unsigned xb_ld(unsigned* p)              { return __hip_atomic_load(p, __ATOMIC_RELAXED, __HIP_MEMORY_SCOPE_AGENT); }
__device__ __forceinline__ unsigned xb_add(unsigned* p, unsigned v) { return __hip_atomic_fetch_add(p, v, __ATOMIC_RELAXED, __HIP_MEMORY_SCOPE_AGENT); }
__device__ __forceinline__ unsigned xb_xcc_id() { return (unsigned)__builtin_amdgcn_s_getreg((3 << 11) | 20) & 0xFu; }
#define XB_SPIN(cond, bar) do { unsigned _sp = 0; while (cond) { __builtin_amdgcn_s_sleep(1); \
    if ((++_sp & 255u) == 0u) { if (xb_ld(&(bar)[XB_TMO])) break; if (_sp > XB_SPIN_CAP) { atomicAdd(&(bar)[XB_TMO], 1u); break; } } } } while (0)
struct XcdBarrier { unsigned* bar; unsigned x; volatile LAS unsigned* st; };
__device__ __forceinline__ XcdBarrier xcd_barrier_post(unsigned* bar, volatile LAS unsigned* st) {
    XcdBarrier b; b.bar = bar; b.x = xb_xcc_id(); b.st = st;
    if (threadIdx.x == 0) (void)xb_add(&bar[XB_XCNT(b.x)], 1u);
    return b;
}
__device__ __forceinline__ void xcd_barrier_complete(unsigned* bar, unsigned x, unsigned& nloc, unsigned& nx) {
    const unsigned G = gridDim.x * gridDim.y * gridDim.z;
    unsigned sum, cnt, mine, sp = 0u;
    for (;;) {
        sum = 0u; cnt = 0u; mine = 0u;
#pragma unroll
        for (unsigned j = 0; j < 16; ++j) { const unsigned c = xb_ld(&bar[XB_XCNT(j)]); sum += c; cnt += (c > 0u) ? 1u : 0u; mine = (j == x) ? c : mine; }
        if (sum == G) break;
        __builtin_amdgcn_s_sleep(1);
        if ((++sp & 255u) == 0u) { if (xb_ld(&bar[XB_TMO])) break; if (sp > XB_SPIN_CAP) { atomicAdd(&bar[XB_TMO], 1u); break; } }
    }
    nloc = mine > 0u ? mine : 1u; nx = cnt > 0u ? cnt : 1u;
}
__device__ __forceinline__ void xcd_barrier(const XcdBarrier& b) {
    asm volatile("s_waitcnt vmcnt(0)" ::: "memory");
    __syncthreads();
    if (threadIdx.x == 0) {
        unsigned* bar = b.bar;
        __builtin_amdgcn_s_waitcnt(0);
        unsigned nloc = b.st[0], nx = b.st[1];
        if (nloc == 0u) { xcd_barrier_complete(bar, b.x, nloc, nx); b.st[0] = nloc; b.st[1] = nx; }
        const unsigned old = xb_add(&bar[XB_XSUB(b.x)], 1u);
        const unsigned gen = old / nloc;
        if (old + 1u == (gen + 1u) * nloc) {
            __builtin_amdgcn_fence(__ATOMIC_RELEASE, "agent");
            asm volatile("s_waitcnt vmcnt(0)" ::: "memory");
            const unsigned og = xb_add(&bar[XB_TOP], 1u);
            const unsigned target = (og / nx + 1u) * nx;
            if (og + 1u != target) XB_SPIN(xb_ld(&bar[XB_TOP]) < target, bar);
            xb_add(&bar[XB_XGEN(b.x)], 1u);
            __builtin_amdgcn_fence(__ATOMIC_ACQUIRE, "agent");
            asm volatile("s_waitcnt vmcnt(0)" ::: "memory");
        } else {
            XB_SPIN(xb_ld(&bar[XB_XGEN(b.x)]) == gen, bar);
            __builtin_amdgcn_fence(__ATOMIC_ACQUIRE, "agent");
            asm volatile("s_waitcnt vmcnt(0)" ::: "memory");
        }
    }
    __syncthreads();
}

struct Args { const float* in[21]; float* out; unsigned char* ws; int ph_lo, ph_hi; };
struct Frame {
    LAS unsigned char* lds;
    int tid, lane, wave, vcu, G;
    const float* const* in_unused;
    float* out; unsigned char* ws;
};

__device__ __forceinline__ void p0_item(const float* W, int N, int scol0, int nvalid, const float* gain, int gmask, bf16* WT, int ldk, int koff, int drow0, int k0, LAS float* scr, int lane) {
    const bool al16 = ((scol0 & 3) == 0) && ((N & 3) == 0) && nvalid == 32;
    if (al16) {
        f32x4 v[8];
#pragma unroll
        for (int i = 0; i < 8; ++i) { const int p_ = lane + 64 * i; v[i] = *(const f32x4*)(W + (size_t)(k0 + (p_ >> 3)) * N + scol0 + (p_ & 7) * 4); }
#pragma unroll
        for (int i = 0; i < 8; ++i) { const int p_ = lane + 64 * i, kk = p_ >> 3, c = (p_ & 7) * 4; const float g = gain ? gain[(k0 + kk) & gmask] : 1.0f;
            scr[kk * 33 + c] = v[i][0] * g; scr[kk * 33 + c + 1] = v[i][1] * g; scr[kk * 33 + c + 2] = v[i][2] * g; scr[kk * 33 + c + 3] = v[i][3] * g; }
    } else {
        float v[32];
#pragma unroll
        for (int i = 0; i < 32; ++i) { const int kk = 2 * i + (lane >> 5), c = lane & 31; v[i] = 0.f; if (c < nvalid) v[i] = W[(size_t)(k0 + kk) * N + scol0 + c]; }
#pragma unroll
        for (int i = 0; i < 32; ++i) { const int kk = 2 * i + (lane >> 5), c = lane & 31; scr[kk * 33 + c] = (gain && c < nvalid) ? v[i] * gain[(k0 + kk) & gmask] : v[i]; }
    }
    LDS_WAIT(); asm volatile("" ::: "memory");
    const int c8 = lane & 7;
#pragma unroll
    for (int j = 0; j < 4; ++j) { const int n = (lane >> 3) + 8 * j; const LAS float* s = scr + (8 * c8) * 33 + n;
        v4u o; o.x = pk2(s[0 * 33], s[1 * 33]); o.y = pk2(s[2 * 33], s[3 * 33]); o.z = pk2(s[4 * 33], s[5 * 33]); o.w = pk2(s[6 * 33], s[7 * 33]);
        *(v4u*)(WT + (size_t)(drow0 + n) * ldk + koff + k0 + 8 * c8) = o; }
    LDS_WAIT(); asm volatile("" ::: "memory");
}
__device__ __forceinline__ int map_ffn_in(int blk) { const int tile = blk >> 3, w = blk & 7; return w < 4 ? tile * 128 + w * 32 : FF + tile * 128 + (w - 4) * 32; }
__device__ __forceinline__ int map_proj_a(int blk, int& nvalid) {
    nvalid = 32;
    if (blk < 16) return S_GQ + 32 * blk;
    if (blk < 32) return S_GK + 32 * (blk - 16);
    if (blk < 64) return S_GV + 32 * (blk - 32);
    if (blk < 96) return S_SQ + 32 * (blk - 64);
    if (blk < 128) return S_GR + 32 * (blk - 96);
    if (blk < 132) return S_SK + 32 * (blk - 128);
    if (blk < 136) return S_SV + 32 * (blk - 132);
    if (blk == 136) { nvalid = GRANK; return S_GLR; }
    nvalid = 0; return 0;
}
__device__ __forceinline__ int map_proj_b(int blk) { const int tile = blk >> 3, w = blk & 7; return w < 4 ? S_GG + tile * 128 + w * 32 : S_GS + tile * 128 + (w - 4) * 32; }


constexpr int P0_I1 = (D / 64) * 176, P0_I1O = (FF / 64) * 32, P0_IA = (D / 64) * 144, P0_IB = (D / 64) * 64, P0_IBR = (D / 64) * 32, P0_IO = (D / 64) * 32;
constexpr int P0_NEARLY = P0_I1 + P0_I1O + P0_IA, P0_NLATE = P0_I1 + P0_I1O + P0_IB + 2 * P0_IBR + P0_IO;
__device__ __forceinline__ void p0_weight_item(const Args& a, int idx, LAS float* scr, int lane) {
    unsigned char* ws = a.ws;
    int r;
    if (idx < P0_NEARLY) {
        r = idx;
        if (r < P0_I1) { const int kb = r / 176, blk = r % 176; p0_item(a.in[6], 2 * FF, map_ffn_in(blk), 32, a.in[5], 1023, (bf16*)(ws + WS_W1T), D, 0, blk * 32, kb * 64, scr, lane); return; }
        r -= P0_I1;
        if (r < P0_I1O) { const int kb = r / 32, blk = r % 32; p0_item(a.in[7], D, blk * 32, 32, nullptr, 0, (bf16*)(ws + WS_W1OT), FF, 0, blk * 32, kb * 64, scr, lane); return; }
        r -= P0_I1O;
        { const int kb = r / 144, blk = r % 144; int nv; const int sc = map_proj_a(blk, nv); p0_item(a.in[9], IN_W, sc, nv, a.in[8], 1023, (bf16*)(ws + WS_WAT), D, 0, blk * 32, kb * 64, scr, lane); return; }
    }
    r = idx - P0_NEARLY;
    if (r < P0_I1) { const int kb = r / 176, blk = r % 176; p0_item(a.in[18], 2 * FF, map_ffn_in(blk), 32, a.in[17], 1023, (bf16*)(ws + WS_W2T), D, 0, blk * 32, kb * 64, scr, lane); return; }
    r -= P0_I1;
    if (r < P0_I1O) { const int kb = r / 32, blk = r % 32; p0_item(a.in[19], D, blk * 32, 32, nullptr, 0, (bf16*)(ws + WS_W2OT), FF, 0, blk * 32, kb * 64, scr, lane); return; }
    r -= P0_I1O;
    if (r < P0_IB) { const int kb = r / 64, blk = r % 64; p0_item(a.in[9], IN_W, map_proj_b(blk), 32, a.in[8], 1023, (bf16*)(ws + WS_WBT), D, 0, blk * 32, kb * 64, scr, lane); return; }
    r -= P0_IB;
    if (r < 2 * P0_IBR) { const int which = r / P0_IBR; r -= which * P0_IBR; const int kb = r / 32, blk = r % 32;
        p0_item(a.in[which ? 15 : 14], D, blk * 32, 32, which ? nullptr : a.in[12], 255, (bf16*)(ws + WS_WBRT), 2 * D, which * D, blk * 32, kb * 64, scr, lane); return; }
    r -= 2 * P0_IBR;
    { const int kb = r / 32, blk = r % 32; p0_item(a.in[16], D, blk * 32, 32, nullptr, 0, (bf16*)(ws + WS_WOUTT), D, 0, blk * 32, kb * 64, scr, lane); }
}
__device__ __forceinline__ void p0_prologue(const Args& a, Frame& F) {
    LAS float* scr = (LAS float*)(F.lds + F.wave * 16384);
    const int gw = F.vcu * NWAVES + F.wave, NGW = F.G * NWAVES;
    unsigned char* ws = a.ws;
    for (int it = gw; it < P0_NEARLY; it += NGW) p0_weight_item(a, it, scr, F.lane);
    bf16* XB = (bf16*)(ws + WS_XB); float* ssq0 = (float*)(ws + WS_SSQ0);
    for (int m0 = gw; m0 < M; m0 += 4 * NGW) {
        f32x4 v[4][4];
#pragma unroll
        for (int r = 0; r < 4; ++r) { const int m = m0 + r * NGW;
            if (m < M) { const f32x4* xr = (const f32x4*)(m < MP ? a.in[0] + (size_t)m * D : a.in[1] + (size_t)(m - MP) * D) + F.lane;
#pragma unroll
                for (int j = 0; j < 4; ++j) v[r][j] = xr[64 * j]; } }
#pragma unroll
        for (int r = 0; r < 4; ++r) { const int m = m0 + r * NGW;
            if (m < M) {
                float s = 0.f;
#pragma unroll
                for (int j = 0; j < 4; ++j) s += (v[r][j].x * v[r][j].x + v[r][j].y * v[r][j].y) + (v[r][j].z * v[r][j].z + v[r][j].w * v[r][j].w);
                s = wave_sum(s);
                unsigned long long* o8 = (unsigned long long*)(XB + (size_t)m * D) + F.lane;
#pragma unroll
                for (int j = 0; j < 4; ++j) o8[64 * j] = (unsigned long long)pk2(v[r][j].x, v[r][j].y) | ((unsigned long long)pk2(v[r][j].z, v[r][j].w) << 32);
                if (m < MP) { if (F.lane < 16) ssq0[(size_t)m * 16 + F.lane] = F.lane == 0 ? s : 0.f; }
                else ((float*)(ws + WS_SSQ0S))[(size_t)(m - MP) * 64 + F.lane] = F.lane == 0 ? s : 0.f;
            } }
    }
    const int gt = gw * 64 + F.lane, NGT = NGW * 64;
    for (int i = gt; i < 2 * NB * 96 * 32; i += NGT) {
        const int which = i / (NB * 96 * 32), r = i % (NB * 96 * 32), b = r / (96 * 32), rr = r % (96 * 32);
        const f32x4 v = *((const f32x4*)(a.in[which ? 4 : 3] + ((size_t)b * WINDOW + 32) * 128) + rr);
        *((f32x4*)(a.out + (which ? O_CVS : O_CKS) + (size_t)b * WINDOW * 128) + rr) = v;
    }
}

constexpr int SWA_KLD_B = 144;
constexpr int SWA_VLD_B = 392;
constexpr int SWA_K_OFF = 0, SWA_V_OFF = 192 * SWA_KLD_B;
__device__ __forceinline__ void swa_unit(const Args& a, Frame& F, int seq, int chunk, int kvh) {
    const int tid = F.tid, lane = F.lane, wave = F.wave, r32 = lane & 31, hi = lane >> 5;
    const bool samp = seq >= NB; const int b = samp ? seq - NB : seq;
    bf16* SQ = (bf16*)(a.ws + WS_T2); const bf16* SKVb = (const bf16*)(a.ws + WS_SKV);
    const int rowq0 = samp ? MP + b * DEC_T : b * SEQ + chunk * 64;
    const int ntb = samp ? 1 : 2, nkb = samp ? 5 : 6, kb0 = samp ? 0 : (chunk >= 2 ? 0 : (2 - chunk) * 2);
    const int nkeys = nkb * 32;
    LAS unsigned char* Kl = F.lds + SWA_K_OFF; LAS unsigned char* Vl = F.lds + SWA_V_OFF;
    __syncthreads();
    for (int it = tid; it < nkeys * 8; it += NWAVES * 64) {
        const int key = it >> 3, c8 = it & 7;
        if (key < kb0 * 32) continue;
        v4u kk, vv;
        if (samp && key < WINDOW) {
            const float* ck = a.in[3] + ((size_t)(b * WINDOW + key) * SKV + kvh) * SHD + c8 * 8; const float* cv = a.in[4] + ((size_t)(b * WINDOW + key) * SKV + kvh) * SHD + c8 * 8;
            const f32x4 k0 = *(const f32x4*)ck, k1 = *(const f32x4*)(ck + 4), v0 = *(const f32x4*)cv, v1 = *(const f32x4*)(cv + 4);
            kk.x = pk2(k0[0], k0[1]); kk.y = pk2(k0[2], k0[3]); kk.z = pk2(k1[0], k1[1]); kk.w = pk2(k1[2], k1[3]);
            vv.x = pk2(v0[0], v0[1]); vv.y = pk2(v0[2], v0[3]); vv.z = pk2(v1[0], v1[1]); vv.w = pk2(v1[2], v1[3]);
        } else {
            const int mrow = samp ? MP + b * DEC_T + (key - WINDOW) : b * SEQ + (chunk - 2) * 64 + key;
            kk = *(const v4u*)(SKVb + (size_t)mrow * 256 + kvh * 64 + c8 * 8); vv = *(const v4u*)(SKVb + (size_t)mrow * 256 + 128 + kvh * 64 + c8 * 8);
        }
        *(LAS v4u*)(Kl + key * SWA_KLD_B + c8 * 16) = kk;
        LAS unsigned short* vt = (LAS unsigned short*)(Vl + (c8 * 8) * SWA_VLD_B + key * 2);
        vt[0 * (SWA_VLD_B / 2)] = (unsigned short)(vv.x & 0xffff); vt[1 * (SWA_VLD_B / 2)] = (unsigned short)(vv.x >> 16);
        vt[2 * (SWA_VLD_B / 2)] = (unsigned short)(vv.y & 0xffff); vt[3 * (SWA_VLD_B / 2)] = (unsigned short)(vv.y >> 16);
        vt[4 * (SWA_VLD_B / 2)] = (unsigned short)(vv.z & 0xffff); vt[5 * (SWA_VLD_B / 2)] = (unsigned short)(vv.z >> 16);
        vt[6 * (SWA_VLD_B / 2)] = (unsigned short)(vv.w & 0xffff); vt[7 * (SWA_VLD_B / 2)] = (unsigned short)(vv.w >> 16);
    }
    __syncthreads();
    const int head = kvh * 8 + wave;
    const float sink2 = a.in[13][head] * LOG2E;
    for (int tb = 0; tb < ntb; ++tb) {
        bf16* qrow = SQ + (size_t)(rowq0 + tb * 32 + r32) * D + head * SHD;
        bf16x8 qf[4];
#pragma unroll
        for (int s = 0; s < 4; ++s) qf[s] = *(const bf16x8*)(qrow + s * 16 + hi * 8);
        f32x16 sacc[6];
#pragma unroll
        for (int kb = 0; kb < 6; ++kb) {
            if (kb >= kb0 && kb < nkb) {
                f32x16 c = {0.f, 0.f, 0.f, 0.f, 0.f, 0.f, 0.f, 0.f, 0.f, 0.f, 0.f, 0.f, 0.f, 0.f, 0.f, 0.f};
#pragma unroll
                for (int s = 0; s < 4; ++s) { const bf16x8 kf = *(const LAS bf16x8*)(Kl + (kb * 32 + r32) * SWA_KLD_B + s * 32 + hi * 16); c = __builtin_amdgcn_mfma_f32_32x32x16_bf16(kf, qf[s], c, 0, 0, 0); }
                sacc[kb] = c;
            }
        }
        float mx = sink2;
#pragma unroll
        for (int kb = 0; kb < 6; ++kb) if (kb >= kb0 && kb < nkb) {
#pragma unroll
            for (int r = 0; r < 16; ++r) mx = fmaxf(mx, sacc[kb][r]); }
        mx = fmaxf(mx, __shfl_xor(mx, 32));
        float l = 0.f;
#pragma unroll
        for (int kb = 0; kb < 6; ++kb) if (kb >= kb0 && kb < nkb) {
#pragma unroll
            for (int r = 0; r < 16; ++r) { const float p = fast_exp2(sacc[kb][r] - mx); sacc[kb][r] = p; l += p; } }
        l += __shfl_xor(l, 32); l += fast_exp2(sink2 - mx);
        f32x16 o[2];
#pragma unroll
        for (int db = 0; db < 2; ++db) o[db] = (f32x16){0.f, 0.f, 0.f, 0.f, 0.f, 0.f, 0.f, 0.f, 0.f, 0.f, 0.f, 0.f, 0.f, 0.f, 0.f, 0.f};
#pragma unroll
        for (int kb = 0; kb < 6; ++kb) if (kb >= kb0 && kb < nkb) {
#pragma unroll
            for (int s2 = 0; s2 < 2; ++s2) {
                v4u pw; pw.x = pk2(sacc[kb][8 * s2 + 0], sacc[kb][8 * s2 + 1]); pw.y = pk2(sacc[kb][8 * s2 + 2], sacc[kb][8 * s2 + 3]);
                pw.z = pk2(sacc[kb][8 * s2 + 4], sacc[kb][8 * s2 + 5]); pw.w = pk2(sacc[kb][8 * s2 + 6], sacc[kb][8 * s2 + 7]);
                const bf16x8 pb = __builtin_bit_cast(bf16x8, pw);
#pragma unroll
                for (int db = 0; db < 2; ++db) {
                    const LAS unsigned char* vp = Vl + (db * 32 + r32) * SWA_VLD_B + (kb * 32 + s2 * 16 + 4 * hi) * 2;
                    const v2u lo = *(const LAS v2u*)vp, hi8 = *(const LAS v2u*)(vp + 16);
                    v4u av; av.x = lo.x; av.y = lo.y; av.z = hi8.x; av.w = hi8.y;
                    o[db] = __builtin_amdgcn_mfma_f32_32x32x16_bf16(__builtin_bit_cast(bf16x8, av), pb, o[db], 0, 0, 0);
                }
            }
        }
        const float inv = fast_rcp(l);
#pragma unroll
        for (int db = 0; db < 2; ++db)
#pragma unroll
            for (int g4 = 0; g4 < 4; ++g4) {
                v2u w; w.x = pk2(o[db][4 * g4 + 0] * inv, o[db][4 * g4 + 1] * inv); w.y = pk2(o[db][4 * g4 + 2] * inv, o[db][4 * g4 + 3] * inv);
                *(v2u*)(qrow + db * 32 + 8 * g4 + 4 * hi) = w;
            }
    }
}

struct SwaRegs { v4u kk[3], vv[3]; };
__device__ __forceinline__ void swa_p_load(SwaRegs& R, const Args& a, int u, int tid) {
    const int b = u >> 7, chunk = (u >> 1) & 63, kvh = u & 1;
    const bf16* SKVb = (const bf16*)(a.ws + WS_SKV);
    const char* base = (const char*)(SKVb + ((size_t)b * SEQ + (size_t)(chunk - 2) * 64) * 256 + kvh * 64);
#pragma unroll
    for (int i = 0; i < 3; ++i) {
        const int it = tid + 512 * i, key = it >> 3, c8 = it & 7;
        R.kk[i] = (v4u){0u, 0u, 0u, 0u}; R.vv[i] = (v4u){0u, 0u, 0u, 0u};
        if (key + (chunk - 2) * 64 >= 0) { R.kk[i] = *(const v4u*)(base + (size_t)key * 512 + c8 * 16); R.vv[i] = *(const v4u*)(base + (size_t)key * 512 + 256 + c8 * 16); }
    }
}
__device__ __forceinline__ void swa_p_compute(SwaRegs& R, const Args& a, Frame& F, int u) {
    const int tid = F.tid, lane = F.lane, wave = F.wave, r32 = lane & 31, hi = lane >> 5;
    const int b = u >> 7, chunk = (u >> 1) & 63, kvh = u & 1;
    bf16* SQ = (bf16*)(a.ws + WS_T2);
    const int rowq0 = b * SEQ + chunk * 64, kb0 = chunk >= 2 ? 0 : (2 - chunk) * 2;
    LAS unsigned char* Kl = F.lds + SWA_K_OFF; LAS unsigned char* Vl = F.lds + SWA_V_OFF;
    const int head = kvh * 8 + wave;
    bf16* qrow0 = SQ + (size_t)(rowq0 + r32) * D + head * SHD;
    bf16x8 qf[2][4];
#pragma unroll
    for (int s = 0; s < 4; ++s) qf[0][s] = *(const bf16x8*)(qrow0 + s * 16 + hi * 8);
    const float sink2 = a.in[13][head] * LOG2E;
    LDS_BAR();
#pragma unroll
    for (int i = 0; i < 3; ++i) {
        const int it = tid + 512 * i, key = it >> 3, c8 = it & 7;
        *(LAS v4u*)(Kl + key * SWA_KLD_B + c8 * 16) = R.kk[i];
        LAS unsigned short* vt = (LAS unsigned short*)(Vl + (c8 * 8) * SWA_VLD_B + key * 2);
        const unsigned w_[4] = {R.vv[i].x, R.vv[i].y, R.vv[i].z, R.vv[i].w};
#pragma unroll
        for (int q = 0; q < 4; ++q) { vt[(2 * q) * (SWA_VLD_B / 2)] = (unsigned short)(w_[q] & 0xffffu); vt[(2 * q + 1) * (SWA_VLD_B / 2)] = (unsigned short)(w_[q] >> 16); }
    }
    LDS_BAR();
#pragma unroll
    for (int tb = 0; tb < 2; ++tb) {
        bf16* qrow = qrow0 + (size_t)tb * 32 * D;
        f32x16 sacc[6];
#pragma unroll
        for (int kb = 0; kb < 6; ++kb) {
            if (kb >= kb0) {
                f32x16 c = {0.f, 0.f, 0.f, 0.f, 0.f, 0.f, 0.f, 0.f, 0.f, 0.f, 0.f, 0.f, 0.f, 0.f, 0.f, 0.f};
                bf16x8 kf[4];
#pragma unroll
                for (int s = 0; s < 4; ++s) kf[s] = *(const LAS bf16x8*)(Kl + (kb * 32 + r32) * SWA_KLD_B + s * 32 + hi * 16);
#pragma unroll
                for (int s = 0; s < 4; ++s) c = __builtin_amdgcn_mfma_f32_32x32x16_bf16(kf[s], qf[tb][s], c, 0, 0, 0);
                sacc[kb] = c;
            }
        }
        if (tb == 0) {
#pragma unroll
            for (int s = 0; s < 4; ++s) qf[1][s] = *(const bf16x8*)(qrow0 + (size_t)32 * D + s * 16 + hi * 8);
        }
        float mx = sink2;
#pragma unroll
        for (int kb = 0; kb < 6; ++kb) if (kb >= kb0) {
#pragma unroll
            for (int r = 0; r < 16; ++r) mx = fmaxf(mx, sacc[kb][r]); }
        mx = fmaxf(mx, __shfl_xor(mx, 32));
        float l = 0.f;
#pragma unroll
        for (int kb = 0; kb < 6; ++kb) if (kb >= kb0) {
#pragma unroll
            for (int r = 0; r < 16; ++r) { const float p = fast_exp2(sacc[kb][r] - mx); sacc[kb][r] = p; l += p; } }
        l += __shfl_xor(l, 32); l += fast_exp2(sink2 - mx);
        f32x16 o[2];
#pragma unroll
        for (int db = 0; db < 2; ++db) o[db] = (f32x16){0.f, 0.f, 0.f, 0.f, 0.f, 0.f, 0.f, 0.f, 0.f, 0.f, 0.f, 0.f, 0.f, 0.f, 0.f, 0.f};
#pragma unroll
        for (int kb = 0; kb < 6; ++kb) if (kb >= kb0) {
            v2u vlo[2][2], vhi[2][2];
#pragma unroll
            for (int s2 = 0; s2 < 2; ++s2)
#pragma unroll
                for (int db = 0; db < 2; ++db) {
                    const LAS unsigned char* vp = Vl + (db * 32 + r32) * SWA_VLD_B + (kb * 32 + s2 * 16 + 4 * hi) * 2;
                    vlo[s2][db] = *(const LAS v2u*)vp; vhi[s2][db] = *(const LAS v2u*)(vp + 16);
                }
            bf16x8 pb[2];
#pragma unroll
            for (int s2 = 0; s2 < 2; ++s2) {
                v4u pw; pw.x = pk2(sacc[kb][8 * s2 + 0], sacc[kb][8 * s2 + 1]); pw.y = pk2(sacc[kb][8 * s2 + 2], sacc[kb][8 * s2 + 3]);
                pw.z = pk2(sacc[kb][8 * s2 + 4], sacc[kb][8 * s2 + 5]); pw.w = pk2(sacc[kb][8 * s2 + 6], sacc[kb][8 * s2 + 7]);
                pb[s2] = __builtin_bit_cast(bf16x8, pw);
            }
            asm volatile("s_waitcnt lgkmcnt(0)" ::: "memory"); __builtin_amdgcn_sched_barrier(0);
#pragma unroll
            for (int s2 = 0; s2 < 2; ++s2)
#pragma unroll
                for (int db = 0; db < 2; ++db) {
                    v4u av; av.x = vlo[s2][db].x; av.y = vlo[s2][db].y; av.z = vhi[s2][db].x; av.w = vhi[s2][db].y;
                    o[db] = __builtin_amdgcn_mfma_f32_32x32x16_bf16(__builtin_bit_cast(bf16x8, av), pb[s2], o[db], 0, 0, 0);
                }
            __builtin_amdgcn_sched_barrier(0);
        }
        const float inv = fast_rcp(l);
#pragma unroll
        for (int db = 0; db < 2; ++db)
#pragma unroll
            for (int g4 = 0; g4 < 4; ++g4) {
                v2u w; w.x = pk2(o[db][4 * g4 + 0] * inv, o[db][4 * g4 + 1] * inv); w.y = pk2(o[db][4 * g4 + 2] * inv, o[db][4 * g4 + 3] * inv);
                *(v2u*)(qrow + db * 32 + 8 * g4 + 4 * hi) = w;
            }
    }
}

constexpr int G1_GLR_OFF = 0, G1_TOT_OFF = 4096, G1_Q_OFF = 6144, G1_LD_B = 272, G1_K_OFF = G1_Q_OFF + 64 * G1_LD_B;
struct G1Regs { v4u qraw[2], kraw[2]; f32x4 gl; };
__device__ __forceinline__ void g1_load(G1Regs& R, const Args& a, int seq, int chunk, int h, int tid) {
    const bool samp = seq >= NB; const int b = samp ? seq - NB : seq;
    const int row0 = samp ? MP + b * DEC_T : b * SEQ + chunk * 64, L = samp ? DEC_T : 64;
    const bf16* QK = (const bf16*)(a.ws + WS_T0); const float* GLR = (const float*)(a.ws + WS_GLR);
#pragma unroll
    for (int j = 0; j < 2; ++j) { const int idx = tid + 512 * j, t = idx >> 4, c16 = idx & 15;
        R.qraw[j] = (v4u){0u, 0u, 0u, 0u}; R.kraw[j] = (v4u){0u, 0u, 0u, 0u};
        if (t < L) { const bf16* src = QK + (size_t)(row0 + t) * D + h * 128 + c16 * 8; R.qraw[j] = *(const v4u*)src; R.kraw[j] = *(const v4u*)(src + 512); } }
    R.gl = (f32x4){0.f, 0.f, 0.f, 0.f};
    if (tid < 256) { const int t = tid >> 2, c4 = tid & 3; if (t < L) R.gl = *(const f32x4*)(GLR + (size_t)(row0 + t) * 16 + c4 * 4); }
}
__device__ __forceinline__ void g1_compute(G1Regs& R, const float (&w)[16], float bias, const Args& a, Frame& F, int seq, int chunk, int h) {
    const int tid = F.tid, lane = F.lane, wave = F.wave, fr = lane & 15, fq = lane >> 4;
    const bool samp = seq >= NB; const int b = samp ? seq - NB : seq;
    const int row0 = samp ? MP + b * DEC_T : b * SEQ + chunk * 64, L = samp ? DEC_T : 64;
    const int uid = samp ? NB * 64 * GH + b * GH + h : (b * 64 + chunk) * GH + h;
    bf16* QK = (bf16*)(a.ws + WS_T0); bf16* KT = (bf16*)(a.ws + WS_T7); bf16* ABUF = (bf16*)(a.ws + WS_ABUF);
    float* gdec = (float*)(a.ws + WS_GDEC);
    LAS float* glr_l = (LAS float*)(F.lds + G1_GLR_OFF); LAS float* tot = (LAS float*)(F.lds + G1_TOT_OFF);
    LAS unsigned char* ql = F.lds + G1_Q_OFF; LAS unsigned char* kl = F.lds + G1_K_OFF;
    const int d = tid & 127, strip = tid >> 7, t0 = strip * 16;
    LDS_BAR();
#pragma unroll
    for (int j = 0; j < 2; ++j) { const int idx = tid + 512 * j, t = idx >> 4, c16 = idx & 15; *(LAS v4u*)(ql + t * G1_LD_B + c16 * 16) = R.qraw[j]; *(LAS v4u*)(kl + t * G1_LD_B + c16 * 16) = R.kraw[j]; }
    if (tid < 256) *(LAS f32x4*)(glr_l + (tid >> 2) * 16 + (tid & 3) * 4) = R.gl;
    LDS_BAR();
    float bc[16]; float run = 0.f;
#pragma unroll
    for (int i = 0; i < 16; ++i) {
        const int t = t0 + i; float lg = bias;
#pragma unroll
        for (int r4 = 0; r4 < 4; ++r4) { const f32x4 gv = *(const LAS f32x4*)(glr_l + t * 16 + r4 * 4); lg += gv[0] * w[r4 * 4] + gv[1] * w[r4 * 4 + 1] + gv[2] * w[r4 * 4 + 2] + gv[3] * w[r4 * 4 + 3]; }
        const float ls = fminf(lg, 0.f) - __logf(1.0f + __expf(-fabsf(lg)));
        run += (t < L) ? ls * (1.0f / 16.0f) : 0.f; bc[i] = run;
    }
    tot[strip * 128 + d] = run;
    LDS_BAR();
    float off = 0.f, bL = 0.f;
#pragma unroll
    for (int s = 0; s < 4; ++s) { const float tv = tot[s * 128 + d]; bL += tv; if (s < strip) off += tv; }
    unsigned short kp[16];
    const float ebL = __expf(bL);
#pragma unroll
    for (int i = 0; i < 16; ++i) {
        const int t = t0 + i; const float bt = bc[i] + off;
        LAS unsigned short* qe = (LAS unsigned short*)(ql + t * G1_LD_B + d * 2); LAS unsigned short* ke = (LAS unsigned short*)(kl + t * G1_LD_B + d * 2);
        const float q = bf2f(*qe), k = bf2f(*ke);
        const float eb = __expf(bt), ebi = fast_rcp(eb);
        kp[i] = f2bf(k * (ebL * ebi));
        *qe = f2bf(q * eb); *ke = f2bf(k * ebi);
    }
    { v4u o0, o1; o0.x = kp[0] | ((unsigned)kp[1] << 16); o0.y = kp[2] | ((unsigned)kp[3] << 16); o0.z = kp[4] | ((unsigned)kp[5] << 16); o0.w = kp[6] | ((unsigned)kp[7] << 16);
      o1.x = kp[8] | ((unsigned)kp[9] << 16); o1.y = kp[10] | ((unsigned)kp[11] << 16); o1.z = kp[12] | ((unsigned)kp[13] << 16); o1.w = kp[14] | ((unsigned)kp[15] << 16);
      v4u* kd = (v4u*)(KT + ((size_t)uid * 128 + d) * 64 + t0); kd[0] = o0; kd[1] = o1; }
    if (strip == 0) gdec[(size_t)uid * 128 + d] = ebL;
    LDS_BAR();
#pragma unroll
    for (int j = 0; j < 2; ++j) { const int idx = tid + 512 * j, t = idx >> 4, c16 = idx & 15;
        if (t < L) *(v4u*)(QK + (size_t)(row0 + t) * D + h * 128 + c16 * 8) = *(const LAS v4u*)(ql + t * G1_LD_B + c16 * 16); }
    const int sb = wave >> 1;
    bf16x8 kf[4];
#pragma unroll
    for (int kd = 0; kd < 4; ++kd) kf[kd] = *(const LAS bf16x8*)(kl + (sb * 16 + fr) * G1_LD_B + (kd * 32 + 8 * fq) * 2);
#pragma unroll
    for (int x = 0; x < 2; ++x) {
        const int tb = 2 * (wave & 1) + x;
        f32x4 c = {0.f, 0.f, 0.f, 0.f};
#pragma unroll
        for (int kd = 0; kd < 4; ++kd) { const bf16x8 qf = *(const LAS bf16x8*)(ql + (tb * 16 + fr) * G1_LD_B + (kd * 32 + 8 * fq) * 2); c = __builtin_amdgcn_mfma_f32_16x16x32_bf16(kf[kd], qf, c, 0, 0, 0); }
        const int t = tb * 16 + fr, s0 = sb * 16 + 4 * fq;
        float v[4];
#pragma unroll
        for (int j = 0; j < 4; ++j) v[j] = (t >= s0 + j) ? c[j] : 0.f;
        if (t < L) { v2u o; o.x = pk2(v[0], v[1]); o.y = pk2(v[2], v[3]); *(v2u*)(ABUF + (size_t)(row0 + t) * 256 + h * 64 + s0) = o; }
    }
}

constexpr int H2_A_OFF = 0, H2_A_LD = 160, H2_Q_OFF = 64 * H2_A_LD, H2_Q_LD = 288, H2_KT_OFF = H2_Q_OFF + 64 * H2_Q_LD, H2_KT_LD = 160, H2_VT_OFF = H2_KT_OFF + 128 * H2_KT_LD, H2_VT_LD = 160,
              H2_ST_OFF = H2_VT_OFF + 64 * H2_VT_LD, H2_ST_LD = 288, H2_END = H2_ST_OFF + 64 * H2_ST_LD;
constexpr int H2_BUF = 77824;
static_assert(H2_END <= H2_BUF && 2 * H2_BUF <= PHASE_LDS, "G2 LDS map");
struct H2Regs { v4u a; v4u q[2]; v4u kt[2]; v4u v; f32x4 g4; };
struct H2Off { unsigned a, q, k, v, g, o; };
template <bool SAMP> __device__ __forceinline__ void h2_load(H2Regs& R, const Args& a, const H2Off& O, int row0, int uid, int h, int es, int tid, int lane) {
    const char* bA = (const char*)(a.ws + WS_ABUF) + ((size_t)row0 * 256 + h * 64) * 2;
    const char* bQ = (const char*)(a.ws + WS_T0) + ((size_t)row0 * D + h * 128) * 2;
    const char* bK = (const char*)(a.ws + WS_T7) + (size_t)uid * 16384;
    const char* bV = (const char*)(a.ws + WS_T1) + ((size_t)row0 * D + h * 256 + es * 64) * 2;
    const char* bG = (const char*)(a.ws + WS_GDEC) + (size_t)uid * 512;
    const v4u z = {0u, 0u, 0u, 0u};
    R.a = z; if (!SAMP || (tid >> 3) < DEC_T) R.a = *(const v4u*)(bA + O.a);
#pragma unroll
    for (int j = 0; j < 2; ++j) { R.q[j] = z; if (!SAMP || j == 0) R.q[j] = *(const v4u*)(bQ + O.q + j * 65536); }
#pragma unroll
    for (int j = 0; j < 2; ++j) R.kt[j] = *(const v4u*)(bK + O.k + j * 8192);
    R.v = z; if (!SAMP || lane < DEC_T) R.v = *(const v4u*)(bV + O.v);
    R.g4 = *(const f32x4*)(bG + O.g);
}
__device__ __forceinline__ void h2_stage(const H2Regs& R, LAS unsigned char* lds, int tid, int lane, int wave) {
    { const int t = tid >> 3, ch = tid & 7; *(LAS v4u*)(lds + H2_A_OFF + t * H2_A_LD + ch * 16) = R.a; }
#pragma unroll
    for (int j = 0; j < 2; ++j) { const int p = tid + 512 * j; *(LAS v4u*)(lds + H2_Q_OFF + (p >> 4) * H2_Q_LD + (p & 15) * 16) = R.q[j]; *(LAS v4u*)(lds + H2_KT_OFF + (p >> 3) * H2_KT_LD + (p & 7) * 16) = R.kt[j]; }
    { LAS unsigned short* vt = (LAS unsigned short*)(lds + H2_VT_OFF + (wave * 8) * H2_VT_LD + lane * 2); const unsigned w_[4] = {R.v.x, R.v.y, R.v.z, R.v.w};
#pragma unroll
      for (int i = 0; i < 4; ++i) { vt[(2 * i) * (H2_VT_LD / 2)] = (unsigned short)(w_[i] & 0xffffu); vt[(2 * i + 1) * (H2_VT_LD / 2)] = (unsigned short)(w_[i] >> 16); } }
}
template <bool SAMP> __device__ __forceinline__ void g2_item(const Args& a, Frame& F, int bh, int es) {
    const int tid = F.tid, lane = F.lane, wave = F.wave, fr = lane & 15, fq = lane >> 4;
    constexpr int nch = SAMP ? 1 : 64; const int b = bh >> 2, h = bh & 3;
    const int tb = wave >> 1, eb0 = (wave & 1) * 2;
    bf16* OG = (bf16*)(a.ws + WS_T1);
    LAS unsigned char* lds0 = F.lds;
    H2Off OF; OF.a = (unsigned)((tid >> 3) * 512 + (tid & 7) * 16); OF.q = (unsigned)((tid >> 4) * 2048 + (tid & 15) * 16); OF.k = (unsigned)(tid * 16);
    OF.v = (unsigned)(lane * 2048 + wave * 16); OF.g = (unsigned)((16 * wave + 4 * fq) * 4); OF.o = (unsigned)(((tb * 16 + fr) * D + eb0 * 16 + 4 * fq) * 2);
    f32x4 S[4];
#pragma unroll
    for (int eb = 0; eb < 4; ++eb)
#pragma unroll
        for (int r = 0; r < 4; ++r) S[eb][r] = SAMP ? a.in[2][((size_t)bh * 128 + 16 * wave + 4 * fq + r) * 256 + es * 64 + eb * 16 + fr] : 0.f;
    H2Regs R0, R1, R2;
#define H2_LOADC(R, cc) do { const int c_ = (cc) < nch ? (cc) : nch - 1; \
        h2_load<SAMP>(R, a, OF, SAMP ? MP + b * DEC_T : b * SEQ + c_ * 64, SAMP ? NB * 64 * GH + bh : (b * 64 + c_) * GH + h, h, es, tid, lane); } while (0)
#define H2_STEP(R, NXT, cc, PAR) do { \
        const int row0 = SAMP ? MP + b * DEC_T : b * SEQ + (cc) * 64; \
        LAS unsigned char* lds = lds0 + (PAR) * H2_BUF; \
        asm volatile("" : "+v"(R.a), "+v"(R.q[0]), "+v"(R.q[1]), "+v"(R.kt[0]), "+v"(R.kt[1]), "+v"(R.v), "+v"(R.g4)); \
        h2_stage(R, lds, tid, lane, wave); \
        const f32x4 g4 = R.g4; \
        _Pragma("unroll") for (int eb = 0; eb < 4; ++eb) { v2u o; o.x = pk2(S[eb][0], S[eb][1]); o.y = pk2(S[eb][2], S[eb][3]); *(LAS v2u*)(lds + H2_ST_OFF + (eb * 16 + fr) * H2_ST_LD + (16 * wave + 4 * fq) * 2) = o; } \
        LDS_BAR(); \
        if (!SAMP) H2_LOADC(NXT, (cc) + 2); \
        { bf16x8 afr[2], qfr[4], vo[2][2], sf[2][4]; \
          _Pragma("unroll") for (int ks = 0; ks < 2; ++ks) afr[ks] = *(const LAS bf16x8*)(lds + H2_A_OFF + (tb * 16 + fr) * H2_A_LD + ks * 64 + fq * 16); \
          _Pragma("unroll") for (int kd = 0; kd < 4; ++kd) qfr[kd] = *(const LAS bf16x8*)(lds + H2_Q_OFF + (tb * 16 + fr) * H2_Q_LD + kd * 64 + fq * 16); \
          _Pragma("unroll") for (int j = 0; j < 2; ++j) { \
              _Pragma("unroll") for (int ks = 0; ks < 2; ++ks) vo[j][ks] = *(const LAS bf16x8*)(lds + H2_VT_OFF + ((eb0 + j) * 16 + fr) * H2_VT_LD + ks * 64 + fq * 16); \
              _Pragma("unroll") for (int kd = 0; kd < 4; ++kd) sf[j][kd] = *(const LAS bf16x8*)(lds + H2_ST_OFF + ((eb0 + j) * 16 + fr) * H2_ST_LD + kd * 64 + fq * 16); } \
          asm volatile("s_waitcnt lgkmcnt(0)" ::: "memory"); __builtin_amdgcn_sched_barrier(0); \
          f32x4 acc0 = {0.f, 0.f, 0.f, 0.f}, acc1 = {0.f, 0.f, 0.f, 0.f}; \
          _Pragma("unroll") for (int ks = 0; ks < 2; ++ks) { acc0 = __builtin_amdgcn_mfma_f32_16x16x32_bf16(vo[0][ks], afr[ks], acc0, 0, 0, 0); acc1 = __builtin_amdgcn_mfma_f32_16x16x32_bf16(vo[1][ks], afr[ks], acc1, 0, 0, 0); } \
          _Pragma("unroll") for (int kd = 0; kd < 4; ++kd) { acc0 = __builtin_amdgcn_mfma_f32_16x16x32_bf16(sf[0][kd], qfr[kd], acc0, 0, 0, 0); acc1 = __builtin_amdgcn_mfma_f32_16x16x32_bf16(sf[1][kd], qfr[kd], acc1, 0, 0, 0); } \
          __builtin_amdgcn_sched_barrier(0); \
          bf16x8 kfr[2], vb[4][2]; \
          _Pragma("unroll") for (int ks = 0; ks < 2; ++ks) kfr[ks] = *(const LAS bf16x8*)(lds + H2_KT_OFF + (16 * wave + fr) * H2_KT_LD + ks * 64 + fq * 16); \
          _Pragma("unroll") for (int eb = 0; eb < 4; ++eb) _Pragma("unroll") for (int ks = 0; ks < 2; ++ks) vb[eb][ks] = *(const LAS bf16x8*)(lds + H2_VT_OFF + (eb * 16 + fr) * H2_VT_LD + ks * 64 + fq * 16); \
          _Pragma("unroll") for (int eb = 0; eb < 4; ++eb) S[eb] = S[eb] * g4; \
          asm volatile("s_waitcnt lgkmcnt(0)" ::: "memory"); __builtin_amdgcn_sched_barrier(0); \
          _Pragma("unroll") for (int ks = 0; ks < 2; ++ks) _Pragma("unroll") for (int eb = 0; eb < 4; ++eb) S[eb] = __builtin_amdgcn_mfma_f32_16x16x32_bf16(kfr[ks], vb[eb][ks], S[eb], 0, 0, 0); \
          if (!SAMP || tb < 2) { v2u o; o.x = pk2(acc0[0], acc0[1]); o.y = pk2(acc0[2], acc0[3]); *(v2u*)((char*)OG + ((size_t)row0 * D + h * 256 + es * 64) * 2 + OF.o) = o; \
                                 o.x = pk2(acc1[0], acc1[1]); o.y = pk2(acc1[2], acc1[3]); *(v2u*)((char*)OG + ((size_t)row0 * D + h * 256 + es * 64) * 2 + OF.o + 32) = o; } } \
    } while (0)
    H2_LOADC(R0, 0); if (!SAMP) H2_LOADC(R1, 1);
    LDS_BAR();
    if (SAMP) { H2_STEP(R0, R2, 0, 0); }
    else {
        H2_STEP(R0, R2, 0, 0); H2_STEP(R1, R0, 1, 1);
        for (int c = 2; c < 62; c += 6) { H2_STEP(R2, R1, c, 0); H2_STEP(R0, R2, c + 1, 1); H2_STEP(R1, R0, c + 2, 0); H2_STEP(R2, R1, c + 3, 1); H2_STEP(R0, R2, c + 4, 0); H2_STEP(R1, R0, c + 5, 1); }
        H2_STEP(R2, R1, 62, 0); H2_STEP(R0, R2, 63, 1);
    }
#undef H2_STEP
#undef H2_LOADC
    float* so = a.out + (SAMP ? O_SGS : O_SGP);
#pragma unroll
    for (int eb = 0; eb < 4; ++eb)
#pragma unroll
        for (int r = 0; r < 4; ++r) so[((size_t)bh * 128 + 16 * wave + 4 * fq + r) * 256 + es * 64 + eb * 16 + fr] = S[eb][r];
}

template <int NACC> __device__ __forceinline__ void sg_kloop(f32x4 (&c)[NACC], const bf16* ap, const bf16* (&bp)[NACC], int K) {
#pragma unroll 8
    for (int k0 = 0; k0 < K; k0 += 32) {
        const bf16x8 a = *(const bf16x8*)(ap + k0);
#pragma unroll
        for (int i = 0; i < NACC; ++i) { const bf16x8 b = *(const bf16x8*)(bp[i] + k0); c[i] = __builtin_amdgcn_mfma_f32_16x16x32_bf16(b, a, c[i], 0, 0, 0); }
    }
}
__device__ __forceinline__ float sg_rstd(const float* ssqs, int lr, int fq) {
    const f32x4* p = (const f32x4*)(ssqs + (size_t)lr * 64 + fq * 16);
    const f32x4 a = p[0], b = p[1], c = p[2], d = p[3];
    float s = ((a.x + a.y) + (a.z + a.w)) + ((b.x + b.y) + (b.z + b.w)) + ((c.x + c.y) + (c.z + c.w)) + ((d.x + d.y) + (d.z + d.w));
    s += __shfl_xor(s, 16); s += __shfl_xor(s, 32);
    return __builtin_amdgcn_rsqf(s * (1.0f / D) + EPS);
}
__device__ __forceinline__ void sg_swiglu(const Args& a, Frame& F, const bf16* Wt, const float* ssqs) {
    const int gw = F.vcu * NWAVES + F.wave, NGW = F.G * NWAVES, fr = F.lane & 15, fq = F.lane >> 4;
    const bf16* XB = (const bf16*)(a.ws + WS_XB); bf16* ACT = (bf16*)(a.ws + WS_ACT);
    LAS f32x4* xch = (LAS f32x4*)F.lds;
    for (int it = gw; it < 2 * 16 * (FF / 16); it += NGW) {
        const int id = it >> 1, kh = it & 1;
        const int mb = id & 15, jb = id >> 4, g0 = 16 * jb, lr = mb * 16 + fr, m = MP + lr;
        const int grow = 256 * (g0 >> 7) + (g0 & 127);
        const bf16* bp[2] = {Wt + (size_t)(grow + fr) * D + kh * (D / 2) + 8 * fq, Wt + (size_t)(grow + 128 + fr) * D + kh * (D / 2) + 8 * fq};
        f32x4 c[2] = {{0.f, 0.f, 0.f, 0.f}, {0.f, 0.f, 0.f, 0.f}};
        sg_kloop<2>(c, XB + (size_t)m * D + kh * (D / 2) + 8 * fq, bp, D / 2);
        __syncthreads();
        if (kh) { xch[(F.wave >> 1) * 128 + F.lane] = c[0]; xch[(F.wave >> 1) * 128 + 64 + F.lane] = c[1]; }
        __syncthreads();
        if (!kh) {
            c[0] += xch[(F.wave >> 1) * 128 + F.lane]; c[1] += xch[(F.wave >> 1) * 128 + 64 + F.lane];
            const float rs = sg_rstd(ssqs, lr, fq);
            float o[4];
#pragma unroll
            for (int j = 0; j < 4; ++j) o[j] = siluf_(c[0][j] * rs) * (c[1][j] * rs);
            v2u w; w.x = pk2(o[0], o[1]); w.y = pk2(o[2], o[3]);
            *(v2u*)(ACT + (size_t)m * FF + g0 + 4 * fq) = w;
        }
    }
}
__device__ __forceinline__ void sg_resid(const Args& a, Frame& F, const bf16* A, int lda, const bf16* Wt, int K, const float* res_f32, float alpha, float* ssqs_out) {
    const int gw = F.vcu * NWAVES + F.wave, NGW = F.G * NWAVES, fr = F.lane & 15, fq = F.lane >> 4;
    bf16* XB = (bf16*)(a.ws + WS_XB);
    LAS f32x4* xch = (LAS f32x4*)F.lds;
    const int Kh = K >> 1;
    for (int it = gw; it < 2 * 16 * (D / 16); it += NGW) {
        const int id = it >> 1, kh = it & 1;
        const int mb = id & 15, nb = id >> 4, lr = mb * 16 + fr, m = MP + lr, n0 = 16 * nb + 4 * fq;
        const bf16* bp[1] = {Wt + (size_t)(16 * nb + fr) * K + kh * Kh + 8 * fq};
        f32x4 c[1] = {{0.f, 0.f, 0.f, 0.f}};
        sg_kloop<1>(c, A + (size_t)m * lda + kh * Kh + 8 * fq, bp, Kh);
        __syncthreads();
        if (kh) xch[(F.wave >> 1) * 64 + F.lane] = c[0];
        __syncthreads();
        if (!kh) {
            c[0] += xch[(F.wave >> 1) * 64 + F.lane];
            f32x4 r;
            if (res_f32) r = *(const f32x4*)(res_f32 + (size_t)lr * D + n0);
            else { const v2u rb = *(const v2u*)(XB + (size_t)m * D + n0); r = (f32x4){bflo(rb.x), bfhi(rb.x), bflo(rb.y), bfhi(rb.y)}; }
            const f32x4 v = r + c[0] * alpha;
            { v2u w; w.x = pk2(v[0], v[1]); w.y = pk2(v[2], v[3]); *(v2u*)(XB + (size_t)m * D + n0) = w; }
            if (ssqs_out) { float ss = (v[0] * v[0] + v[1] * v[1]) + (v[2] * v[2] + v[3] * v[3]); ss += __shfl_xor(ss, 16); ss += __shfl_xor(ss, 32); if (fq == 0) ssqs_out[(size_t)lr * 64 + nb] = ss; }
        }
    }
}
__device__ __forceinline__ void sg_proj(const Args& a, Frame& F) {
    const int gw = F.vcu * NWAVES + F.wave, NGW = F.G * NWAVES, fr = F.lane & 15, fq = F.lane >> 4;
    unsigned char* ws = a.ws;
    const bf16* XB = (const bf16*)(ws + WS_XB); const bf16* Wt = (const bf16*)(ws + WS_WAT); const float* ssqs = (const float*)(ws + WS_SSQAS);
    const int ntile = 16 * ((NA - 240) / 16);
    LAS f32x4* xch = (LAS f32x4*)F.lds;
    for (int it = gw; it < 2 * ntile; it += NGW) {
        const int id = it >> 1, kh = it & 1;
        const int mb = id & 15, nb = id >> 4, lr = mb * 16 + fr, m = MP + lr, n0 = 16 * nb, nq = n0 + 4 * fq;
        const bf16* bp[1] = {Wt + (size_t)(n0 + fr) * D + kh * (D / 2) + 8 * fq};
        f32x4 c[1] = {{0.f, 0.f, 0.f, 0.f}};
        sg_kloop<1>(c, XB + (size_t)m * D + kh * (D / 2) + 8 * fq, bp, D / 2);
        __syncthreads();
        if (kh) xch[(F.wave >> 1) * 64 + F.lane] = c[0];
        __syncthreads();
        if (kh) continue;
        c[0] += xch[(F.wave >> 1) * 64 + F.lane];
        const float rs = sg_rstd(ssqs, lr, fq);
        f32x4 v = c[0] * rs;
        if (n0 >= 4352) {
            *(f32x4*)((float*)(ws + WS_GLR) + (size_t)m * 16 + 4 * fq) = v;
        } else if (n0 >= 4096) {
            v2u w; w.x = pk2(v[0], v[1]); w.y = pk2(v[2], v[3]);
            *(v2u*)((bf16*)(ws + WS_SKV) + (size_t)m * 256 + (nq - 4096)) = w;
            const int bs = lr >> 5, t = lr & 31;
            *(f32x4*)(a.out + (nq < 4224 ? O_CKS : O_CVS) + ((size_t)(bs * WINDOW + 96 + t)) * 128 + ((nq - 4096) & 127)) = v;
        } else {
            bf16* dst; int col;
            if (n0 < 1024) { dst = (bf16*)(ws + WS_T0); col = nq; if (n0 < 512) v = v * 0.08838834764831845f; }
            else if (n0 < 2048) { dst = (bf16*)(ws + WS_T1); col = nq - 1024; }
            else if (n0 < 3072) { dst = (bf16*)(ws + WS_T2); col = nq - 2048; v = v * (0.125f * LOG2E); }
            else { dst = (bf16*)(ws + WS_T8); col = nq - 3072;
#pragma unroll
                for (int j = 0; j < 4; ++j) v[j] = siluf_(v[j]); }
            v2u w; w.x = pk2(v[0], v[1]); w.y = pk2(v[2], v[3]);
            *(v2u*)(dst + (size_t)m * D + col) = w;
        }
    }
}
__device__ __forceinline__ void sg_gates(const Args& a, Frame& F) {
    const int gw = F.vcu * NWAVES + F.wave, NGW = F.G * NWAVES, fr = F.lane & 15, fq = F.lane >> 4;
    unsigned char* ws = a.ws;
    const bf16* XB = (const bf16*)(ws + WS_XB); const bf16* Wt = (const bf16*)(ws + WS_WBT); const float* ssqs = (const float*)(ws + WS_SSQAS);
    bf16* R = (bf16*)(ws + WS_T0); bf16* SS = (bf16*)(ws + WS_T7);
    LAS f32x4* xch = (LAS f32x4*)F.lds;
    for (int it = gw; it < 2 * 16 * (D / 16); it += NGW) {
        const int id = it >> 1, kh = it & 1;
        const int mb = id & 15, nb = id >> 4, n0 = 16 * nb, lr = mb * 16 + fr, m = MP + lr;
        const int grow = 256 * (n0 >> 7) + (n0 & 127);
        const bf16* bp[2] = {Wt + (size_t)(grow + fr) * D + kh * (D / 2) + 8 * fq, Wt + (size_t)(grow + 128 + fr) * D + kh * (D / 2) + 8 * fq};
        f32x4 c[2] = {{0.f, 0.f, 0.f, 0.f}, {0.f, 0.f, 0.f, 0.f}};
        sg_kloop<2>(c, XB + (size_t)m * D + kh * (D / 2) + 8 * fq, bp, D / 2);
        __syncthreads();
        if (kh) { xch[(F.wave >> 1) * 128 + F.lane] = c[0]; xch[(F.wave >> 1) * 128 + 64 + F.lane] = c[1]; }
        __syncthreads();
        if (kh) continue;
        c[0] += xch[(F.wave >> 1) * 128 + F.lane]; c[1] += xch[(F.wave >> 1) * 128 + 64 + F.lane];
        const float rs = sg_rstd(ssqs, lr, fq);
        float r[4], ss[4];
#pragma unroll
        for (int j = 0; j < 4; ++j) { const float eg = fast_exp(-c[0][j] * rs), es = fast_exp(-c[1][j] * rs); ss[j] = fast_rcp(1.0f + es); r[j] = (1.0f + es) * fast_rcp(1.0f + eg); }
        v2u w; w.x = pk2(r[0], r[1]); w.y = pk2(r[2], r[3]); *(v2u*)(R + (size_t)m * D + n0 + 4 * fq) = w;
        w.x = pk2(ss[0], ss[1]); w.y = pk2(ss[2], ss[3]); *(v2u*)(SS + (size_t)m * D + n0 + 4 * fq) = w;
    }
}
__device__ __forceinline__ void sg_branch(const Args& a, Frame& F) {
    const int gw = F.vcu * NWAVES + F.wave, NGW = F.G * NWAVES, fr = F.lane & 15, fq = F.lane >> 4;
    unsigned char* ws = a.ws;
    const bf16* Wt = (const bf16*)(ws + WS_WBRT);
    const bf16* GG = (const bf16*)(ws + WS_T0); const bf16* GS = (const bf16*)(ws + WS_T7); bf16* O = (bf16*)(ws + WS_T8);
    LAS f32x4* xch = (LAS f32x4*)F.lds;
    for (int it = gw; it < 2 * 16 * (D / 16); it += NGW) {
        const int id = it >> 1, kh = it & 1;
        const int mb = id & 15, nb = id >> 4, m = MP + mb * 16 + fr, n0 = 16 * nb + 4 * fq;
        const bf16* Asrc = (const bf16*)(ws + (kh ? WS_T2 : WS_T1));
        const bf16* bp[1] = {Wt + (size_t)(16 * nb + fr) * (2 * D) + kh * D + 8 * fq};
        f32x4 c[1] = {{0.f, 0.f, 0.f, 0.f}};
        sg_kloop<1>(c, Asrc + (size_t)m * D + 8 * fq, bp, D);
        __syncthreads();
        if (kh) xch[(F.wave >> 1) * 64 + F.lane] = c[0];
        __syncthreads();
        if (!kh) {
            const f32x4 cb = xch[(F.wave >> 1) * 64 + F.lane];
            const v2u g = *(const v2u*)(GG + (size_t)m * D + n0), sv = *(const v2u*)(GS + (size_t)m * D + n0);
            const float rr[4] = {bflo(g.x), bfhi(g.x), bflo(g.y), bfhi(g.y)}, ss[4] = {bflo(sv.x), bfhi(sv.x), bflo(sv.y), bfhi(sv.y)};
            v2u w; w.x = pk2((c[0][0] * rr[0] + cb[0]) * ss[0], (c[0][1] * rr[1] + cb[1]) * ss[1]); w.y = pk2((c[0][2] * rr[2] + cb[2]) * ss[2], (c[0][3] * rr[3] + cb[3]) * ss[3]);
            *(v2u*)(O + (size_t)m * D + n0) = w;
        }
    }
}

template <int K> __device__ __forceinline__ void run_phase(const Args& args, LAS unsigned char* ldsp) {
    Frame F;
    { int t = threadIdx.x; asm volatile("" : "+v"(t)); F.tid = t; }
    F.lds = ldsp; F.lane = F.tid & 63; F.wave = __builtin_amdgcn_readfirstlane(F.tid >> 6);
    F.G = gridDim.x; { const int bx = blockIdx.x; F.vcu = (F.G % 8 == 0) ? (bx % 8) * (F.G / 8) + bx / 8 : bx; }
    F.out = args.out; F.ws = args.ws;
    unsigned char* ws = args.ws;
    const int gw = F.vcu * NWAVES + F.wave, NGW = F.G * NWAVES;
    bf16* XB = (bf16*)(ws + WS_XB); bf16* ACT = (bf16*)(ws + WS_ACT);
    float* X = args.out + O_Y;
    (void)gw; (void)NGW; (void)XB; (void)ACT; (void)X;
    if constexpr (K == 0) { p0_prologue(args, F); }
    if constexpr (K == 1) {
        pg8::Gemm g{XB, XB, (const bf16*)(ws + WS_W1T), D, D, D, 1}; pg8::StaticOrder S; S.init(MP / 256, 2 * FF / 256, 1, F.G, (int)blockIdx.x);
        pg8::EpiSwiglu E{ACT, (const float*)(ws + WS_SSQ0)};
        pg8::gemm_phase<pg8::EpiSwiglu, true>(F.lds, g, S, E);
        sg_swiglu(args, F, (const bf16*)(ws + WS_W1T), (const float*)(ws + WS_SSQ0S));
    }
    if constexpr (K == 2) {
        pg8::Gemm g{ACT, ACT, (const bf16*)(ws + WS_W1OT), FF, FF, FF, 1}; pg8::StaticOrder S; S.init(MP / 256, D / 256, 1, F.G, (int)blockIdx.x);
        pg8::EpiResid<true> E{nullptr, XB, (float*)(ws + WS_SSQA), 0.5f};
        pg8::gemm_phase<pg8::EpiResid<true>, true>(F.lds, g, S, E);
        sg_resid(args, F, ACT, FF, (const bf16*)(ws + WS_W1OT), FF, nullptr, 0.5f, (float*)(ws + WS_SSQAS));
    }
    if constexpr (K == 3) {
        pg8::Gemm g{XB, XB, (const bf16*)(ws + WS_WAT), D, D, D, 1}; pg8::StaticOrder S; S.init(MP / 256, NA / 256, 1, F.G, (int)blockIdx.x);
        pg8::EpiProjA E{(bf16*)(ws + WS_T0), (bf16*)(ws + WS_T1), (bf16*)(ws + WS_T2), (bf16*)(ws + WS_T8), (bf16*)(ws + WS_SKV), (float*)(ws + WS_GLR), args.out, (const float*)(ws + WS_SSQA)};
        pg8::gemm_phase<pg8::EpiProjA, true>(F.lds, g, S, E);
        sg_proj(args, F);
    }
    if constexpr (K == 4) {
#define G1_SEQ(u) ((u) < NB * 64 * GH ? (u) >> 8 : NB + (((u) - NB * 64 * GH) >> 2))
#define G1_CHK(u) ((u) < NB * 64 * GH ? ((u) >> 2) & 63 : 0)
        const int hh = F.vcu & 3, dcol = F.tid & 127;
        float w[16];
#pragma unroll
        for (int r = 0; r < 16; ++r) w[r] = args.in[10][r * 512 + hh * 128 + dcol];
        const float bias = args.in[11][hh * 128 + dcol];
        G1Regs RA, RB;
        int u = F.vcu;
        if (u < NUNIT_G) g1_load(RA, args, G1_SEQ(u), G1_CHK(u), hh, F.tid);
        while (u < NUNIT_G) {
            const int u1 = u + F.G; if (u1 < NUNIT_G) g1_load(RB, args, G1_SEQ(u1), G1_CHK(u1), hh, F.tid);
            g1_compute(RA, w, bias, args, F, G1_SEQ(u), G1_CHK(u), hh);
            if (u1 >= NUNIT_G) break;
            const int u2 = u1 + F.G; if (u2 < NUNIT_G) g1_load(RA, args, G1_SEQ(u2), G1_CHK(u2), hh, F.tid);
            g1_compute(RB, w, bias, args, F, G1_SEQ(u1), G1_CHK(u1), hh);
            u = u2;
        }
#undef G1_SEQ
#undef G1_CHK
    }
    if constexpr (K == 5) {
        const int nh = F.G >> 1;
        constexpr int NSWA_P = NB * 64 * SKV, NSWA_S = NB * SKV;
        if ((F.vcu & 1) == 0) {
            for (int it = F.vcu >> 1; it < NB * GH * 4; it += nh) { g2_item<false>(args, F, it >> 2, it & 3); g2_item<true>(args, F, it >> 2, it & 3); }
        } else {
            for (int us = F.vcu >> 1; us < NSWA_S; us += nh) swa_unit(args, F, NB + (us >> 1), 0, us & 1);
        }
    }
    if constexpr (K == 12) {
        constexpr int NSWA_P = NB * 64 * SKV;
        unsigned* qhead = (unsigned*)(ws + WS_CTL) + 12288;
        volatile LAS unsigned* qslot = (volatile LAS unsigned*)(F.lds + MISC_OFF) + 16;
        unsigned t0 = 0, t1 = 0;
        if (F.tid == 0) { t0 = __hip_atomic_fetch_add(qhead, 1u, __ATOMIC_RELAXED, __HIP_MEMORY_SCOPE_AGENT); t1 = __hip_atomic_fetch_add(qhead, 1u, __ATOMIC_RELAXED, __HIP_MEMORY_SCOPE_AGENT); qslot[0] = t0; qslot[1] = t1; }
        __syncthreads();
        int u = (int)qslot[0], u1 = (int)qslot[1];
        SwaRegs RA, RB;
        if (u < NSWA_P) swa_p_load(RA, args, u, F.tid);
        while (u < NSWA_P) {
            unsigned tn = 0;
            if (F.tid == 0) tn = __hip_atomic_fetch_add(qhead, 1u, __ATOMIC_RELAXED, __HIP_MEMORY_SCOPE_AGENT);
            if (u1 < NSWA_P) swa_p_load(RB, args, u1, F.tid);
            swa_p_compute(RA, args, F, u);
            if (F.tid == 0) qslot[2] = tn;
            LDS_BAR();
            const int u2 = (int)qslot[2];
            if (u1 >= NSWA_P) break;
            if (F.tid == 0) tn = __hip_atomic_fetch_add(qhead, 1u, __ATOMIC_RELAXED, __HIP_MEMORY_SCOPE_AGENT);
            if (u2 < NSWA_P) swa_p_load(RA, args, u2, F.tid);
            swa_p_compute(RB, args, F, u1);
            if (F.tid == 0) qslot[3] = tn;
            LDS_BAR();
            u = u2; u1 = (int)qslot[3];
        }
        if (F.vcu & 1) {
            LDS_BAR();
            LAS float* scr = (LAS float*)(F.lds + F.wave * 16384);
            for (int l = (F.vcu >> 1) * NWAVES + F.wave; l < P0_NLATE; l += (F.G >> 1) * NWAVES) p0_weight_item(args, P0_NEARLY + l, scr, F.lane);
        }
    }
    if constexpr (K == 6) {
        bf16* OG = (bf16*)(ws + WS_T1); const bf16* GR = (const bf16*)(ws + WS_T8);
        for (int m0 = gw; m0 < M; m0 += 4 * NGW) {
            v4u ov[4][2], gv4[4][2];
#pragma unroll
            for (int r = 0; r < 4; ++r) { const int m = m0 + r * NGW; if (m < M) {
                ov[r][0] = *(const v4u*)(OG + (size_t)m * D + 16 * F.lane); ov[r][1] = *(const v4u*)(OG + (size_t)m * D + 16 * F.lane + 8);
                gv4[r][0] = *(const v4u*)(GR + (size_t)m * D + 16 * F.lane); gv4[r][1] = *(const v4u*)(GR + (size_t)m * D + 16 * F.lane + 8); } }
#pragma unroll
            for (int r = 0; r < 4; ++r) { const int m = m0 + r * NGW; if (m < M) {
                const v4u o0 = ov[r][0], o1 = ov[r][1], g0 = gv4[r][0], g1 = gv4[r][1];
                float ovf[16] = {bflo(o0.x), bfhi(o0.x), bflo(o0.y), bfhi(o0.y), bflo(o0.z), bfhi(o0.z), bflo(o0.w), bfhi(o0.w), bflo(o1.x), bfhi(o1.x), bflo(o1.y), bfhi(o1.y), bflo(o1.z), bfhi(o1.z), bflo(o1.w), bfhi(o1.w)};
                const float gvf[16] = {bflo(g0.x), bfhi(g0.x), bflo(g0.y), bfhi(g0.y), bflo(g0.z), bfhi(g0.z), bflo(g0.w), bfhi(g0.w), bflo(g1.x), bfhi(g1.x), bflo(g1.y), bfhi(g1.y), bflo(g1.z), bfhi(g1.z), bflo(g1.w), bfhi(g1.w)};
                float ss = 0.f;
#pragma unroll
                for (int j = 0; j < 16; ++j) ss += ovf[j] * ovf[j];
                ss += __shfl_xor(ss, 1); ss += __shfl_xor(ss, 2); ss += __shfl_xor(ss, 4); ss += __shfl_xor(ss, 8);
                const float rs = __builtin_amdgcn_rsqf(ss * (1.0f / GDV) + EPS);
#pragma unroll
                for (int j = 0; j < 16; ++j) ovf[j] = ovf[j] * rs * gvf[j];
                v4u w0, w1;
                w0.x = pk2(ovf[0], ovf[1]); w0.y = pk2(ovf[2], ovf[3]); w0.z = pk2(ovf[4], ovf[5]); w0.w = pk2(ovf[6], ovf[7]);
                w1.x = pk2(ovf[8], ovf[9]); w1.y = pk2(ovf[10], ovf[11]); w1.z = pk2(ovf[12], ovf[13]); w1.w = pk2(ovf[14], ovf[15]);
                *(v4u*)(OG + (size_t)m * D + 16 * F.lane) = w0; *(v4u*)(OG + (size_t)m * D + 16 * F.lane + 8) = w1; } }
        }
        __syncthreads();
        pg8::Gemm g{XB, XB, (const bf16*)(ws + WS_WBT), D, D, D, 1}; pg8::StaticOrder S; S.init(MP / 256, NBP / 256, 1, F.G, (int)blockIdx.x);
        pg8::EpiProjB E{(bf16*)(ws + WS_T0), (bf16*)(ws + WS_T7), (const float*)(ws + WS_SSQA)};
        pg8::gemm_phase<pg8::EpiProjB, true>(F.lds, g, S, E);
        sg_gates(args, F);
    }
    if constexpr (K == 7) {
        pg8::Gemm g{(const bf16*)(ws + WS_T1), (const bf16*)(ws + WS_T2), (const bf16*)(ws + WS_WBRT), D, 2 * D, D, 2}; pg8::StaticOrder S; S.init(MP / 256, D / 256, 2, F.G, (int)blockIdx.x);
        pg8::EpiBranch E{(const bf16*)(ws + WS_T0), (const bf16*)(ws + WS_T7), (bf16*)(ws + WS_T8)};
        pg8::gemm_phase<pg8::EpiBranch, true>(F.lds, g, S, E);
        sg_branch(args, F);
    }
    if constexpr (K == 8) {
        pg8::Gemm g{(const bf16*)(ws + WS_T8), (const bf16*)(ws + WS_T8), (const bf16*)(ws + WS_WOUTT), D, D, D, 1}; pg8::StaticOrder S; S.init(MP / 256, D / 256, 1, F.G, (int)blockIdx.x);
        pg8::EpiResid<true> E{nullptr, XB, (float*)(ws + WS_SSQB), 1.0f};
        pg8::gemm_phase<pg8::EpiResid<true>, true>(F.lds, g, S, E);
        sg_resid(args, F, (const bf16*)(ws + WS_T8), D, (const bf16*)(ws + WS_WOUTT), D, nullptr, 1.0f, (float*)(ws + WS_SSQBS));
    }
    if constexpr (K == 9) {
        pg8::Gemm g{XB, XB, (const bf16*)(ws + WS_W2T), D, D, D, 1}; pg8::StaticOrder S; S.init(MP / 256, 2 * FF / 256, 1, F.G, (int)blockIdx.x);
        pg8::EpiSwiglu E{ACT, (const float*)(ws + WS_SSQB)};
        pg8::gemm_phase<pg8::EpiSwiglu, true>(F.lds, g, S, E);
        sg_swiglu(args, F, (const bf16*)(ws + WS_W2T), (const float*)(ws + WS_SSQBS));
    }
    if constexpr (K == 10) {
        pg8::Gemm g{ACT, ACT, (const bf16*)(ws + WS_W2OT), FF, FF, FF, 1}; pg8::StaticOrder S; S.init(MP / 256, D / 256, 1, F.G, (int)blockIdx.x);
        pg8::EpiFinal E{XB, X, args.in[20], (unsigned*)(ws + WS_XSLOT), (unsigned*)(ws + WS_CTL) + CW_PAN, 0.5f};
        pg8::gemm_phase<pg8::EpiFinal, true>(F.lds, g, S, E);
        sg_resid(args, F, ACT, FF, (const bf16*)(ws + WS_W2OT), FF, nullptr, 0.5f, nullptr);
    }
    if constexpr (K == 11) {
        const f32x4* gf = (const f32x4*)args.in[20];
        f32x4 g4[4];
#pragma unroll
        for (int q = 0; q < 4; ++q) g4[q] = gf[4 * F.lane + q];
        for (int m0 = MP + gw; m0 < M; m0 += 4 * NGW) {
            v4u xv[4][2];
#pragma unroll
            for (int r = 0; r < 4; ++r) { const int m = m0 + r * NGW; if (m < M) { xv[r][0] = *(const v4u*)(XB + (size_t)m * D + 16 * F.lane); xv[r][1] = *(const v4u*)(XB + (size_t)m * D + 16 * F.lane + 8); } }
#pragma unroll
            for (int r = 0; r < 4; ++r) { const int m = m0 + r * NGW; if (m < M) {
                const v4u x0 = xv[r][0], x1 = xv[r][1];
                float v[16] = {bflo(x0.x), bfhi(x0.x), bflo(x0.y), bfhi(x0.y), bflo(x0.z), bfhi(x0.z), bflo(x0.w), bfhi(x0.w), bflo(x1.x), bfhi(x1.x), bflo(x1.y), bfhi(x1.y), bflo(x1.z), bfhi(x1.z), bflo(x1.w), bfhi(x1.w)};
                float s2 = 0.f;
#pragma unroll
                for (int j = 0; j < 16; ++j) s2 += v[j] * v[j];
                const float rs = __builtin_amdgcn_rsqf(wave_sum(s2) * (1.0f / D) + EPS);
                f32x4* yr = (f32x4*)(X + (size_t)m * D + 16 * F.lane);
#pragma unroll
                for (int q = 0; q < 4; ++q) yr[q] = (f32x4){v[4 * q] * rs * g4[q][0], v[4 * q + 1] * rs * g4[q][1], v[4 * q + 2] * rs * g4[q][2], v[4 * q + 3] * rs * g4[q][3]}; } }
        }
    }
}

#ifndef MK_SEQ
#define MK_SEQ P(0) S P(1) S P(2) S P(3) S P(4) S P(5) P(12) S P(6) S P(7) S P(8) S P(9) S P(10) S P(11)
#endif
__global__ void __launch_bounds__(NWAVES * 64, 2) mk_fwd(Args args) {
    extern __shared__ __attribute__((aligned(16))) unsigned char lds[];
    LAS unsigned char* ldsp = (LAS unsigned char*)lds;
    volatile LAS unsigned* MISC = (volatile LAS unsigned*)(ldsp + MISC_OFF);
    if (threadIdx.x < 32) MISC[threadIdx.x] = 0u;
    __syncthreads();
    XcdBarrier bar = xcd_barrier_post((unsigned*)(args.ws + WS_CTL) + 4096, MISC + 8);
#define P(k) if (args.ph_hi > (k)) run_phase<k>(args, ldsp);
#define S xcd_barrier(bar);
    MK_SEQ
#undef P
#undef S
}

extern "C" void kernel_launch(void* const* d_in, const int* in_sizes, int n_in, void* d_out, int out_size, void* d_ws, size_t ws_size, hipStream_t stream) {
    static int grid = 0;
    if (grid == 0) {
        if (n_in != 21 || in_sizes[0] != MP * D || (size_t)out_size != O_END || ws_size < WS_END) { fprintf(stderr, "kernel_launch: unexpected shapes (n_in %d in0 %d out %d ws %zu need %zu)\n", n_in, n_in > 0 ? in_sizes[0] : -1, out_size, ws_size, (size_t)WS_END); grid = -1; return; }
        int dev = 0, cus = 0, per_cu = 0;
        if (hipGetDevice(&dev) != hipSuccess || hipDeviceGetAttribute(&cus, hipDeviceAttributeMultiprocessorCount, dev) != hipSuccess) { grid = -1; return; }
        if (hipFuncSetAttribute((const void*)mk_fwd, hipFuncAttributeMaxDynamicSharedMemorySize, LDS_BYTES) != hipSuccess) { fprintf(stderr, "kernel_launch: hipFuncSetAttribute failed\n"); grid = -1; return; }
        if (hipOccupancyMaxActiveBlocksPerMultiprocessor(&per_cu, (const void*)mk_fwd, NWAVES * 64, LDS_BYTES) != hipSuccess || per_cu < 1) { fprintf(stderr, "kernel_launch: occupancy query says %d\n", per_cu); per_cu = 1; }
        (void)hipGetLastError();
        grid = cus;
    }
    if (grid < 0) return;
    Args a{};
    for (int i = 0; i < 21; ++i) a.in[i] = (const float*)d_in[i];
    a.out = (float*)d_out; a.ws = (unsigned char*)d_ws;
    if (hipMemsetAsync((char*)d_ws + WS_CTL, 0, 65536, stream) != hipSuccess) { fprintf(stderr, "kernel_launch: memset failed\n"); return; }
    a.ph_lo = 0; a.ph_hi = 13;
    void* kargs[] = {&a};
    hipError_t e = hipLaunchCooperativeKernel((const void*)mk_fwd, dim3(grid), dim3(NWAVES * 64), kargs, LDS_BYTES, stream);
    if (e != hipSuccess) fprintf(stderr, "kernel_launch: cooperative launch failed: %s\n", hipGetErrorString(e));
}
```

```cpp
#include <hip/hip_runtime.h>
#include <hip/hip_cooperative_groups.h>
#include <cstdio>
#include <cstdint>
namespace cg = cooperative_groups;


constexpr int D = 1024, NB = 8, SEQ = 4096, DEC_T = 32;
constexpr int MP = NB * SEQ, MS = NB * DEC_T, M = MP + MS;
constexpr int FF = 2816;
constexpr int GH = 4, GDK = 128, GDV = 256, GRANK = 16;
constexpr int SH = 16, SKV = 2, SHD = 64, WINDOW = 128;
constexpr float EPS = 1e-6f;
constexpr float LOG2E = 1.4426950408889634f;
constexpr int NA = 18 * 256;
constexpr int NBP = 8 * 256;
constexpr int S_GQ = 0, S_GK = 512, S_GV = 1024, S_GR = 2048, S_GLR = 3072, S_SQ = 3088, S_SK = 4112, S_SV = 4240, S_GG = 4368, S_GS = 5392, IN_W = 6416;

constexpr size_t O_Y = 0;
constexpr size_t O_SGP = (size_t)M * D;
constexpr size_t O_CKP = O_SGP + (size_t)NB * GH * GDK * GDV;
constexpr size_t O_CVP = O_CKP + (size_t)NB * WINDOW * SKV * SHD;
constexpr size_t O_SGS = O_CVP + (size_t)NB * WINDOW * SKV * SHD;
constexpr size_t O_CKS = O_SGS + (size_t)NB * GH * GDK * GDV;
constexpr size_t O_CVS = O_CKS + (size_t)NB * WINDOW * SKV * SHD;
constexpr size_t O_END = O_CVS + (size_t)NB * WINDOW * SKV * SHD;

constexpr size_t MiB = 1u << 20;
constexpr size_t R1 = (size_t)M * D * 2;
constexpr size_t WS_CTL = 0;
constexpr size_t WS_W1T = 1 * MiB;
constexpr size_t WS_W1OT = WS_W1T + (size_t)2 * FF * D * 2;
constexpr size_t WS_WAT = WS_W1OT + (size_t)D * FF * 2;
constexpr size_t WS_WBT = WS_WAT + (size_t)NA * D * 2;
constexpr size_t WS_WBRT = WS_WBT + (size_t)NBP * D * 2;
constexpr size_t WS_WOUTT = WS_WBRT + (size_t)D * 2 * D * 2;
constexpr size_t WS_W2T = WS_WOUTT + (size_t)D * D * 2;
constexpr size_t WS_W2OT = WS_W2T + (size_t)2 * FF * D * 2;
constexpr size_t WS_SSQ0 = WS_W2OT + (size_t)D * FF * 2;
constexpr size_t SSQ_BYTES = (size_t)M * 16 * 4;
constexpr size_t WS_SSQA = WS_SSQ0 + SSQ_BYTES;
constexpr size_t WS_SSQB = WS_SSQA + SSQ_BYTES;
constexpr int NUNIT_G = NB * 64 * GH + NB * GH;
constexpr size_t SSQS_BYTES = (size_t)MS * 64 * 4;
constexpr size_t WS_SSQ0S = WS_SSQB + SSQ_BYTES, WS_SSQAS = WS_SSQ0S + SSQS_BYTES, WS_SSQBS = WS_SSQAS + SSQS_BYTES;
constexpr size_t WS_GDEC = WS_SSQBS + SSQS_BYTES;
constexpr size_t WS_XB = (WS_GDEC + (size_t)NUNIT_G * 128 * 4 + 4095) & ~(size_t)4095;
constexpr size_t WS_T0 = WS_XB + R1;
constexpr size_t WS_T1 = WS_T0 + R1;
constexpr size_t WS_T2 = WS_T1 + R1;
constexpr size_t WS_T7 = WS_T2 + R1;
constexpr size_t WS_T8 = WS_T7 + R1;
constexpr size_t WS_SKV = WS_T8 + R1;
constexpr size_t WS_ABUF = WS_SKV + (size_t)M * 256 * 2;
constexpr size_t WS_GLR = WS_ABUF + (size_t)M * 256 * 2;
constexpr size_t WS_XSLOT = (WS_GLR + (size_t)M * 16 * 4 + 4095) & ~(size_t)4095;
constexpr size_t WS_END = WS_XSLOT + (size_t)(MP / 256) * 256 * 4 * 4;
constexpr int CW_PAN = 13312, CW_PAN_STRIDE = 16;
constexpr size_t WS_ACT = WS_T0;
static_assert((size_t)M * FF * 2 <= 5 * R1, "act overlay");
static_assert(WS_END <= 512 * MiB, "workspace map must fit 512 MiB");

constexpr int RING_BYTES = 131072;
constexpr int PHASE_LDS = 155648;
constexpr int MISC_OFF = PHASE_LDS + 320;
constexpr int LDS_BYTES = 159744;
constexpr int NWAVES = 8;

#define GAS __attribute__((address_space(1)))
#define LAS __attribute__((address_space(3)))
typedef unsigned short bf16;
typedef unsigned v4u __attribute__((ext_vector_type(4)));
typedef unsigned v2u __attribute__((ext_vector_type(2)));
typedef float f32x4 __attribute__((ext_vector_type(4)));
typedef float f32x16 __attribute__((ext_vector_type(16)));
typedef short bf16x8 __attribute__((ext_vector_type(8)));
typedef float f32x2_t __attribute__((ext_vector_type(2)));
typedef __bf16 bf16x2_t __attribute__((ext_vector_type(2)));
#define LDS_WAIT() asm volatile("s_waitcnt lgkmcnt(0)" ::: "memory")
#define VM_WAIT() asm volatile("s_waitcnt vmcnt(0)" ::: "memory")
#define LDS_BAR() do { asm volatile("s_waitcnt lgkmcnt(0)" ::: "memory"); __builtin_amdgcn_s_barrier(); asm volatile("" ::: "memory"); } while (0)
__device__ __forceinline__ unsigned pk2(float lo, float hi) { f32x2_t v = {lo, hi}; bf16x2_t b = __builtin_convertvector(v, bf16x2_t); return __builtin_bit_cast(unsigned, b); }
__device__ __forceinline__ unsigned short f2bf(float f) { return (unsigned short)(pk2(f, 0.f) & 0xffffu); }
__device__ __forceinline__ float bf2f(unsigned short b) { return __uint_as_float((unsigned)b << 16); }
__device__ __forceinline__ float bflo(unsigned w) { return __uint_as_float(w << 16); }
__device__ __forceinline__ float bfhi(unsigned w) { return __uint_as_float(w & 0xffff0000u); }
__device__ __forceinline__ float fast_exp2(float x) { return __builtin_amdgcn_exp2f(x); }
__device__ __forceinline__ float fast_exp(float x) { return __builtin_amdgcn_exp2f(x * LOG2E); }
__device__ __forceinline__ float fast_rcp(float x) { return __builtin_amdgcn_rcpf(x); }
__device__ __forceinline__ float sigmoidf_(float x) { return fast_rcp(1.0f + fast_exp(-x)); }
__device__ __forceinline__ float siluf_(float x) { return x * sigmoidf_(x); }
__device__ __forceinline__ float wave_sum(float v) {
#pragma unroll
    for (int o = 1; o < 64; o <<= 1) v += __shfl_xor(v, o);
    return v;
}
__device__ __forceinline__ void rows_rstd(float (&rs)[2][4], const float* ssqp, int row0, int fq) {
    f32x4 q[2][4];
#pragma unroll
    for (int ai = 0; ai < 2; ++ai)
#pragma unroll
        for (int m = 0; m < 4; ++m) q[ai][m] = *(const f32x4*)(ssqp + (size_t)(row0 + ai * 128 + m * 16) * 16 + fq * 4);
#pragma unroll
    for (int ai = 0; ai < 2; ++ai)
#pragma unroll
        for (int m = 0; m < 4; ++m) { float s = (q[ai][m].x + q[ai][m].y) + (q[ai][m].z + q[ai][m].w); s += __shfl_xor(s, 16); s += __shfl_xor(s, 32); rs[ai][m] = __builtin_amdgcn_rsqf(s * (1.0f / D) + EPS); }
}
__device__ __forceinline__ float row_rstd(const float* ssqp, int row) {
    const f32x4* p = (const f32x4*)(ssqp + (size_t)row * 16);
    const f32x4 a = p[0], b = p[1], c = p[2], d = p[3];
    const float s = ((a.x + a.y) + (a.z + a.w)) + ((b.x + b.y) + (b.z + b.w)) + ((c.x + c.y) + (c.z + c.w)) + ((d.x + d.y) + (d.z + d.w));
    return __builtin_amdgcn_rsqf(s * (1.0f / D) + EPS);
}

namespace pg8 {
#define PG8_LAS __attribute__((address_space(3)))
typedef unsigned short bf16_t;
typedef unsigned u32x4 __attribute__((ext_vector_type(4)));
constexpr int BM = 256, BK = 64, HALF = 128, HTB = HALF * BK * 2, STAGE_BYTES = 8 * HTB, NXCD = 8, WGM = 8;
__host__ __device__ __forceinline__ int lds_byte(int r, int c) { const int st = (r >> 4) * 2 + (c >> 5), rr = r & 15, cc = c & 31, ob = rr * 64 + cc * 2; return st * 1024 + (ob ^ (((ob >> 9) & 1) << 5)); }
__host__ __device__ __forceinline__ void stage_rc(int b, int& R, int& C) { const int st = b / 1024, sb = b % 1024, swz = sb ^ (((sb >> 9) & 1) << 5); R = (st >> 1) * 16 + swz / 64; C = (st & 1) * 32 + (swz % 64) / 2; }
__host__ __device__ __forceinline__ int perm32(int rho) { const int n = rho >> 4, i = rho & 15; return 8 * (i >> 2) + 4 * n + (i & 3); }

struct Unit { int pm, pn, sub; };
struct Gemm { const bf16_t* A0; const bf16_t* A1; const bf16_t* Bt; int lda, ldb, K, nsub; };

struct StaticOrder {
    int nM, nN, nwg, G, c, nsub;
    __device__ void init(int nM_, int nN_, int nsub_, int G_, int c_) { nM = nM_; nN = nN_; nwg = nM * nN; G = G_; c = c_; nsub = nsub_; }
    __device__ bool next(int i, Unit& u) const {
        const int ti = i / nsub; u.sub = i - ti * nsub;
        const long L = (long)ti * G + c; if (L >= nwg) return false;
        int wgid = (int)L; { const int q = nwg / NXCD, r = nwg % NXCD, xcd = wgid % NXCD, off = wgid / NXCD; wgid = (xcd < r ? xcd * (q + 1) : r * (q + 1) + (xcd - r) * q) + off; }
        const int nig = WGM * nN, gid = wgid / nig, fm = gid * WGM, gsz = (nM - fm) < WGM ? (nM - fm) : WGM;
        u.pm = fm + ((wgid % nig) % gsz); u.pn = (wgid % nig) / gsz; return true;
    }
};

typedef f32x4 Acc[2][2][4][2];

struct EpiSwiglu {
    static constexpr bool PERM = true, FUSED = false;
    bf16_t* O; const float* ssqp;
    __device__ __forceinline__ bool keep(const Unit&) const { return false; }
    __device__ __forceinline__ void operator()(Acc& acc, const Unit& u, int wr, int wc, int fr, int fq) const {
        const int row0 = u.pm * BM + wr * 64 + fr, col0 = u.pn * HALF + wc * 32 + 8 * fq;
        float rsa[2][4]; rows_rstd(rsa, ssqp, row0, fq);
#pragma unroll
        for (int ai = 0; ai < 2; ++ai)
#pragma unroll
            for (int m = 0; m < 4; ++m) {
                const int row = row0 + ai * HALF + m * 16; const float rs = rsa[ai][m];
                float o[8];
#pragma unroll
                for (int n = 0; n < 2; ++n)
#pragma unroll
                    for (int j = 0; j < 4; ++j) { const float g = acc[ai][0][m][n][j] * rs, up = acc[ai][1][m][n][j] * rs; o[n * 4 + j] = siluf_(g) * up; }
                u32x4 w; w.x = pk2(o[0], o[1]); w.y = pk2(o[2], o[3]); w.z = pk2(o[4], o[5]); w.w = pk2(o[6], o[7]);
                *(u32x4*)(O + (size_t)row * FF + col0) = w;
            }
    }
};
template <bool RES_BF16> struct EpiResid {
    static constexpr bool PERM = true, FUSED = false;
    const float* res_f32; bf16_t* XBo; float* ssqp; float alpha;
    __device__ __forceinline__ bool keep(const Unit&) const { return false; }
    __device__ __forceinline__ void operator()(Acc& acc, const Unit& u, int wr, int wc, int fr, int fq) const {
        const int col0 = u.pn * BM + wc * 32 + 8 * fq;
        const char* rbase = (const char*)XBo + (size_t)u.pm * BM * D * 2; const unsigned loff = (unsigned)((wr * 64 + fr) * D + col0) * 2u;
        u32x4 rb[2][4][2];
        if (RES_BF16) {
#pragma unroll
            for (int ai = 0; ai < 2; ++ai)
#pragma unroll
                for (int m = 0; m < 4; ++m)
#pragma unroll
                    for (int bj = 0; bj < 2; ++bj) rb[ai][m][bj] = *(const u32x4*)(rbase + (size_t)((ai * HALF + m * 16) * D + bj * HALF) * 2 + loff);
        }
#pragma unroll
        for (int ai = 0; ai < 2; ++ai)
#pragma unroll
            for (int m = 0; m < 4; ++m) {
                const int row = u.pm * BM + ai * HALF + wr * 64 + m * 16 + fr;
                float ss = 0.f;
#pragma unroll
                for (int bj = 0; bj < 2; ++bj) {
                    const size_t off = (size_t)row * D + col0 + bj * HALF;
                    f32x4 r0, r1;
                    if (RES_BF16) { const u32x4 q = rb[ai][m][bj]; r0 = (f32x4){bflo(q.x), bfhi(q.x), bflo(q.y), bfhi(q.y)}; r1 = (f32x4){bflo(q.z), bfhi(q.z), bflo(q.w), bfhi(q.w)}; }
                    else { r0 = *(const f32x4*)(res_f32 + off); r1 = *(const f32x4*)(res_f32 + off + 4); }
                    const f32x4 v0 = r0 + acc[ai][bj][m][0] * alpha, v1 = r1 + acc[ai][bj][m][1] * alpha;
                    u32x4 w; w.x = pk2(v0[0], v0[1]); w.y = pk2(v0[2], v0[3]); w.z = pk2(v1[0], v1[1]); w.w = pk2(v1[2], v1[3]);
                    *(u32x4*)((char*)rbase + (size_t)((ai * HALF + m * 16) * D + bj * HALF) * 2 + loff) = w;
                    ss += (v0[0] * v0[0] + v0[1] * v0[1]) + (v0[2] * v0[2] + v0[3] * v0[3]) + (v1[0] * v1[0] + v1[1] * v1[1]) + (v1[2] * v1[2] + v1[3] * v1[3]);
                }
                ss += __shfl_xor(ss, 16); ss += __shfl_xor(ss, 32);
                if (ssqp && fq == 0) ssqp[(size_t)row * 16 + u.pn * 4 + wc] = ss;
                if (!RES_BF16 && (m & 1)) asm volatile("" ::: "memory");
            }
    }
};
struct EpiProjA {
    static constexpr bool PERM = true, FUSED = false;
    bf16_t *QK, *V, *SQ, *GR, *SKVb; float* GLR; float* out; const float* ssqp;
    __device__ __forceinline__ bool keep(const Unit&) const { return false; }
    __device__ __forceinline__ void operator()(Acc& acc, const Unit& u, int wr, int wc, int fr, int fq) const {
        const int pn = u.pn;
        bf16_t* dst; int ld = D, cbase; float scale = 1.f; int mode = 0;
        if (pn < 4) { dst = QK; cbase = pn * BM; if (pn < 2) scale = 0.08838834764831845f; }
        else if (pn < 8) { dst = V; cbase = (pn - 4) * BM; }
        else if (pn < 12) { dst = SQ; cbase = (pn - 8) * BM; scale = 0.125f * LOG2E; }
        else if (pn < 16) { dst = GR; cbase = (pn - 12) * BM; mode = 1; }
        else if (pn == 16) { dst = SKVb; ld = 256; cbase = 0; mode = 2; }
        else { dst = SKVb; cbase = 0; mode = 3; }
        float rsa[2][4]; rows_rstd(rsa, ssqp, u.pm * BM + wr * 64 + fr, fq);
#pragma unroll
        for (int ai = 0; ai < 2; ++ai)
#pragma unroll
            for (int m = 0; m < 4; ++m) {
                const int row = u.pm * BM + ai * HALF + wr * 64 + m * 16 + fr; const float rs = rsa[ai][m] * scale;
#pragma unroll
                for (int bj = 0; bj < 2; ++bj) {
                    const int within = bj * HALF + wc * 32 + 8 * fq;
                    f32x4 v0 = acc[ai][bj][m][0] * rs, v1 = acc[ai][bj][m][1] * rs;
                    if (mode == 3) { if (within < GRANK) { *(f32x4*)(GLR + (size_t)row * 16 + within) = v0; *(f32x4*)(GLR + (size_t)row * 16 + within + 4) = v1; } continue; }
                    if (mode == 1) {
#pragma unroll
                        for (int j = 0; j < 4; ++j) { v0[j] = siluf_(v0[j]); v1[j] = siluf_(v1[j]); }
                    }
                    u32x4 w; w.x = pk2(v0[0], v0[1]); w.y = pk2(v0[2], v0[3]); w.z = pk2(v1[0], v1[1]); w.w = pk2(v1[2], v1[3]);
                    *(u32x4*)(dst + (size_t)row * ld + cbase + within) = w;
                    if (mode == 2) {
                        float* cp = nullptr;
                        if (u.pm >= MP / BM) { const int rs_ = row - MP, bs = rs_ >> 5, t = rs_ & 31; cp = out + (bj == 0 ? O_CKS : O_CVS) + ((size_t)(bs * WINDOW + 96 + t)) * 128 + (within & 127); }
                        else if ((u.pm & 15) == 15 && ai == 1) { const int b = row >> 12, t = row & 4095; cp = out + (bj == 0 ? O_CKP : O_CVP) + ((size_t)(b * WINDOW + (t - (SEQ - WINDOW)))) * 128 + (within & 127); }
                        if (cp) { *(f32x4*)cp = v0; *(f32x4*)(cp + 4) = v1; }
                    }
                }
            }
    }
};
struct EpiProjB {
    static constexpr bool PERM = true, FUSED = false;
    bf16_t *R, *SS; const float* ssqp;
    __device__ __forceinline__ bool keep(const Unit&) const { return false; }
    __device__ __forceinline__ void operator()(Acc& acc, const Unit& u, int wr, int wc, int fr, int fq) const {
        const int row0 = u.pm * BM + wr * 64 + fr, col0 = u.pn * HALF + wc * 32 + 8 * fq;
        float rsa[2][4]; rows_rstd(rsa, ssqp, row0, fq);
#pragma unroll
        for (int ai = 0; ai < 2; ++ai)
#pragma unroll
            for (int m = 0; m < 4; ++m) {
                const int row = row0 + ai * HALF + m * 16; const float rs = rsa[ai][m];
                float r[8], ss[8];
#pragma unroll
                for (int n = 0; n < 2; ++n)
#pragma unroll
                    for (int j = 0; j < 4; ++j) { const float eg = fast_exp(-acc[ai][0][m][n][j] * rs), es = fast_exp(-acc[ai][1][m][n][j] * rs);
                        ss[n * 4 + j] = fast_rcp(1.0f + es); r[n * 4 + j] = (1.0f + es) * fast_rcp(1.0f + eg); }
                u32x4 w; w.x = pk2(r[0], r[1]); w.y = pk2(r[2], r[3]); w.z = pk2(r[4], r[5]); w.w = pk2(r[6], r[7]);
                *(u32x4*)(R + (size_t)row * D + col0) = w;
                w.x = pk2(ss[0], ss[1]); w.y = pk2(ss[2], ss[3]); w.z = pk2(ss[4], ss[5]); w.w = pk2(ss[6], ss[7]);
                *(u32x4*)(SS + (size_t)row * D + col0) = w;
            }
    }
};
struct EpiBranch {
    static constexpr bool PERM = true, FUSED = false;
    const bf16_t *R, *SS; bf16_t* O;
    __device__ __forceinline__ bool keep(const Unit& u) const { return u.sub == 0; }
    __device__ __forceinline__ void operator()(Acc& acc, const Unit& u, int wr, int wc, int fr, int fq) const {
        const int col0 = u.pn * BM + wc * 32 + 8 * fq;
        const bf16_t* G = u.sub == 0 ? R : SS;
        const size_t tbase = (size_t)u.pm * BM * D * 2; const unsigned loff = (unsigned)((wr * 64 + fr) * D + col0) * 2u;
        const char* gbase = (const char*)G + tbase; char* obase = (char*)O + tbase;
        u32x4 gq[2][4][2];
#pragma unroll
        for (int ai = 0; ai < 2; ++ai)
#pragma unroll
            for (int m = 0; m < 4; ++m)
#pragma unroll
                for (int bj = 0; bj < 2; ++bj) gq[ai][m][bj] = *(const u32x4*)(gbase + (size_t)((ai * HALF + m * 16) * D + bj * HALF) * 2 + loff);
#pragma unroll
        for (int ai = 0; ai < 2; ++ai)
#pragma unroll
            for (int m = 0; m < 4; ++m) {
#pragma unroll
                for (int bj = 0; bj < 2; ++bj) {
                    const u32x4 s = gq[ai][m][bj];
                    const float gv[8] = {bflo(s.x), bfhi(s.x), bflo(s.y), bfhi(s.y), bflo(s.z), bfhi(s.z), bflo(s.w), bfhi(s.w)};
                    if (u.sub == 0) {
#pragma unroll
                        for (int j = 0; j < 4; ++j) { acc[ai][bj][m][0][j] *= gv[j]; acc[ai][bj][m][1][j] *= gv[4 + j]; }
                    } else {
                        float o[8];
#pragma unroll
                        for (int j = 0; j < 4; ++j) { o[j] = acc[ai][bj][m][0][j] * gv[j]; o[4 + j] = acc[ai][bj][m][1][j] * gv[4 + j]; }
                        u32x4 w; w.x = pk2(o[0], o[1]); w.y = pk2(o[2], o[3]); w.z = pk2(o[4], o[5]); w.w = pk2(o[6], o[7]);
                        *(u32x4*)(obase + (size_t)((ai * HALF + m * 16) * D + bj * HALF) * 2 + loff) = w;
                    }
                }
            }
    }
};
constexpr int EX_OFF = 131072;
struct EpiFinal {
    static constexpr bool PERM = true, FUSED = true;
    const bf16_t* XBr; float* Y; const float* gfin; unsigned* xslot; unsigned* cnt; float alpha;
    __device__ __forceinline__ bool keep(const Unit&) const { return false; }
    __device__ __forceinline__ void fused(Acc& acc, const Unit& u, int wr, int wc, int fr, int fq, PG8_LAS unsigned char* lds, int wid, int lane) const {
        PG8_LAS float* P = (PG8_LAS float*)(lds + EX_OFF); PG8_LAS float* Sx = (PG8_LAS float*)(lds + EX_OFF + 4096);
        const int col0 = u.pn * BM + wc * 32 + 8 * fq;
        const char* rbase = (const char*)XBr + (size_t)u.pm * BM * D * 2; const unsigned loff = (unsigned)((wr * 64 + fr) * D + col0) * 2u;
        u32x4 rq[2][4][2];
#pragma unroll
        for (int ai = 0; ai < 2; ++ai)
#pragma unroll
            for (int m = 0; m < 4; ++m)
#pragma unroll
                for (int bj = 0; bj < 2; ++bj) rq[ai][m][bj] = *(const u32x4*)(rbase + (size_t)((ai * HALF + m * 16) * D + bj * HALF) * 2 + loff);
#pragma unroll
        for (int ai = 0; ai < 2; ++ai)
#pragma unroll
            for (int m = 0; m < 4; ++m) {
                const int lr = ai * HALF + wr * 64 + m * 16 + fr;
                float ss = 0.f;
#pragma unroll
                for (int bj = 0; bj < 2; ++bj) {
                    const u32x4 rb = rq[ai][m][bj];
                    const f32x4 r0 = {bflo(rb.x), bfhi(rb.x), bflo(rb.y), bfhi(rb.y)}, r1 = {bflo(rb.z), bfhi(rb.z), bflo(rb.w), bfhi(rb.w)};
                    const f32x4 v0 = r0 + acc[ai][bj][m][0] * alpha, v1 = r1 + acc[ai][bj][m][1] * alpha;
                    acc[ai][bj][m][0] = v0; acc[ai][bj][m][1] = v1;
                    ss += (v0[0] * v0[0] + v0[1] * v0[1]) + (v0[2] * v0[2] + v0[3] * v0[3]) + (v1[0] * v1[0] + v1[1] * v1[1]) + (v1[2] * v1[2] + v1[3] * v1[3]);
                }
                ss += __shfl_xor(ss, 16); ss += __shfl_xor(ss, 32);
                if (fq == 0) P[lr * 4 + wc] = ss;
            }
        asm volatile("s_waitcnt lgkmcnt(0)" ::: "memory"); __builtin_amdgcn_s_barrier(); asm volatile("" ::: "memory");
        const int row = wid * 32 + (lane & 31);
        if (lane < 32) {
            const float s4 = (P[row * 4 + 0] + P[row * 4 + 1]) + (P[row * 4 + 2] + P[row * 4 + 3]);
            __hip_atomic_store(xslot + ((size_t)(u.pm * BM + row) * 4 + u.pn), __float_as_uint(s4), __ATOMIC_RELAXED, __HIP_MEMORY_SCOPE_AGENT);
        }
        asm volatile("s_waitcnt vmcnt(0)" ::: "memory");
        if (lane == 0) __hip_atomic_fetch_add(cnt + CW_PAN_STRIDE * u.pm, 1u, __ATOMIC_RELAXED, __HIP_MEMORY_SCOPE_AGENT);
        if (wid == 0) {
            unsigned spins = 0;
            while ((unsigned)__builtin_amdgcn_readfirstlane((int)__hip_atomic_load(cnt + CW_PAN_STRIDE * u.pm, __ATOMIC_RELAXED, __HIP_MEMORY_SCOPE_AGENT)) < 32u) { __builtin_amdgcn_s_sleep(2); if (++spins > (1u << 24)) break; }
            __builtin_amdgcn_fence(__ATOMIC_ACQUIRE, "agent");
        }
        asm volatile("s_waitcnt vmcnt(0) lgkmcnt(0)" ::: "memory"); __builtin_amdgcn_s_barrier(); asm volatile("" ::: "memory");
        if (lane < 32) {
            const unsigned* sl = xslot + (size_t)(u.pm * BM + row) * 4; float t = 0.f;
#pragma unroll
            for (int q = 0; q < 4; ++q) t += __uint_as_float(__hip_atomic_load(sl + q, __ATOMIC_RELAXED, __HIP_MEMORY_SCOPE_AGENT));
            Sx[row] = __builtin_amdgcn_rsqf(t * (1.0f / D) + EPS);
        }
        asm volatile("s_waitcnt lgkmcnt(0)" ::: "memory"); __builtin_amdgcn_s_barrier(); asm volatile("" ::: "memory");
        f32x4 gv[2][2];
#pragma unroll
        for (int bj = 0; bj < 2; ++bj) { gv[bj][0] = *(const f32x4*)(gfin + col0 + bj * HALF); gv[bj][1] = *(const f32x4*)(gfin + col0 + bj * HALF + 4); }
#pragma unroll
        for (int ai = 0; ai < 2; ++ai)
#pragma unroll
            for (int m = 0; m < 4; ++m) {
                const int lr = ai * HALF + wr * 64 + m * 16 + fr; const size_t grow = (size_t)(u.pm * BM + lr) * D; const float rs = Sx[lr];
#pragma unroll
                for (int bj = 0; bj < 2; ++bj) {
                    *(f32x4*)(Y + grow + col0 + bj * HALF) = acc[ai][bj][m][0] * rs * gv[bj][0];
                    *(f32x4*)(Y + grow + col0 + bj * HALF + 4) = acc[ai][bj][m][1] * rs * gv[bj][1];
                }
            }
    }
};

template <class Epi, bool ALIGN_EPI>
__device__ __forceinline__ void gemm_phase(PG8_LAS unsigned char* lds, const Gemm g, const StaticOrder& S, const Epi& E) {
    const int tid = threadIdx.x, wid = __builtin_amdgcn_readfirstlane(tid >> 6), lane = tid & 63, wr = wid >> 2, wc = wid & 3, fr = lane & 15, fq = lane >> 4;
    const int K = g.K, nt = K / BK;
    unsigned voffA[2], voffB[2];
#pragma unroll
    for (int i = 0; i < 2; ++i) { int R, C; stage_rc(tid * 16 + i * 8192, R, C); const int Rb = Epi::PERM ? ((R & ~31) + perm32(R & 31)) : R;
        voffA[i] = (unsigned)(R * g.lda + C) * 2u; voffB[i] = (unsigned)(Rb * g.ldb + C) * 2u; }
    const size_t kstep = (size_t)(BK * 2);
    const size_t hstepA = (size_t)HALF * g.lda * 2, hstepB = (size_t)HALF * g.ldb * 2;
    const size_t tstepA = 2 * hstepA, tstepB = 2 * hstepB;
    const unsigned ldsw = (unsigned)wid * 1024u;
    const int aoff = lds_byte(wr * 64 + fr, fq * 8), boff = lds_byte(wc * 32 + fr, fq * 8);
#define PG8_SA(b, h) (((b) * 2 + (h)) * HTB)
#define PG8_SB(b, h) ((4 + (b) * 2 + (h)) * HTB)
#define PG8_STAGE(bufoff, gbase, voff) do { _Pragma("unroll") for (int _i = 0; _i < 2; ++_i) \
        __builtin_amdgcn_global_load_lds((const unsigned*)((const char*)(gbase) + (voff)[_i]), (PG8_LAS unsigned*)(lds + (bufoff) + ldsw + _i * 8192), 16, 0, 0); } while (0)
#define PG8_LDA(dst, b, h) do { _Pragma("unroll") for (int m = 0; m < 4; ++m) _Pragma("unroll") for (int k = 0; k < 2; ++k) dst[m][k] = *(const PG8_LAS bf16x8*)(lds + PG8_SA(b, h) + aoff + m * 2048 + k * 1024); } while (0)
#define PG8_LDB(dst, b, h) do { _Pragma("unroll") for (int n = 0; n < 2; ++n) _Pragma("unroll") for (int k = 0; k < 2; ++k) dst[n][k] = *(const PG8_LAS bf16x8*)(lds + PG8_SB(b, h) + boff + n * 2048 + k * 1024); } while (0)
#define PG8_MMA(ai, bj, At, Bt) do { __builtin_amdgcn_s_setprio(1); _Pragma("unroll") for (int m = 0; m < 4; ++m) _Pragma("unroll") for (int n = 0; n < 2; ++n) _Pragma("unroll") for (int k = 0; k < 2; ++k) \
        acc[ai][bj][m][n] = __builtin_amdgcn_mfma_f32_16x16x32_bf16(Bt[n][k], At[m][k], acc[ai][bj][m][n], 0, 0, 0); __builtin_amdgcn_s_setprio(0); } while (0)
#define PG8_WAIT_V(n) asm volatile("s_waitcnt vmcnt(" #n ")" ::: "memory")
#define PG8_WAIT_L(n) asm volatile("s_waitcnt lgkmcnt(" #n ")" ::: "memory")
#define PG8_BAR __builtin_amdgcn_s_barrier()
#define PG8_SCHED __builtin_amdgcn_sched_barrier(0)
#define PG8_ABASE(u) ((const char*)((u).sub ? g.A1 : g.A0) + (size_t)(u).pm * tstepA)
#define PG8_BBASE(u) ((const char*)g.Bt + (size_t)(u).pn * tstepB + (size_t)(u).sub * K * 2)
    Unit cur, nxt; int ui = 0;
    if (!S.next(0, cur)) return;
    Acc acc;
#pragma unroll
    for (int a = 0; a < 2; ++a)
#pragma unroll
        for (int b = 0; b < 2; ++b)
#pragma unroll
            for (int m = 0; m < 4; ++m)
#pragma unroll
                for (int n = 0; n < 2; ++n) acc[a][b][m][n] = (f32x4){0.f, 0.f, 0.f, 0.f};
    bf16x8 At[4][2], B0[2][2], B1[2][2];
    const char* cA = PG8_ABASE(cur); const char* cB = PG8_BBASE(cur);
    PG8_STAGE(PG8_SB(0, 0), cB, voffB); PG8_STAGE(PG8_SB(0, 1), cB + hstepB, voffB); PG8_STAGE(PG8_SA(0, 0), cA, voffA); PG8_STAGE(PG8_SA(0, 1), cA + hstepA, voffA);
    if (wr == 1) PG8_BAR;
    PG8_WAIT_V(2); PG8_BAR;
    PG8_STAGE(PG8_SB(1, 0), cB + kstep, voffB); PG8_STAGE(PG8_SA(1, 0), cA + kstep, voffA); PG8_STAGE(PG8_SB(1, 1), cB + hstepB + kstep, voffB);
    PG8_WAIT_V(6); PG8_BAR;
    for (;;) {
        const bool has_next = S.next(ui + 1, nxt);
        const char* nA = has_next ? PG8_ABASE(nxt) : cA; const char* nB = has_next ? PG8_BBASE(nxt) : cB;
        for (int t = 0; t < nt; t += 2) {
            const bool last = (t == nt - 2);
            const char* a1 = cA + (size_t)(t + 1) * kstep;
            const char* a2 = last ? nA : cA + (size_t)(t + 2) * kstep; const char* b2 = last ? nB : cB + (size_t)(t + 2) * kstep;
            const char* a3 = a2 + kstep; const char* b3 = b2 + kstep;
            PG8_LDB(B0, 0, 0); PG8_LDB(B1, 0, 1); PG8_SCHED; PG8_LDA(At, 0, 0); PG8_STAGE(PG8_SA(1, 1), a1 + hstepA, voffA);
            PG8_WAIT_V(8); PG8_WAIT_L(0); PG8_BAR; PG8_MMA(0, 0, At, B0); PG8_MMA(0, 1, At, B1); PG8_BAR; PG8_SCHED;
            PG8_LDA(At, 0, 1); PG8_STAGE(PG8_SB(0, 0), b2, voffB); PG8_STAGE(PG8_SB(0, 1), b2 + hstepB, voffB); PG8_STAGE(PG8_SA(0, 0), a2, voffA);
            PG8_WAIT_V(8); PG8_WAIT_L(0); PG8_BAR; PG8_MMA(1, 0, At, B0); PG8_MMA(1, 1, At, B1); PG8_BAR; PG8_SCHED;
            PG8_LDB(B0, 1, 0); PG8_LDB(B1, 1, 1); PG8_SCHED; PG8_LDA(At, 1, 0); PG8_STAGE(PG8_SA(0, 1), a2 + hstepA, voffA);
            PG8_WAIT_V(8); PG8_WAIT_L(0); PG8_BAR; PG8_MMA(0, 0, At, B0); PG8_MMA(0, 1, At, B1); PG8_BAR; PG8_SCHED;
            PG8_LDA(At, 1, 1); PG8_STAGE(PG8_SB(1, 0), b3, voffB); PG8_STAGE(PG8_SB(1, 1), b3 + hstepB, voffB); PG8_STAGE(PG8_SA(1, 0), a3, voffA);
            PG8_WAIT_V(8); PG8_WAIT_L(0); PG8_BAR; PG8_MMA(1, 0, At, B0); PG8_MMA(1, 1, At, B1); PG8_BAR; PG8_SCHED;
        }
        if constexpr (ALIGN_EPI) { if (wr == 0) PG8_BAR; }
        if constexpr (Epi::FUSED) E.fused(acc, cur, wr, wc, fr, fq, lds, wid, lane); else E(acc, cur, wr, wc, fr, fq);
        if (!has_next) break;
        if (!E.keep(cur)) {
#pragma unroll
            for (int a = 0; a < 2; ++a)
#pragma unroll
                for (int b = 0; b < 2; ++b)
#pragma unroll
                    for (int m = 0; m < 4; ++m)
#pragma unroll
                        for (int n = 0; n < 2; ++n) acc[a][b][m][n] = (f32x4){0.f, 0.f, 0.f, 0.f};
        }
        cur = nxt; cA = nA; cB = nB; ++ui;
        if constexpr (ALIGN_EPI) { if (wr == 1) PG8_BAR; }
    }
    PG8_WAIT_V(0);
    if constexpr (!ALIGN_EPI) { if (wr == 0) PG8_BAR; }
    PG8_BAR;
#undef PG8_SA
#undef PG8_SB
#undef PG8_STAGE
#undef PG8_LDA
#undef PG8_LDB
#undef PG8_MMA
#undef PG8_WAIT_V
#undef PG8_WAIT_L
#undef PG8_BAR
#undef PG8_SCHED
#undef PG8_ABASE
#undef PG8_BBASE
}
}


#define XB_TMO      128
#define XB_XCNT(j)  (256  + 64 * (j))
#define XB_XSUB(j)  (1280 + 64 * (j))
#define XB_XGEN(j)  (2304 + 64 * (j))
#define XB_TOP      3328
#define XB_TOPGEN   3392
#define XCD_BAR_WORDS 3456
#define XB_SPIN_CAP (1u << 22)
__device__ __forceinline__ unsigned xb_ld(unsigned* p)              { return __hip_atomic_load(p, __ATOMIC_RELAXED, __HIP_MEMORY_SCOPE_AGENT); }
__device__ __forceinline__ unsigned xb_add(unsigned* p, unsigned v) { return __hip_atomic_fetch_add(p, v, __ATOMIC_RELAXED, __HIP_MEMORY_SCOPE_AGENT); }
__device__ __forceinline__ unsigned xb_xcc_id() { return (unsigned)__builtin_amdgcn_s_getreg((3 << 11) | 20) & 0xFu; }
#define XB_SPIN(cond, bar) do { unsigned _sp = 0; while (cond) { __builtin_amdgcn_s_sleep(1); \
    if ((++_sp & 255u) == 0u) { if (xb_ld(&(bar)[XB_TMO])) break; if (_sp > XB_SPIN_CAP) { atomicAdd(&(bar)[XB_TMO], 1u); break; } } } } while (0)
struct XcdBarrier { unsigned* bar; unsigned x; volatile LAS unsigned* st; };
__device__ __forceinline__ XcdBarrier xcd_barrier_post(unsigned* bar, volatile LAS unsigned* st) {
    XcdBarrier b; b.bar = bar; b.x = xb_xcc_id(); b.st = st;
    if (threadIdx.x == 0) (void)xb_add(&bar[XB_XCNT(b.x)], 1u);
    return b;
}
__device__ __forceinline__ void xcd_barrier_complete(unsigned* bar, unsigned x, unsigned& nloc, unsigned& nx) {
    const unsigned G = gridDim.x * gridDim.y * gridDim.z;
    unsigned sum, cnt, mine, sp = 0u;
    for (;;) {
        sum = 0u; cnt = 0u; mine = 0u;
#pragma unroll
        for (unsigned j = 0; j < 16; ++j) { const unsigned c = xb_ld(&bar[XB_XCNT(j)]); sum += c; cnt += (c > 0u) ? 1u : 0u; mine = (j == x) ? c : mine; }
        if (sum == G) break;
        __builtin_amdgcn_s_sleep(1);
        if ((++sp & 255u) == 0u) { if (xb_ld(&bar[XB_TMO])) break; if (sp > XB_SPIN_CAP) { atomicAdd(&bar[XB_TMO], 1u); break; } }
    }
    nloc = mine > 0u ? mine : 1u; nx = cnt > 0u ? cnt : 1u;
}
__device__ __forceinline__ void xcd_barrier(const XcdBarrier& b) {
    asm volatile("s_waitcnt vmcnt(0)" ::: "memory");
    __syncthreads();
    if (threadIdx.x == 0) {
        unsigned* bar = b.bar;
        __builtin_amdgcn_s_waitcnt(0);
        unsigned nloc = b.st[0], nx = b.st[1];
        if (nloc == 0u) { xcd_barrier_complete(bar, b.x, nloc, nx); b.st[0] = nloc; b.st[1] = nx; }
        const unsigned old = xb_add(&bar[XB_XSUB(b.x)], 1u);
        const unsigned gen = old / nloc;
        if (old + 1u == (gen + 1u) * nloc) {
            __builtin_amdgcn_fence(__ATOMIC_RELEASE, "agent");
            asm volatile("s_waitcnt vmcnt(0)" ::: "memory");
            const unsigned og = xb_add(&bar[XB_TOP], 1u);
            const unsigned target = (og / nx + 1u) * nx;
            if (og + 1u != target) XB_SPIN(xb_ld(&bar[XB_TOP]) < target, bar);
            xb_add(&bar[XB_XGEN(b.x)], 1u);
            __builtin_amdgcn_fence(__ATOMIC_ACQUIRE, "agent");
            asm volatile("s_waitcnt vmcnt(0)" ::: "memory");
        } else {
            XB_SPIN(xb_ld(&bar[XB_XGEN(b.x)]) == gen, bar);
            __builtin_amdgcn_fence(__ATOMIC_ACQUIRE, "agent");
            asm volatile("s_waitcnt vmcnt(0)" ::: "memory");
        }
    }
    __syncthreads();
}

struct Args { const float* in[21]; float* out; unsigned char* ws; int ph_lo, ph_hi; };
struct Frame {
    LAS unsigned char* lds;
    int tid, lane, wave, vcu, G;
    const float* const* in_unused;
    float* out; unsigned char* ws;
};

__device__ __forceinline__ void p0_item(const float* W, int N, int scol0, int nvalid, const float* gain, int gmask, bf16* WT, int ldk, int koff, int drow0, int k0, LAS float* scr, int lane) {
    const bool al16 = ((scol0 & 3) == 0) && ((N & 3) == 0) && nvalid == 32;
    if (al16) {
        f32x4 v[8];
#pragma unroll
        for (int i = 0; i < 8; ++i) { const int p_ = lane + 64 * i; v[i] = *(const f32x4*)(W + (size_t)(k0 + (p_ >> 3)) * N + scol0 + (p_ & 7) * 4); }
#pragma unroll
        for (int i = 0; i < 8; ++i) { const int p_ = lane + 64 * i, kk = p_ >> 3, c = (p_ & 7) * 4; const float g = gain ? gain[(k0 + kk) & gmask] : 1.0f;
            scr[kk * 33 + c] = v[i][0] * g; scr[kk * 33 + c + 1] = v[i][1] * g; scr[kk * 33 + c + 2] = v[i][2] * g; scr[kk * 33 + c + 3] = v[i][3] * g; }
    } else {
        float v[32];
#pragma unroll
        for (int i = 0; i < 32; ++i) { const int kk = 2 * i + (lane >> 5), c = lane & 31; v[i] = 0.f; if (c < nvalid) v[i] = W[(size_t)(k0 + kk) * N + scol0 + c]; }
#pragma unroll
        for (int i = 0; i < 32; ++i) { const int kk = 2 * i + (lane >> 5), c = lane & 31; scr[kk * 33 + c] = (gain && c < nvalid) ? v[i] * gain[(k0 + kk) & gmask] : v[i]; }
    }
    LDS_WAIT(); asm volatile("" ::: "memory");
    const int c8 = lane & 7;
#pragma unroll
    for (int j = 0; j < 4; ++j) { const int n = (lane >> 3) + 8 * j; const LAS float* s = scr + (8 * c8) * 33 + n;
        v4u o; o.x = pk2(s[0 * 33], s[1 * 33]); o.y = pk2(s[2 * 33], s[3 * 33]); o.z = pk2(s[4 * 33], s[5 * 33]); o.w = pk2(s[6 * 33], s[7 * 33]);
        *(v4u*)(WT + (size_t)(drow0 + n) * ldk + koff + k0 + 8 * c8) = o; }
    LDS_WAIT(); asm volatile("" ::: "memory");
}
__device__ __forceinline__ int map_ffn_in(int blk) { const int tile = blk >> 3, w = blk & 7; return w < 4 ? tile * 128 + w * 32 : FF + tile * 128 + (w - 4) * 32; }
__device__ __forceinline__ int map_proj_a(int blk, int& nvalid) {
    nvalid = 32;
    if (blk < 16) return S_GQ + 32 * blk;
    if (blk < 32) return S_GK + 32 * (blk - 16);
    if (blk < 64) return S_GV + 32 * (blk - 32);
    if (blk < 96) return S_SQ + 32 * (blk - 64);
    if (blk < 128) return S_GR + 32 * (blk - 96);
    if (blk < 132) return S_SK + 32 * (blk - 128);
    if (blk < 136) return S_SV + 32 * (blk - 132);
    if (blk == 136) { nvalid = GRANK; return S_GLR; }
    nvalid = 0; return 0;
}
__device__ __forceinline__ int map_proj_b(int blk) { const int tile = blk >> 3, w = blk & 7; return w < 4 ? S_GG + tile * 128 + w * 32 : S_GS + tile * 128 + (w - 4) * 32; }


constexpr int P0_I1 = (D / 64) * 176, P0_I1O = (FF / 64) * 32, P0_IA = (D / 64) * 144, P0_IB = (D / 64) * 64, P0_IBR = (D / 64) * 32, P0_IO = (D / 64) * 32;
constexpr int P0_NEARLY = P0_I1 + P0_I1O + P0_IA, P0_NLATE = P0_I1 + P0_I1O + P0_IB + 2 * P0_IBR + P0_IO;
__device__ __forceinline__ void p0_weight_item(const Args& a, int idx, LAS float* scr, int lane) {
    unsigned char* ws = a.ws;
    int r;
    if (idx < P0_NEARLY) {
        r = idx;
        if (r < P0_I1) { const int kb = r / 176, blk = r % 176; p0_item(a.in[6], 2 * FF, map_ffn_in(blk), 32, a.in[5], 1023, (bf16*)(ws + WS_W1T), D, 0, blk * 32, kb * 64, scr, lane); return; }
        r -= P0_I1;
        if (r < P0_I1O) { const int kb = r / 32, blk = r % 32; p0_item(a.in[7], D, blk * 32, 32, nullptr, 0, (bf16*)(ws + WS_W1OT), FF, 0, blk * 32, kb * 64, scr, lane); return; }
        r -= P0_I1O;
        { const int kb = r / 144, blk = r % 144; int nv; const int sc = map_proj_a(blk, nv); p0_item(a.in[9], IN_W, sc, nv, a.in[8], 1023, (bf16*)(ws + WS_WAT), D, 0, blk * 32, kb * 64, scr, lane); return; }
    }
    r = idx - P0_NEARLY;
    if (r < P0_I1) { const int kb = r / 176, blk = r % 176; p0_item(a.in[18], 2 * FF, map_ffn_in(blk), 32, a.in[17], 1023, (bf16*)(ws + WS_W2T), D, 0, blk * 32, kb * 64, scr, lane); return; }
    r -= P0_I1;
    if (r < P0_I1O) { const int kb = r / 32, blk = r % 32; p0_item(a.in[19], D, blk * 32, 32, nullptr, 0, (bf16*)(ws + WS_W2OT), FF, 0, blk * 32, kb * 64, scr, lane); return; }
    r -= P0_I1O;
    if (r < P0_IB) { const int kb = r / 64, blk = r % 64; p0_item(a.in[9], IN_W, map_proj_b(blk), 32, a.in[8], 1023, (bf16*)(ws + WS_WBT), D, 0, blk * 32, kb * 64, scr, lane); return; }
    r -= P0_IB;
    if (r < 2 * P0_IBR) { const int which = r / P0_IBR; r -= which * P0_IBR; const int kb = r / 32, blk = r % 32;
        p0_item(a.in[which ? 15 : 14], D, blk * 32, 32, which ? nullptr : a.in[12], 255, (bf16*)(ws + WS_WBRT), 2 * D, which * D, blk * 32, kb * 64, scr, lane); return; }
    r -= 2 * P0_IBR;
    { const int kb = r / 32, blk = r % 32; p0_item(a.in[16], D, blk * 32, 32, nullptr, 0, (bf16*)(ws + WS_WOUTT), D, 0, blk * 32, kb * 64, scr, lane); }
}
__device__ __forceinline__ void p0_prologue(const Args& a, Frame& F) {
    LAS float* scr = (LAS float*)(F.lds + F.wave * 16384);
    const int gw = F.vcu * NWAVES + F.wave, NGW = F.G * NWAVES;
    unsigned char* ws = a.ws;
    for (int it = gw; it < P0_NEARLY; it += NGW) p0_weight_item(a, it, scr, F.lane);
    bf16* XB = (bf16*)(ws + WS_XB); float* ssq0 = (float*)(ws + WS_SSQ0);
    for (int m0 = gw; m0 < M; m0 += 4 * NGW) {
        f32x4 v[4][4];
#pragma unroll
        for (int r = 0; r < 4; ++r) { const int m = m0 + r * NGW;
            if (m < M) { const f32x4* xr = (const f32x4*)(m < MP ? a.in[0] + (size_t)m * D : a.in[1] + (size_t)(m - MP) * D) + F.lane;
#pragma unroll
                for (int j = 0; j < 4; ++j) v[r][j] = xr[64 * j]; } }
#pragma unroll
        for (int r = 0; r < 4; ++r) { const int m = m0 + r * NGW;
            if (m < M) {
                float s = 0.f;
#pragma unroll
                for (int j = 0; j < 4; ++j) s += (v[r][j].x * v[r][j].x + v[r][j].y * v[r][j].y) + (v[r][j].z * v[r][j].z + v[r][j].w * v[r][j].w);
                s = wave_sum(s);
                unsigned long long* o8 = (unsigned long long*)(XB + (size_t)m * D) + F.lane;
#pragma unroll
                for (int j = 0; j < 4; ++j) o8[64 * j] = (unsigned long long)pk2(v[r][j].x, v[r][j].y) | ((unsigned long long)pk2(v[r][j].z, v[r][j].w) << 32);
                if (m < MP) { if (F.lane < 16) ssq0[(size_t)m * 16 + F.lane] = F.lane == 0 ? s : 0.f; }
                else ((float*)(ws + WS_SSQ0S))[(size_t)(m - MP) * 64 + F.lane] = F.lane == 0 ? s : 0.f;
            } }
    }
    const int gt = gw * 64 + F.lane, NGT = NGW * 64;
    for (int i = gt; i < 2 * NB * 96 * 32; i += NGT) {
        const int which = i / (NB * 96 * 32), r = i % (NB * 96 * 32), b = r / (96 * 32), rr = r % (96 * 32);
        const f32x4 v = *((const f32x4*)(a.in[which ? 4 : 3] + ((size_t)b * WINDOW + 32) * 128) + rr);
        *((f32x4*)(a.out + (which ? O_CVS : O_CKS) + (size_t)b * WINDOW * 128) + rr) = v;
    }
}

constexpr int SWA_KLD_B = 144;
constexpr int SWA_VLD_B = 392;
constexpr int SWA_K_OFF = 0, SWA_V_OFF = 192 * SWA_KLD_B;
__device__ __forceinline__ void swa_unit(const Args& a, Frame& F, int seq, int chunk, int kvh) {
    const int tid = F.tid, lane = F.lane, wave = F.wave, r32 = lane & 31, hi = lane >> 5;
    const bool samp = seq >= NB; const int b = samp ? seq - NB : seq;
    bf16* SQ = (bf16*)(a.ws + WS_T2); const bf16* SKVb = (const bf16*)(a.ws + WS_SKV);
    const int rowq0 = samp ? MP + b * DEC_T : b * SEQ + chunk * 64;
    const int ntb = samp ? 1 : 2, nkb = samp ? 5 : 6, kb0 = samp ? 0 : (chunk >= 2 ? 0 : (2 - chunk) * 2);
    const int nkeys = nkb * 32;
    LAS unsigned char* Kl = F.lds + SWA_K_OFF; LAS unsigned char* Vl = F.lds + SWA_V_OFF;
    __syncthreads();
    for (int it = tid; it < nkeys * 8; it += NWAVES * 64) {
        const int key = it >> 3, c8 = it & 7;
        if (key < kb0 * 32) continue;
        v4u kk, vv;
        if (samp && key < WINDOW) {
            const float* ck = a.in[3] + ((size_t)(b * WINDOW + key) * SKV + kvh) * SHD + c8 * 8; const float* cv = a.in[4] + ((size_t)(b * WINDOW + key) * SKV + kvh) * SHD + c8 * 8;
            const f32x4 k0 = *(const f32x4*)ck, k1 = *(const f32x4*)(ck + 4), v0 = *(const f32x4*)cv, v1 = *(const f32x4*)(cv + 4);
            kk.x = pk2(k0[0], k0[1]); kk.y = pk2(k0[2], k0[3]); kk.z = pk2(k1[0], k1[1]); kk.w = pk2(k1[2], k1[3]);
            vv.x = pk2(v0[0], v0[1]); vv.y = pk2(v0[2], v0[3]); vv.z = pk2(v1[0], v1[1]); vv.w = pk2(v1[2], v1[3]);
        } else {
            const int mrow = samp ? MP + b * DEC_T + (key - WINDOW) : b * SEQ + (chunk - 2) * 64 + key;
            kk = *(const v4u*)(SKVb + (size_t)mrow * 256 + kvh * 64 + c8 * 8); vv = *(const v4u*)(SKVb + (size_t)mrow * 256 + 128 + kvh * 64 + c8 * 8);
        }
        *(LAS v4u*)(Kl + key * SWA_KLD_B + c8 * 16) = kk;
        LAS unsigned short* vt = (LAS unsigned short*)(Vl + (c8 * 8) * SWA_VLD_B + key * 2);
        vt[0 * (SWA_VLD_B / 2)] = (unsigned short)(vv.x & 0xffff); vt[1 * (SWA_VLD_B / 2)] = (unsigned short)(vv.x >> 16);
        vt[2 * (SWA_VLD_B / 2)] = (unsigned short)(vv.y & 0xffff); vt[3 * (SWA_VLD_B / 2)] = (unsigned short)(vv.y >> 16);
        vt[4 * (SWA_VLD_B / 2)] = (unsigned short)(vv.z & 0xffff); vt[5 * (SWA_VLD_B / 2)] = (unsigned short)(vv.z >> 16);
        vt[6 * (SWA_VLD_B / 2)] = (unsigned short)(vv.w & 0xffff); vt[7 * (SWA_VLD_B / 2)] = (unsigned short)(vv.w >> 16);
    }
    __syncthreads();
    const int head = kvh * 8 + wave;
    const float sink2 = a.in[13][head] * LOG2E;
    for (int tb = 0; tb < ntb; ++tb) {
        bf16* qrow = SQ + (size_t)(rowq0 + tb * 32 + r32) * D + head * SHD;
        bf16x8 qf[4];
#pragma unroll
        for (int s = 0; s < 4; ++s) qf[s] = *(const bf16x8*)(qrow + s * 16 + hi * 8);
        f32x16 sacc[6];
#pragma unroll
        for (int kb = 0; kb < 6; ++kb) {
            if (kb >= kb0 && kb < nkb) {
                f32x16 c = {0.f, 0.f, 0.f, 0.f, 0.f, 0.f, 0.f, 0.f, 0.f, 0.f, 0.f, 0.f, 0.f, 0.f, 0.f, 0.f};
#pragma unroll
                for (int s = 0; s < 4; ++s) { const bf16x8 kf = *(const LAS bf16x8*)(Kl + (kb * 32 + r32) * SWA_KLD_B + s * 32 + hi * 16); c = __builtin_amdgcn_mfma_f32_32x32x16_bf16(kf, qf[s], c, 0, 0, 0); }
                sacc[kb] = c;
            }
        }
        float mx = sink2;
#pragma unroll
        for (int kb = 0; kb < 6; ++kb) if (kb >= kb0 && kb < nkb) {
#pragma unroll
            for (int r = 0; r < 16; ++r) mx = fmaxf(mx, sacc[kb][r]); }
        mx = fmaxf(mx, __shfl_xor(mx, 32));
        float l = 0.f;
#pragma unroll
        for (int kb = 0; kb < 6; ++kb) if (kb >= kb0 && kb < nkb) {
#pragma unroll
            for (int r = 0; r < 16; ++r) { const float p = fast_exp2(sacc[kb][r] - mx); sacc[kb][r] = p; l += p; } }
        l += __shfl_xor(l, 32); l += fast_exp2(sink2 - mx);
        f32x16 o[2];
#pragma unroll
        for (int db = 0; db < 2; ++db) o[db] = (f32x16){0.f, 0.f, 0.f, 0.f, 0.f, 0.f, 0.f, 0.f, 0.f, 0.f, 0.f, 0.f, 0.f, 0.f, 0.f, 0.f};
#pragma unroll
        for (int kb = 0; kb < 6; ++kb) if (kb >= kb0 && kb < nkb) {
#pragma unroll
            for (int s2 = 0; s2 < 2; ++s2) {
                v4u pw; pw.x = pk2(sacc[kb][8 * s2 + 0], sacc[kb][8 * s2 + 1]); pw.y = pk2(sacc[kb][8 * s2 + 2], sacc[kb][8 * s2 + 3]);
                pw.z = pk2(sacc[kb][8 * s2 + 4], sacc[kb][8 * s2 + 5]); pw.w = pk2(sacc[kb][8 * s2 + 6], sacc[kb][8 * s2 + 7]);
                const bf16x8 pb = __builtin_bit_cast(bf16x8, pw);
#pragma unroll
                for (int db = 0; db < 2; ++db) {
                    const LAS unsigned char* vp = Vl + (db * 32 + r32) * SWA_VLD_B + (kb * 32 + s2 * 16 + 4 * hi) * 2;
                    const v2u lo = *(const LAS v2u*)vp, hi8 = *(const LAS v2u*)(vp + 16);
                    v4u av; av.x = lo.x; av.y = lo.y; av.z = hi8.x; av.w = hi8.y;
                    o[db] = __builtin_amdgcn_mfma_f32_32x32x16_bf16(__builtin_bit_cast(bf16x8, av), pb, o[db], 0, 0, 0);
                }
            }
        }
        const float inv = fast_rcp(l);
#pragma unroll
        for (int db = 0; db < 2; ++db)
#pragma unroll
            for (int g4 = 0; g4 < 4; ++g4) {
                v2u w; w.x = pk2(o[db][4 * g4 + 0] * inv, o[db][4 * g4 + 1] * inv); w.y = pk2(o[db][4 * g4 + 2] * inv, o[db][4 * g4 + 3] * inv);
                *(v2u*)(qrow + db * 32 + 8 * g4 + 4 * hi) = w;
            }
    }
}

struct SwaRegs { v4u kk[3], vv[3]; };
__device__ __forceinline__ void swa_p_load(SwaRegs& R, const Args& a, int u, int tid) {
    const int b = u >> 7, chunk = (u >> 1) & 63, kvh = u & 1;
    const bf16* SKVb = (const bf16*)(a.ws + WS_SKV);
    const char* base = (const char*)(SKVb + ((size_t)b * SEQ + (size_t)(chunk - 2) * 64) * 256 + kvh * 64);
#pragma unroll
    for (int i = 0; i < 3; ++i) {
        const int it = tid + 512 * i, key = it >> 3, c8 = it & 7;
        R.kk[i] = (v4u){0u, 0u, 0u, 0u}; R.vv[i] = (v4u){0u, 0u, 0u, 0u};
        if (key + (chunk - 2) * 64 >= 0) { R.kk[i] = *(const v4u*)(base + (size_t)key * 512 + c8 * 16); R.vv[i] = *(const v4u*)(base + (size_t)key * 512 + 256 + c8 * 16); }
    }
}
__device__ __forceinline__ void swa_p_compute(SwaRegs& R, const Args& a, Frame& F, int u) {
    const int tid = F.tid, lane = F.lane, wave = F.wave, r32 = lane & 31, hi = lane >> 5;
    const int b = u >> 7, chunk = (u >> 1) & 63, kvh = u & 1;
    bf16* SQ = (bf16*)(a.ws + WS_T2);
    const int rowq0 = b * SEQ + chunk * 64, kb0 = chunk >= 2 ? 0 : (2 - chunk) * 2;
    LAS unsigned char* Kl = F.lds + SWA_K_OFF; LAS unsigned char* Vl = F.lds + SWA_V_OFF;
    const int head = kvh * 8 + wave;
    bf16* qrow0 = SQ + (size_t)(rowq0 + r32) * D + head * SHD;
    bf16x8 qf[2][4];
#pragma unroll
    for (int s = 0; s < 4; ++s) qf[0][s] = *(const bf16x8*)(qrow0 + s * 16 + hi * 8);
    const float sink2 = a.in[13][head] * LOG2E;
    LDS_BAR();
#pragma unroll
    for (int i = 0; i < 3; ++i) {
        const int it = tid + 512 * i, key = it >> 3, c8 = it & 7;
        *(LAS v4u*)(Kl + key * SWA_KLD_B + c8 * 16) = R.kk[i];
        LAS unsigned short* vt = (LAS unsigned short*)(Vl + (c8 * 8) * SWA_VLD_B + key * 2);
        const unsigned w_[4] = {R.vv[i].x, R.vv[i].y, R.vv[i].z, R.vv[i].w};
#pragma unroll
        for (int q = 0; q < 4; ++q) { vt[(2 * q) * (SWA_VLD_B / 2)] = (unsigned short)(w_[q] & 0xffffu); vt[(2 * q + 1) * (SWA_VLD_B / 2)] = (unsigned short)(w_[q] >> 16); }
    }
    LDS_BAR();
#pragma unroll
    for (int tb = 0; tb < 2; ++tb) {
        bf16* qrow = qrow0 + (size_t)tb * 32 * D;
        f32x16 sacc[6];
#pragma unroll
        for (int kb = 0; kb < 6; ++kb) {
            if (kb >= kb0) {
                f32x16 c = {0.f, 0.f, 0.f, 0.f, 0.f, 0.f, 0.f, 0.f, 0.f, 0.f, 0.f, 0.f, 0.f, 0.f, 0.f, 0.f};
                bf16x8 kf[4];
#pragma unroll
                for (int s = 0; s < 4; ++s) kf[s] = *(const LAS bf16x8*)(Kl + (kb * 32 + r32) * SWA_KLD_B + s * 32 + hi * 16);
#pragma unroll
                for (int s = 0; s < 4; ++s) c = __builtin_amdgcn_mfma_f32_32x32x16_bf16(kf[s], qf[tb][s], c, 0, 0, 0);
                sacc[kb] = c;
            }
        }
        if (tb == 0) {
#pragma unroll
            for (int s = 0; s < 4; ++s) qf[1][s] = *(const bf16x8*)(qrow0 + (size_t)32 * D + s * 16 + hi * 8);
        }
        float mx = sink2;
#pragma unroll
        for (int kb = 0; kb < 6; ++kb) if (kb >= kb0) {
#pragma unroll
            for (int r = 0; r < 16; ++r) mx = fmaxf(mx, sacc[kb][r]); }
        mx = fmaxf(mx, __shfl_xor(mx, 32));
        float l = 0.f;
#pragma unroll
        for (int kb = 0; kb < 6; ++kb) if (kb >= kb0) {
#pragma unroll
            for (int r = 0; r < 16; ++r) { const float p = fast_exp2(sacc[kb][r] - mx); sacc[kb][r] = p; l += p; } }
        l += __shfl_xor(l, 32); l += fast_exp2(sink2 - mx);
        f32x16 o[2];
#pragma unroll
        for (int db = 0; db < 2; ++db) o[db] = (f32x16){0.f, 0.f, 0.f, 0.f, 0.f, 0.f, 0.f, 0.f, 0.f, 0.f, 0.f, 0.f, 0.f, 0.f, 0.f, 0.f};
#pragma unroll
        for (int kb = 0; kb < 6; ++kb) if (kb >= kb0) {
            v2u vlo[2][2], vhi[2][2];
#pragma unroll
            for (int s2 = 0; s2 < 2; ++s2)
#pragma unroll
                for (int db = 0; db < 2; ++db) {
                    const LAS unsigned char* vp = Vl + (db * 32 + r32) * SWA_VLD_B + (kb * 32 + s2 * 16 + 4 * hi) * 2;
                    vlo[s2][db] = *(const LAS v2u*)vp; vhi[s2][db] = *(const LAS v2u*)(vp + 16);
                }
            bf16x8 pb[2];
#pragma unroll
            for (int s2 = 0; s2 < 2; ++s2) {
                v4u pw; pw.x = pk2(sacc[kb][8 * s2 + 0], sacc[kb][8 * s2 + 1]); pw.y = pk2(sacc[kb][8 * s2 + 2], sacc[kb][8 * s2 + 3]);
                pw.z = pk2(sacc[kb][8 * s2 + 4], sacc[kb][8 * s2 + 5]); pw.w = pk2(sacc[kb][8 * s2 + 6], sacc[kb][8 * s2 + 7]);
                pb[s2] = __builtin_bit_cast(bf16x8, pw);
            }
            asm volatile("s_waitcnt lgkmcnt(0)" ::: "memory"); __builtin_amdgcn_sched_barrier(0);
#pragma unroll
            for (int s2 = 0; s2 < 2; ++s2)
#pragma unroll
                for (int db = 0; db < 2; ++db) {
                    v4u av; av.x = vlo[s2][db].x; av.y = vlo[s2][db].y; av.z = vhi[s2][db].x; av.w = vhi[s2][db].y;
                    o[db] = __builtin_amdgcn_mfma_f32_32x32x16_bf16(__builtin_bit_cast(bf16x8, av), pb[s2], o[db], 0, 0, 0);
                }
            __builtin_amdgcn_sched_barrier(0);
        }
        const float inv = fast_rcp(l);
#pragma unroll
        for (int db = 0; db < 2; ++db)
#pragma unroll
            for (int g4 = 0; g4 < 4; ++g4) {
                v2u w; w.x = pk2(o[db][4 * g4 + 0] * inv, o[db][4 * g4 + 1] * inv); w.y = pk2(o[db][4 * g4 + 2] * inv, o[db][4 * g4 + 3] * inv);
                *(v2u*)(qrow + db * 32 + 8 * g4 + 4 * hi) = w;
            }
    }
}

constexpr int G1_GLR_OFF = 0, G1_TOT_OFF = 4096, G1_Q_OFF = 6144, G1_LD_B = 272, G1_K_OFF = G1_Q_OFF + 64 * G1_LD_B;
struct G1Regs { v4u qraw[2], kraw[2]; f32x4 gl; };
__device__ __forceinline__ void g1_load(G1Regs& R, const Args& a, int seq, int chunk, int h, int tid) {
    const bool samp = seq >= NB; const int b = samp ? seq - NB : seq;
    const int row0 = samp ? MP + b * DEC_T : b * SEQ + chunk * 64, L = samp ? DEC_T : 64;
    const bf16* QK = (const bf16*)(a.ws + WS_T0); const float* GLR = (const float*)(a.ws + WS_GLR);
#pragma unroll
    for (int j = 0; j < 2; ++j) { const int idx = tid + 512 * j, t = idx >> 4, c16 = idx & 15;
        R.qraw[j] = (v4u){0u, 0u, 0u, 0u}; R.kraw[j] = (v4u){0u, 0u, 0u, 0u};
        if (t < L) { const bf16* src = QK + (size_t)(row0 + t) * D + h * 128 + c16 * 8; R.qraw[j] = *(const v4u*)src; R.kraw[j] = *(const v4u*)(src + 512); } }
    R.gl = (f32x4){0.f, 0.f, 0.f, 0.f};
    if (tid < 256) { const int t = tid >> 2, c4 = tid & 3; if (t < L) R.gl = *(const f32x4*)(GLR + (size_t)(row0 + t) * 16 + c4 * 4); }
}
__device__ __forceinline__ void g1_compute(G1Regs& R, const float (&w)[16], float bias, const Args& a, Frame& F, int seq, int chunk, int h) {
    const int tid = F.tid, lane = F.lane, wave = F.wave, fr = lane & 15, fq = lane >> 4;
    const bool samp = seq >= NB; const int b = samp ? seq - NB : seq;
    const int row0 = samp ? MP + b * DEC_T : b * SEQ + chunk * 64, L = samp ? DEC_T : 64;
    const int uid = samp ? NB * 64 * GH + b * GH + h : (b * 64 + chunk) * GH + h;
    bf16* QK = (bf16*)(a.ws + WS_T0); bf16* KT = (bf16*)(a.ws + WS_T7); bf16* ABUF = (bf16*)(a.ws + WS_ABUF);
    float* gdec = (float*)(a.ws + WS_GDEC);
    LAS float* glr_l = (LAS float*)(F.lds + G1_GLR_OFF); LAS float* tot = (LAS float*)(F.lds + G1_TOT_OFF);
    LAS unsigned char* ql = F.lds + G1_Q_OFF; LAS unsigned char* kl = F.lds + G1_K_OFF;
    const int d = tid & 127, strip = tid >> 7, t0 = strip * 16;
    LDS_BAR();
#pragma unroll
    for (int j = 0; j < 2; ++j) { const int idx = tid + 512 * j, t = idx >> 4, c16 = idx & 15; *(LAS v4u*)(ql + t * G1_LD_B + c16 * 16) = R.qraw[j]; *(LAS v4u*)(kl + t * G1_LD_B + c16 * 16) = R.kraw[j]; }
    if (tid < 256) *(LAS f32x4*)(glr_l + (tid >> 2) * 16 + (tid & 3) * 4) = R.gl;
    LDS_BAR();
    float bc[16]; float run = 0.f;
#pragma unroll
    for (int i = 0; i < 16; ++i) {
        const int t = t0 + i; float lg = bias;
#pragma unroll
        for (int r4 = 0; r4 < 4; ++r4) { const f32x4 gv = *(const LAS f32x4*)(glr_l + t * 16 + r4 * 4); lg += gv[0] * w[r4 * 4] + gv[1] * w[r4 * 4 + 1] + gv[2] * w[r4 * 4 + 2] + gv[3] * w[r4 * 4 + 3]; }
        const float ls = fminf(lg, 0.f) - __logf(1.0f + __expf(-fabsf(lg)));
        run += (t < L) ? ls * (1.0f / 16.0f) : 0.f; bc[i] = run;
    }
    tot[strip * 128 + d] = run;
    LDS_BAR();
    float off = 0.f, bL = 0.f;
#pragma unroll
    for (int s = 0; s < 4; ++s) { const float tv = tot[s * 128 + d]; bL += tv; if (s < strip) off += tv; }
    unsigned short kp[16];
    const float ebL = __expf(bL);
#pragma unroll
    for (int i = 0; i < 16; ++i) {
        const int t = t0 + i; const float bt = bc[i] + off;
        LAS unsigned short* qe = (LAS unsigned short*)(ql + t * G1_LD_B + d * 2); LAS unsigned short* ke = (LAS unsigned short*)(kl + t * G1_LD_B + d * 2);
        const float q = bf2f(*qe), k = bf2f(*ke);
        const float eb = __expf(bt), ebi = fast_rcp(eb);
        kp[i] = f2bf(k * (ebL * ebi));
        *qe = f2bf(q * eb); *ke = f2bf(k * ebi);
    }
    { v4u o0, o1; o0.x = kp[0] | ((unsigned)kp[1] << 16); o0.y = kp[2] | ((unsigned)kp[3] << 16); o0.z = kp[4] | ((unsigned)kp[5] << 16); o0.w = kp[6] | ((unsigned)kp[7] << 16);
      o1.x = kp[8] | ((unsigned)kp[9] << 16); o1.y = kp[10] | ((unsigned)kp[11] << 16); o1.z = kp[12] | ((unsigned)kp[13] << 16); o1.w = kp[14] | ((unsigned)kp[15] << 16);
      v4u* kd = (v4u*)(KT + ((size_t)uid * 128 + d) * 64 + t0); kd[0] = o0; kd[1] = o1; }
    if (strip == 0) gdec[(size_t)uid * 128 + d] = ebL;
    LDS_BAR();
#pragma unroll
    for (int j = 0; j < 2; ++j) { const int idx = tid + 512 * j, t = idx >> 4, c16 = idx & 15;
        if (t < L) *(v4u*)(QK + (size_t)(row0 + t) * D + h * 128 + c16 * 8) = *(const LAS v4u*)(ql + t * G1_LD_B + c16 * 16); }
    const int sb = wave >> 1;
    bf16x8 kf[4];
#pragma unroll
    for (int kd = 0; kd < 4; ++kd) kf[kd] = *(const LAS bf16x8*)(kl + (sb * 16 + fr) * G1_LD_B + (kd * 32 + 8 * fq) * 2);
#pragma unroll
    for (int x = 0; x < 2; ++x) {
        const int tb = 2 * (wave & 1) + x;
        f32x4 c = {0.f, 0.f, 0.f, 0.f};
#pragma unroll
        for (int kd = 0; kd < 4; ++kd) { const bf16x8 qf = *(const LAS bf16x8*)(ql + (tb * 16 + fr) * G1_LD_B + (kd * 32 + 8 * fq) * 2); c = __builtin_amdgcn_mfma_f32_16x16x32_bf16(kf[kd], qf, c, 0, 0, 0); }
        const int t = tb * 16 + fr, s0 = sb * 16 + 4 * fq;
        float v[4];
#pragma unroll
        for (int j = 0; j < 4; ++j) v[j] = (t >= s0 + j) ? c[j] : 0.f;
        if (t < L) { v2u o; o.x = pk2(v[0], v[1]); o.y = pk2(v[2], v[3]); *(v2u*)(ABUF + (size_t)(row0 + t) * 256 + h * 64 + s0) = o; }
    }
}

constexpr int H2_A_OFF = 0, H2_A_LD = 160, H2_Q_OFF = 64 * H2_A_LD, H2_Q_LD = 288, H2_KT_OFF = H2_Q_OFF + 64 * H2_Q_LD, H2_KT_LD = 160, H2_VT_OFF = H2_KT_OFF + 128 * H2_KT_LD, H2_VT_LD = 160,
              H2_ST_OFF = H2_VT_OFF + 64 * H2_VT_LD, H2_ST_LD = 288, H2_END = H2_ST_OFF + 64 * H2_ST_LD;
constexpr int H2_BUF = 77824;
static_assert(H2_END <= H2_BUF && 2 * H2_BUF <= PHASE_LDS, "G2 LDS map");
struct H2Regs { v4u a; v4u q[2]; v4u kt[2]; v4u v; f32x4 g4; };
struct H2Off { unsigned a, q, k, v, g, o; };
template <bool SAMP> __device__ __forceinline__ void h2_load(H2Regs& R, const Args& a, const H2Off& O, int row0, int uid, int h, int es, int tid, int lane) {
    const char* bA = (const char*)(a.ws + WS_ABUF) + ((size_t)row0 * 256 + h * 64) * 2;
    const char* bQ = (const char*)(a.ws + WS_T0) + ((size_t)row0 * D + h * 128) * 2;
    const char* bK = (const char*)(a.ws + WS_T7) + (size_t)uid * 16384;
    const char* bV = (const char*)(a.ws + WS_T1) + ((size_t)row0 * D + h * 256 + es * 64) * 2;
    const char* bG = (const char*)(a.ws + WS_GDEC) + (size_t)uid * 512;
    const v4u z = {0u, 0u, 0u, 0u};
    R.a = z; if (!SAMP || (tid >> 3) < DEC_T) R.a = *(const v4u*)(bA + O.a);
#pragma unroll
    for (int j = 0; j < 2; ++j) { R.q[j] = z; if (!SAMP || j == 0) R.q[j] = *(const v4u*)(bQ + O.q + j * 65536); }
#pragma unroll
    for (int j = 0; j < 2; ++j) R.kt[j] = *(const v4u*)(bK + O.k + j * 8192);
    R.v = z; if (!SAMP || lane < DEC_T) R.v = *(const v4u*)(bV + O.v);
    R.g4 = *(const f32x4*)(bG + O.g);
}
__device__ __forceinline__ void h2_stage(const H2Regs& R, LAS unsigned char* lds, int tid, int lane, int wave) {
    { const int t = tid >> 3, ch = tid & 7; *(LAS v4u*)(lds + H2_A_OFF + t * H2_A_LD + ch * 16) = R.a; }
#pragma unroll
    for (int j = 0; j < 2; ++j) { const int p = tid + 512 * j; *(LAS v4u*)(lds + H2_Q_OFF + (p >> 4) * H2_Q_LD + (p & 15) * 16) = R.q[j]; *(LAS v4u*)(lds + H2_KT_OFF + (p >> 3) * H2_KT_LD + (p & 7) * 16) = R.kt[j]; }
    { LAS unsigned short* vt = (LAS unsigned short*)(lds + H2_VT_OFF + (wave * 8) * H2_VT_LD + lane * 2); const unsigned w_[4] = {R.v.x, R.v.y, R.v.z, R.v.w};
#pragma unroll
      for (int i = 0; i < 4; ++i) { vt[(2 * i) * (H2_VT_LD / 2)] = (unsigned short)(w_[i] & 0xffffu); vt[(2 * i + 1) * (H2_VT_LD / 2)] = (unsigned short)(w_[i] >> 16); } }
}
template <bool SAMP> __device__ __forceinline__ void g2_item(const Args& a, Frame& F, int bh, int es) {
    const int tid = F.tid, lane = F.lane, wave = F.wave, fr = lane & 15, fq = lane >> 4;
    constexpr int nch = SAMP ? 1 : 64; const int b = bh >> 2, h = bh & 3;
    const int tb = wave >> 1, eb0 = (wave & 1) * 2;
    bf16* OG = (bf16*)(a.ws + WS_T1);
    LAS unsigned char* lds0 = F.lds;
    H2Off OF; OF.a = (unsigned)((tid >> 3) * 512 + (tid & 7) * 16); OF.q = (unsigned)((tid >> 4) * 2048 + (tid & 15) * 16); OF.k = (unsigned)(tid * 16);
    OF.v = (unsigned)(lane * 2048 + wave * 16); OF.g = (unsigned)((16 * wave + 4 * fq) * 4); OF.o = (unsigned)(((tb * 16 + fr) * D + eb0 * 16 + 4 * fq) * 2);
    f32x4 S[4];
#pragma unroll
    for (int eb = 0; eb < 4; ++eb)
#pragma unroll
        for (int r = 0; r < 4; ++r) S[eb][r] = SAMP ? a.in[2][((size_t)bh * 128 + 16 * wave + 4 * fq + r) * 256 + es * 64 + eb * 16 + fr] : 0.f;
    H2Regs R0, R1, R2;
#define H2_LOADC(R, cc) do { const int c_ = (cc) < nch ? (cc) : nch - 1; \
        h2_load<SAMP>(R, a, OF, SAMP ? MP + b * DEC_T : b * SEQ + c_ * 64, SAMP ? NB * 64 * GH + bh : (b * 64 + c_) * GH + h, h, es, tid, lane); } while (0)
#define H2_STEP(R, NXT, cc, PAR) do { \
        const int row0 = SAMP ? MP + b * DEC_T : b * SEQ + (cc) * 64; \
        LAS unsigned char* lds = lds0 + (PAR) * H2_BUF; \
        asm volatile("" : "+v"(R.a), "+v"(R.q[0]), "+v"(R.q[1]), "+v"(R.kt[0]), "+v"(R.kt[1]), "+v"(R.v), "+v"(R.g4)); \
        h2_stage(R, lds, tid, lane, wave); \
        const f32x4 g4 = R.g4; \
        _Pragma("unroll") for (int eb = 0; eb < 4; ++eb) { v2u o; o.x = pk2(S[eb][0], S[eb][1]); o.y = pk2(S[eb][2], S[eb][3]); *(LAS v2u*)(lds + H2_ST_OFF + (eb * 16 + fr) * H2_ST_LD + (16 * wave + 4 * fq) * 2) = o; } \
        LDS_BAR(); \
        if (!SAMP) H2_LOADC(NXT, (cc) + 2); \
        { bf16x8 afr[2], qfr[4], vo[2][2], sf[2][4]; \
          _Pragma("unroll") for (int ks = 0; ks < 2; ++ks) afr[ks] = *(const LAS bf16x8*)(lds + H2_A_OFF + (tb * 16 + fr) * H2_A_LD + ks * 64 + fq * 16); \
          _Pragma("unroll") for (int kd = 0; kd < 4; ++kd) qfr[kd] = *(const LAS bf16x8*)(lds + H2_Q_OFF + (tb * 16 + fr) * H2_Q_LD + kd * 64 + fq * 16); \
          _Pragma("unroll") for (int j = 0; j < 2; ++j) { \
              _Pragma("unroll") for (int ks = 0; ks < 2; ++ks) vo[j][ks] = *(const LAS bf16x8*)(lds + H2_VT_OFF + ((eb0 + j) * 16 + fr) * H2_VT_LD + ks * 64 + fq * 16); \
              _Pragma("unroll") for (int kd = 0; kd < 4; ++kd) sf[j][kd] = *(const LAS bf16x8*)(lds + H2_ST_OFF + ((eb0 + j) * 16 + fr) * H2_ST_LD + kd * 64 + fq * 16); } \
          asm volatile("s_waitcnt lgkmcnt(0)" ::: "memory"); __builtin_amdgcn_sched_barrier(0); \
          f32x4 acc0 = {0.f, 0.f, 0.f, 0.f}, acc1 = {0.f, 0.f, 0.f, 0.f}; \
          _Pragma("unroll") for (int ks = 0; ks < 2; ++ks) { acc0 = __builtin_amdgcn_mfma_f32_16x16x32_bf16(vo[0][ks], afr[ks], acc0, 0, 0, 0); acc1 = __builtin_amdgcn_mfma_f32_16x16x32_bf16(vo[1][ks], afr[ks], acc1, 0, 0, 0); } \
          _Pragma("unroll") for (int kd = 0; kd < 4; ++kd) { acc0 = __builtin_amdgcn_mfma_f32_16x16x32_bf16(sf[0][kd], qfr[kd], acc0, 0, 0, 0); acc1 = __builtin_amdgcn_mfma_f32_16x16x32_bf16(sf[1][kd], qfr[kd], acc1, 0, 0, 0); } \
          __builtin_amdgcn_sched_barrier(0); \
          bf16x8 kfr[2], vb[4][2]; \
          _Pragma("unroll") for (int ks = 0; ks < 2; ++ks) kfr[ks] = *(const LAS bf16x8*)(lds + H2_KT_OFF + (16 * wave + fr) * H2_KT_LD + ks * 64 + fq * 16); \
          _Pragma("unroll") for (int eb = 0; eb < 4; ++eb) _Pragma("unroll") for (int ks = 0; ks < 2; ++ks) vb[eb][ks] = *(const LAS bf16x8*)(lds + H2_VT_OFF + (eb * 16 + fr) * H2_VT_LD + ks * 64 + fq * 16); \
          _Pragma("unroll") for (int eb = 0; eb < 4; ++eb) S[eb] = S[eb] * g4; \
          asm volatile("s_waitcnt lgkmcnt(0)" ::: "memory"); __builtin_amdgcn_sched_barrier(0); \
          _Pragma("unroll") for (int ks = 0; ks < 2; ++ks) _Pragma("unroll") for (int eb = 0; eb < 4; ++eb) S[eb] = __builtin_amdgcn_mfma_f32_16x16x32_bf16(kfr[ks], vb[eb][ks], S[eb], 0, 0, 0); \
          if (!SAMP || tb < 2) { v2u o; o.x = pk2(acc0[0], acc0[1]); o.y = pk2(acc0[2], acc0[3]); *(v2u*)((char*)OG + ((size_t)row0 * D + h * 256 + es * 64) * 2 + OF.o) = o; \
                                 o.x = pk2(acc1[0], acc1[1]); o.y = pk2(acc1[2], acc1[3]); *(v2u*)((char*)OG + ((size_t)row0 * D + h * 256 + es * 64) * 2 + OF.o + 32) = o; } } \
    } while (0)
    H2_LOADC(R0, 0); if (!SAMP) H2_LOADC(R1, 1);
    LDS_BAR();
    if (SAMP) { H2_STEP(R0, R2, 0, 0); }
    else {
        H2_STEP(R0, R2, 0, 0); H2_STEP(R1, R0, 1, 1);
        for (int c = 2; c < 62; c += 6) { H2_STEP(R2, R1, c, 0); H2_STEP(R0, R2, c + 1, 1); H2_STEP(R1, R0, c + 2, 0); H2_STEP(R2, R1, c + 3, 1); H2_STEP(R0, R2, c + 4, 0); H2_STEP(R1, R0, c + 5, 1); }
        H2_STEP(R2, R1, 62, 0); H2_STEP(R0, R2, 63, 1);
    }
#undef H2_STEP
#undef H2_LOADC
    float* so = a.out + (SAMP ? O_SGS : O_SGP);
#pragma unroll
    for (int eb = 0; eb < 4; ++eb)
#pragma unroll
        for (int r = 0; r < 4; ++r) so[((size_t)bh * 128 + 16 * wave + 4 * fq + r) * 256 + es * 64 + eb * 16 + fr] = S[eb][r];
}

template <int RM, int RN> __device__ __forceinline__ void sg_kloop2(f32x4 (&c)[RM][RN], const bf16* ap, int arow16, const bf16* (&bp)[RN], int K) {
#pragma unroll 4
    for (int k0 = 0; k0 < K; k0 += 32) {
        bf16x8 av[RM], bv[RN];
#pragma unroll
        for (int r = 0; r < RM; ++r) av[r] = *(const bf16x8*)(ap + (size_t)r * arow16 + k0);
#pragma unroll
        for (int n = 0; n < RN; ++n) bv[n] = *(const bf16x8*)(bp[n] + k0);
#pragma unroll
        for (int r = 0; r < RM; ++r)
#pragma unroll
            for (int n = 0; n < RN; ++n) c[r][n] = __builtin_amdgcn_mfma_f32_16x16x32_bf16(bv[n], av[r], c[r][n], 0, 0, 0);
    }
}
__device__ __forceinline__ float sg_rstd(const float* ssqs, int lr, int fq) {
    const f32x4* p = (const f32x4*)(ssqs + (size_t)lr * 64 + fq * 16);
    const f32x4 a = p[0], b = p[1], c = p[2], d = p[3];
    float s = ((a.x + a.y) + (a.z + a.w)) + ((b.x + b.y) + (b.z + b.w)) + ((c.x + c.y) + (c.z + c.w)) + ((d.x + d.y) + (d.z + d.w));
    s += __shfl_xor(s, 16); s += __shfl_xor(s, 32);
    return __builtin_amdgcn_rsqf(s * (1.0f / D) + EPS);
}
__device__ __forceinline__ void sg_swiglu(const Args& a, Frame& F, const bf16* Wt, const float* ssqs) {
    const int gw = F.vcu * NWAVES + F.wave, NGW = F.G * NWAVES, fr = F.lane & 15, fq = F.lane >> 4;
    const bf16* XB = (const bf16*)(a.ws + WS_XB); bf16* ACT = (bf16*)(a.ws + WS_ACT);
    LAS f32x4* xch = (LAS f32x4*)F.lds;
    for (int it = gw; it < 2 * 4 * (FF / 16); it += NGW) {
        const int id = it >> 1, kh = it & 1, mq = id & 3, jb = id >> 2, g0 = 16 * jb;
        const int grow = 256 * (g0 >> 7) + (g0 & 127);
        const bf16* bp[2] = {Wt + (size_t)(grow + fr) * D + kh * (D / 2) + 8 * fq, Wt + (size_t)(grow + 128 + fr) * D + kh * (D / 2) + 8 * fq};
        f32x4 c[4][2];
#pragma unroll
        for (int r = 0; r < 4; ++r) { c[r][0] = (f32x4){0.f, 0.f, 0.f, 0.f}; c[r][1] = (f32x4){0.f, 0.f, 0.f, 0.f}; }
        sg_kloop2<4, 2>(c, XB + (size_t)(MP + mq * 64 + fr) * D + kh * (D / 2) + 8 * fq, 16 * D, bp, D / 2);
        __syncthreads();
        if (kh) {
#pragma unroll
            for (int r = 0; r < 4; ++r) { xch[((F.wave >> 1) * 8 + 2 * r) * 64 + F.lane] = c[r][0]; xch[((F.wave >> 1) * 8 + 2 * r + 1) * 64 + F.lane] = c[r][1]; }
        }
        __syncthreads();
        if (!kh) {
#pragma unroll
            for (int r = 0; r < 4; ++r) {
                const int lr = mq * 64 + r * 16 + fr, m = MP + lr;
                const f32x4 g = c[r][0] + xch[((F.wave >> 1) * 8 + 2 * r) * 64 + F.lane], up = c[r][1] + xch[((F.wave >> 1) * 8 + 2 * r + 1) * 64 + F.lane];
                const float rs = sg_rstd(ssqs, lr, fq);
                float o[4];
#pragma unroll
                for (int j = 0; j < 4; ++j) o[j] = siluf_(g[j] * rs) * (up[j] * rs);
                v2u w; w.x = pk2(o[0], o[1]); w.y = pk2(o[2], o[3]);
                *(v2u*)(ACT + (size_t)m * FF + g0 + 4 * fq) = w;
            }
        }
    }
}
__device__ __forceinline__ void sg_resid(const Args& a, Frame& F, const bf16* A, int lda, const bf16* Wt, int K, const float* res_f32, float alpha, float* ssqs_out) {
    const int fr = F.lane & 15, fq = F.lane >> 4;
    bf16* XB = (bf16*)(a.ws + WS_XB);
    LAS f32x4* xch = (LAS f32x4*)F.lds;
    const int Ks = K >> 3, ks = F.wave * Ks;
    for (int u = F.vcu; u < 8 * (D / 32); u += F.G) {
        const int mp = u & 7, np = u >> 3;
        const bf16* bp[2] = {Wt + (size_t)(32 * np + fr) * K + ks + 8 * fq, Wt + (size_t)(32 * np + 16 + fr) * K + ks + 8 * fq};
        f32x4 c[2][2] = {{{0.f, 0.f, 0.f, 0.f}, {0.f, 0.f, 0.f, 0.f}}, {{0.f, 0.f, 0.f, 0.f}, {0.f, 0.f, 0.f, 0.f}}};
        sg_kloop2<2, 2>(c, A + (size_t)(MP + mp * 32 + fr) * lda + ks + 8 * fq, 16 * lda, bp, Ks);
        __syncthreads();
#pragma unroll
        for (int r = 0; r < 2; ++r) { xch[(F.wave * 4 + 2 * r) * 64 + F.lane] = c[r][0]; xch[(F.wave * 4 + 2 * r + 1) * 64 + F.lane] = c[r][1]; }
        __syncthreads();
        if (F.wave < 4) {
            f32x4 s = xch[F.wave * 64 + F.lane];
#pragma unroll
            for (int q = 1; q < 8; ++q) s += xch[(q * 4 + F.wave) * 64 + F.lane];
            const int r = F.wave >> 1, nb = 2 * np + (F.wave & 1), lr = mp * 32 + r * 16 + fr, m = MP + lr, n0 = 16 * nb + 4 * fq;
            f32x4 rr;
            if (res_f32) rr = *(const f32x4*)(res_f32 + (size_t)lr * D + n0);
            else { const v2u rb = *(const v2u*)(XB + (size_t)m * D + n0); rr = (f32x4){bflo(rb.x), bfhi(rb.x), bflo(rb.y), bfhi(rb.y)}; }
            const f32x4 v = rr + s * alpha;
            { v2u w; w.x = pk2(v[0], v[1]); w.y = pk2(v[2], v[3]); *(v2u*)(XB + (size_t)m * D + n0) = w; }
            if (ssqs_out) { float ss = (v[0] * v[0] + v[1] * v[1]) + (v[2] * v[2] + v[3] * v[3]); ss += __shfl_xor(ss, 16); ss += __shfl_xor(ss, 32); if (fq == 0) ssqs_out[(size_t)lr * 64 + nb] = ss; }
        }
    }
}
__device__ __forceinline__ void sg_proj(const Args& a, Frame& F) {
    const int gw = F.vcu * NWAVES + F.wave, NGW = F.G * NWAVES, fr = F.lane & 15, fq = F.lane >> 4;
    unsigned char* ws = a.ws;
    const bf16* XB = (const bf16*)(ws + WS_XB); const bf16* Wt = (const bf16*)(ws + WS_WAT); const float* ssqs = (const float*)(ws + WS_SSQAS);
    constexpr int NBLK = (NA - 240) / 16, NPAIR = (NBLK + 1) / 2;
    LAS f32x4* xch = (LAS f32x4*)F.lds;
    for (int it = gw; it < 2 * 4 * NPAIR; it += NGW) {
        const int id = it >> 1, kh = it & 1, mq = id & 3, jp = id >> 2;
        const bf16* bp[2] = {Wt + (size_t)(32 * jp + fr) * D + kh * (D / 2) + 8 * fq, Wt + (size_t)(32 * jp + 16 + fr) * D + kh * (D / 2) + 8 * fq};
        f32x4 c[4][2];
#pragma unroll
        for (int r = 0; r < 4; ++r) { c[r][0] = (f32x4){0.f, 0.f, 0.f, 0.f}; c[r][1] = (f32x4){0.f, 0.f, 0.f, 0.f}; }
        sg_kloop2<4, 2>(c, XB + (size_t)(MP + mq * 64 + fr) * D + kh * (D / 2) + 8 * fq, 16 * D, bp, D / 2);
        __syncthreads();
        if (kh) {
#pragma unroll
            for (int r = 0; r < 4; ++r) { xch[((F.wave >> 1) * 8 + 2 * r) * 64 + F.lane] = c[r][0]; xch[((F.wave >> 1) * 8 + 2 * r + 1) * 64 + F.lane] = c[r][1]; }
        }
        __syncthreads();
        if (kh) continue;
#pragma unroll
        for (int r = 0; r < 4; ++r) {
            const int lr = mq * 64 + r * 16 + fr, m = MP + lr;
            const float rs = sg_rstd(ssqs, lr, fq);
#pragma unroll
            for (int n = 0; n < 2; ++n) {
                const int n0 = 32 * jp + 16 * n, nq = n0 + 4 * fq;
                if (n0 >= 16 * NBLK) continue;
                f32x4 v = (c[r][n] + xch[((F.wave >> 1) * 8 + 2 * r + n) * 64 + F.lane]) * rs;
                if (n0 >= 4352) {
                    *(f32x4*)((float*)(ws + WS_GLR) + (size_t)m * 16 + 4 * fq) = v;
                } else if (n0 >= 4096) {
                    v2u w; w.x = pk2(v[0], v[1]); w.y = pk2(v[2], v[3]);
                    *(v2u*)((bf16*)(ws + WS_SKV) + (size_t)m * 256 + (nq - 4096)) = w;
                    const int bs = lr >> 5, t = lr & 31;
                    *(f32x4*)(a.out + (nq < 4224 ? O_CKS : O_CVS) + ((size_t)(bs * WINDOW + 96 + t)) * 128 + ((nq - 4096) & 127)) = v;
                } else {
                    bf16* dst; int col;
                    if (n0 < 1024) { dst = (bf16*)(ws + WS_T0); col = nq; if (n0 < 512) v = v * 0.08838834764831845f; }
                    else if (n0 < 2048) { dst = (bf16*)(ws + WS_T1); col = nq - 1024; }
                    else if (n0 < 3072) { dst = (bf16*)(ws + WS_T2); col = nq - 2048; v = v * (0.125f * LOG2E); }
                    else { dst = (bf16*)(ws + WS_T8); col = nq - 3072;
#pragma unroll
                        for (int j = 0; j < 4; ++j) v[j] = siluf_(v[j]); }
                    v2u w; w.x = pk2(v[0], v[1]); w.y = pk2(v[2], v[3]);
                    *(v2u*)(dst + (size_t)m * D + col) = w;
                }
            }
        }
    }
}
__device__ __forceinline__ void sg_gates(const Args& a, Frame& F) {
    const int fr = F.lane & 15, fq = F.lane >> 4;
    unsigned char* ws = a.ws;
    const bf16* XB = (const bf16*)(ws + WS_XB); const bf16* Wt = (const bf16*)(ws + WS_WBT); const float* ssqs = (const float*)(ws + WS_SSQAS);
    bf16* R = (bf16*)(ws + WS_T0); bf16* SS = (bf16*)(ws + WS_T7);
    LAS f32x4* xch = (LAS f32x4*)F.lds;
    const int ks = F.wave * (D / 8);
    for (int u = F.vcu; u < 4 * (D / 16); u += F.G) {
        const int mq = u & 3, nb = u >> 2, n0 = 16 * nb;
        const int grow = 256 * (n0 >> 7) + (n0 & 127);
        const bf16* bp[2] = {Wt + (size_t)(grow + fr) * D + ks + 8 * fq, Wt + (size_t)(grow + 128 + fr) * D + ks + 8 * fq};
        f32x4 c[4][2];
#pragma unroll
        for (int r = 0; r < 4; ++r) { c[r][0] = (f32x4){0.f, 0.f, 0.f, 0.f}; c[r][1] = (f32x4){0.f, 0.f, 0.f, 0.f}; }
        sg_kloop2<4, 2>(c, XB + (size_t)(MP + mq * 64 + fr) * D + ks + 8 * fq, 16 * D, bp, D / 8);
        __syncthreads();
#pragma unroll
        for (int r = 0; r < 4; ++r) { xch[(F.wave * 8 + 2 * r) * 64 + F.lane] = c[r][0]; xch[(F.wave * 8 + 2 * r + 1) * 64 + F.lane] = c[r][1]; }
        __syncthreads();
        if (F.wave < 4) {
            f32x4 cg = xch[(2 * F.wave) * 64 + F.lane], cs = xch[(2 * F.wave + 1) * 64 + F.lane];
#pragma unroll
            for (int q = 1; q < 8; ++q) { cg += xch[(q * 8 + 2 * F.wave) * 64 + F.lane]; cs += xch[(q * 8 + 2 * F.wave + 1) * 64 + F.lane]; }
            const int lr = mq * 64 + F.wave * 16 + fr, m = MP + lr;
            const float rs = sg_rstd(ssqs, lr, fq);
            float r[4], ss[4];
#pragma unroll
            for (int j = 0; j < 4; ++j) { const float eg = fast_exp(-cg[j] * rs), es = fast_exp(-cs[j] * rs); ss[j] = fast_rcp(1.0f + es); r[j] = (1.0f + es) * fast_rcp(1.0f + eg); }
            v2u w; w.x = pk2(r[0], r[1]); w.y = pk2(r[2], r[3]); *(v2u*)(R + (size_t)m * D + n0 + 4 * fq) = w;
            w.x = pk2(ss[0], ss[1]); w.y = pk2(ss[2], ss[3]); *(v2u*)(SS + (size_t)m * D + n0 + 4 * fq) = w;
        }
    }
}
__device__ __forceinline__ void sg_branch(const Args& a, Frame& F) {
    const int fr = F.lane & 15, fq = F.lane >> 4;
    unsigned char* ws = a.ws;
    const bf16* Wt = (const bf16*)(ws + WS_WBRT);
    const bf16* GG = (const bf16*)(ws + WS_T0); const bf16* GS = (const bf16*)(ws + WS_T7); bf16* O = (bf16*)(ws + WS_T8);
    LAS f32x4* xch = (LAS f32x4*)F.lds;
    const int half = F.wave >> 2, kq = (F.wave & 3) * (D / 4);
    const bf16* Asrc = (const bf16*)(ws + (half ? WS_T2 : WS_T1));
    for (int u = F.vcu; u < 8 * (D / 32); u += F.G) {
        const int mp = u & 7, np = u >> 3;
        const bf16* bp[2] = {Wt + (size_t)(32 * np + fr) * (2 * D) + half * D + kq + 8 * fq, Wt + (size_t)(32 * np + 16 + fr) * (2 * D) + half * D + kq + 8 * fq};
        f32x4 c[2][2] = {{{0.f, 0.f, 0.f, 0.f}, {0.f, 0.f, 0.f, 0.f}}, {{0.f, 0.f, 0.f, 0.f}, {0.f, 0.f, 0.f, 0.f}}};
        sg_kloop2<2, 2>(c, Asrc + (size_t)(MP + mp * 32 + fr) * D + kq + 8 * fq, 16 * D, bp, D / 4);
        __syncthreads();
#pragma unroll
        for (int r = 0; r < 2; ++r) { xch[(F.wave * 4 + 2 * r) * 64 + F.lane] = c[r][0]; xch[(F.wave * 4 + 2 * r + 1) * 64 + F.lane] = c[r][1]; }
        __syncthreads();
        if (F.wave < 4) {
            f32x4 ca = xch[F.wave * 64 + F.lane], cb = xch[(16 + F.wave) * 64 + F.lane];
#pragma unroll
            for (int q = 1; q < 4; ++q) { ca += xch[(q * 4 + F.wave) * 64 + F.lane]; cb += xch[((4 + q) * 4 + F.wave) * 64 + F.lane]; }
            const int r = F.wave >> 1, m = MP + mp * 32 + r * 16 + fr, n0 = 16 * (2 * np + (F.wave & 1)) + 4 * fq;
            const v2u g = *(const v2u*)(GG + (size_t)m * D + n0), sv = *(const v2u*)(GS + (size_t)m * D + n0);
            const float rr[4] = {bflo(g.x), bfhi(g.x), bflo(g.y), bfhi(g.y)}, ss[4] = {bflo(sv.x), bfhi(sv.x), bflo(sv.y), bfhi(sv.y)};
            v2u w; w.x = pk2((ca[0] * rr[0] + cb[0]) * ss[0], (ca[1] * rr[1] + cb[1]) * ss[1]); w.y = pk2((ca[2] * rr[2] + cb[2]) * ss[2], (ca[3] * rr[3] + cb[3]) * ss[3]);
            *(v2u*)(O + (size_t)m * D + n0) = w;
        }
    }
}

template <int K> __device__ __forceinline__ void run_phase(const Args& args, LAS unsigned char* ldsp) {
    Frame F;
    { int t = threadIdx.x; asm volatile("" : "+v"(t)); F.tid = t; }
    F.lds = ldsp; F.lane = F.tid & 63; F.wave = __builtin_amdgcn_readfirstlane(F.tid >> 6);
    F.G = gridDim.x; { const int bx = blockIdx.x; F.vcu = (F.G % 8 == 0) ? (bx % 8) * (F.G / 8) + bx / 8 : bx; }
    F.out = args.out; F.ws = args.ws;
    unsigned char* ws = args.ws;
    const int gw = F.vcu * NWAVES + F.wave, NGW = F.G * NWAVES;
    bf16* XB = (bf16*)(ws + WS_XB); bf16* ACT = (bf16*)(ws + WS_ACT);
    float* X = args.out + O_Y;
    (void)gw; (void)NGW; (void)XB; (void)ACT; (void)X;
    if constexpr (K == 0) { p0_prologue(args, F); }
    if constexpr (K == 1) {
        pg8::Gemm g{XB, XB, (const bf16*)(ws + WS_W1T), D, D, D, 1}; pg8::StaticOrder S; S.init(MP / 256, 2 * FF / 256, 1, F.G, (int)blockIdx.x);
        pg8::EpiSwiglu E{ACT, (const float*)(ws + WS_SSQ0)};
        pg8::gemm_phase<pg8::EpiSwiglu, true>(F.lds, g, S, E);
        sg_swiglu(args, F, (const bf16*)(ws + WS_W1T), (const float*)(ws + WS_SSQ0S));
    }
    if constexpr (K == 2) {
        pg8::Gemm g{ACT, ACT, (const bf16*)(ws + WS_W1OT), FF, FF, FF, 1}; pg8::StaticOrder S; S.init(MP / 256, D / 256, 1, F.G, (int)blockIdx.x);
        pg8::EpiResid<true> E{nullptr, XB, (float*)(ws + WS_SSQA), 0.5f};
        pg8::gemm_phase<pg8::EpiResid<true>, true>(F.lds, g, S, E);
        sg_resid(args, F, ACT, FF, (const bf16*)(ws + WS_W1OT), FF, nullptr, 0.5f, (float*)(ws + WS_SSQAS));
    }
    if constexpr (K == 3) {
        pg8::Gemm g{XB, XB, (const bf16*)(ws + WS_WAT), D, D, D, 1}; pg8::StaticOrder S; S.init(MP / 256, NA / 256, 1, F.G, (int)blockIdx.x);
        pg8::EpiProjA E{(bf16*)(ws + WS_T0), (bf16*)(ws + WS_T1), (bf16*)(ws + WS_T2), (bf16*)(ws + WS_T8), (bf16*)(ws + WS_SKV), (float*)(ws + WS_GLR), args.out, (const float*)(ws + WS_SSQA)};
        pg8::gemm_phase<pg8::EpiProjA, true>(F.lds, g, S, E);
        sg_proj(args, F);
    }
    if constexpr (K == 4) {
#define G1_SEQ(u) ((u) < NB * 64 * GH ? (u) >> 8 : NB + (((u) - NB * 64 * GH) >> 2))
#define G1_CHK(u) ((u) < NB * 64 * GH ? ((u) >> 2) & 63 : 0)
        const int hh = F.vcu & 3, dcol = F.tid & 127;
        float w[16];
#pragma unroll
        for (int r = 0; r < 16; ++r) w[r] = args.in[10][r * 512 + hh * 128 + dcol];
        const float bias = args.in[11][hh * 128 + dcol];
        G1Regs RA, RB;
        int u = F.vcu;
        if (u < NUNIT_G) g1_load(RA, args, G1_SEQ(u), G1_CHK(u), hh, F.tid);
        while (u < NUNIT_G) {
            const int u1 = u + F.G; if (u1 < NUNIT_G) g1_load(RB, args, G1_SEQ(u1), G1_CHK(u1), hh, F.tid);
            g1_compute(RA, w, bias, args, F, G1_SEQ(u), G1_CHK(u), hh);
            if (u1 >= NUNIT_G) break;
            const int u2 = u1 + F.G; if (u2 < NUNIT_G) g1_load(RA, args, G1_SEQ(u2), G1_CHK(u2), hh, F.tid);
            g1_compute(RB, w, bias, args, F, G1_SEQ(u1), G1_CHK(u1), hh);
            u = u2;
        }
#undef G1_SEQ
#undef G1_CHK
    }
    if constexpr (K == 5) {
        const int nh = F.G >> 1;
        constexpr int NSWA_P = NB * 64 * SKV, NSWA_S = NB * SKV;
        if ((F.vcu & 1) == 0) {
            for (int it = F.vcu >> 1; it < NB * GH * 4; it += nh) { g2_item<false>(args, F, it >> 2, it & 3); g2_item<true>(args, F, it >> 2, it & 3); }
        } else {
            for (int us = F.vcu >> 1; us < NSWA_S; us += nh) swa_unit(args, F, NB + (us >> 1), 0, us & 1);
        }
    }
    if constexpr (K == 12) {
        constexpr int NSWA_P = NB * 64 * SKV;
        unsigned* qhead = (unsigned*)(ws + WS_CTL) + 12288;
        volatile LAS unsigned* qslot = (volatile LAS unsigned*)(F.lds + MISC_OFF) + 16;
        unsigned t0 = 0, t1 = 0;
        if (F.tid == 0) { t0 = __hip_atomic_fetch_add(qhead, 1u, __ATOMIC_RELAXED, __HIP_MEMORY_SCOPE_AGENT); t1 = __hip_atomic_fetch_add(qhead, 1u, __ATOMIC_RELAXED, __HIP_MEMORY_SCOPE_AGENT); qslot[0] = t0; qslot[1] = t1; }
        __syncthreads();
        int u = (int)qslot[0], u1 = (int)qslot[1];
        SwaRegs RA, RB;
        if (u < NSWA_P) swa_p_load(RA, args, u, F.tid);
        while (u < NSWA_P) {
            unsigned tn = 0;
            if (F.tid == 0) tn = __hip_atomic_fetch_add(qhead, 1u, __ATOMIC_RELAXED, __HIP_MEMORY_SCOPE_AGENT);
            if (u1 < NSWA_P) swa_p_load(RB, args, u1, F.tid);
            swa_p_compute(RA, args, F, u);
            if (F.tid == 0) qslot[2] = tn;
            LDS_BAR();
            const int u2 = (int)qslot[2];
            if (u1 >= NSWA_P) break;
            if (F.tid == 0) tn = __hip_atomic_fetch_add(qhead, 1u, __ATOMIC_RELAXED, __HIP_MEMORY_SCOPE_AGENT);
            if (u2 < NSWA_P) swa_p_load(RA, args, u2, F.tid);
            swa_p_compute(RB, args, F, u1);
            if (F.tid == 0) qslot[3] = tn;
            LDS_BAR();
            u = u2; u1 = (int)qslot[3];
        }
        if (F.vcu & 1) {
            LDS_BAR();
            LAS float* scr = (LAS float*)(F.lds + F.wave * 16384);
            for (int l = (F.vcu >> 1) * NWAVES + F.wave; l < P0_NLATE; l += (F.G >> 1) * NWAVES) p0_weight_item(args, P0_NEARLY + l, scr, F.lane);
        }
    }
    if constexpr (K == 6) {
        bf16* OG = (bf16*)(ws + WS_T1); const bf16* GR = (const bf16*)(ws + WS_T8);
        for (int m0 = gw; m0 < M; m0 += 4 * NGW) {
            v4u ov[4][2], gv4[4][2];
#pragma unroll
            for (int r = 0; r < 4; ++r) { const int m = m0 + r * NGW; if (m < M) {
                ov[r][0] = *(const v4u*)(OG + (size_t)m * D + 16 * F.lane); ov[r][1] = *(const v4u*)(OG + (size_t)m * D + 16 * F.lane + 8);
                gv4[r][0] = *(const v4u*)(GR + (size_t)m * D + 16 * F.lane); gv4[r][1] = *(const v4u*)(GR + (size_t)m * D + 16 * F.lane + 8); } }
#pragma unroll
            for (int r = 0; r < 4; ++r) { const int m = m0 + r * NGW; if (m < M) {
                const v4u o0 = ov[r][0], o1 = ov[r][1], g0 = gv4[r][0], g1 = gv4[r][1];
                float ovf[16] = {bflo(o0.x), bfhi(o0.x), bflo(o0.y), bfhi(o0.y), bflo(o0.z), bfhi(o0.z), bflo(o0.w), bfhi(o0.w), bflo(o1.x), bfhi(o1.x), bflo(o1.y), bfhi(o1.y), bflo(o1.z), bfhi(o1.z), bflo(o1.w), bfhi(o1.w)};
                const float gvf[16] = {bflo(g0.x), bfhi(g0.x), bflo(g0.y), bfhi(g0.y), bflo(g0.z), bfhi(g0.z), bflo(g0.w), bfhi(g0.w), bflo(g1.x), bfhi(g1.x), bflo(g1.y), bfhi(g1.y), bflo(g1.z), bfhi(g1.z), bflo(g1.w), bfhi(g1.w)};
                float ss = 0.f;
#pragma unroll
                for (int j = 0; j < 16; ++j) ss += ovf[j] * ovf[j];
                ss += __shfl_xor(ss, 1); ss += __shfl_xor(ss, 2); ss += __shfl_xor(ss, 4); ss += __shfl_xor(ss, 8);
                const float rs = __builtin_amdgcn_rsqf(ss * (1.0f / GDV) + EPS);
#pragma unroll
                for (int j = 0; j < 16; ++j) ovf[j] = ovf[j] * rs * gvf[j];
                v4u w0, w1;
                w0.x = pk2(ovf[0], ovf[1]); w0.y = pk2(ovf[2], ovf[3]); w0.z = pk2(ovf[4], ovf[5]); w0.w = pk2(ovf[6], ovf[7]);
                w1.x = pk2(ovf[8], ovf[9]); w1.y = pk2(ovf[10], ovf[11]); w1.z = pk2(ovf[12], ovf[13]); w1.w = pk2(ovf[14], ovf[15]);
                *(v4u*)(OG + (size_t)m * D + 16 * F.lane) = w0; *(v4u*)(OG + (size_t)m * D + 16 * F.lane + 8) = w1; } }
        }
        __syncthreads();
        pg8::Gemm g{XB, XB, (const bf16*)(ws + WS_WBT), D, D, D, 1}; pg8::StaticOrder S; S.init(MP / 256, NBP / 256, 1, F.G, (int)blockIdx.x);
        pg8::EpiProjB E{(bf16*)(ws + WS_T0), (bf16*)(ws + WS_T7), (const float*)(ws + WS_SSQA)};
        pg8::gemm_phase<pg8::EpiProjB, true>(F.lds, g, S, E);
        sg_gates(args, F);
    }
    if constexpr (K == 7) {
        pg8::Gemm g{(const bf16*)(ws + WS_T1), (const bf16*)(ws + WS_T2), (const bf16*)(ws + WS_WBRT), D, 2 * D, D, 2}; pg8::StaticOrder S; S.init(MP / 256, D / 256, 2, F.G, (int)blockIdx.x);
        pg8::EpiBranch E{(const bf16*)(ws + WS_T0), (const bf16*)(ws + WS_T7), (bf16*)(ws + WS_T8)};
        pg8::gemm_phase<pg8::EpiBranch, true>(F.lds, g, S, E);
        sg_branch(args, F);
    }
    if constexpr (K == 8) {
        pg8::Gemm g{(const bf16*)(ws + WS_T8), (const bf16*)(ws + WS_T8), (const bf16*)(ws + WS_WOUTT), D, D, D, 1}; pg8::StaticOrder S; S.init(MP / 256, D / 256, 1, F.G, (int)blockIdx.x);
        pg8::EpiResid<true> E{nullptr, XB, (float*)(ws + WS_SSQB), 1.0f};
        pg8::gemm_phase<pg8::EpiResid<true>, true>(F.lds, g, S, E);
        sg_resid(args, F, (const bf16*)(ws + WS_T8), D, (const bf16*)(ws + WS_WOUTT), D, nullptr, 1.0f, (float*)(ws + WS_SSQBS));
    }
    if constexpr (K == 9) {
        pg8::Gemm g{XB, XB, (const bf16*)(ws + WS_W2T), D, D, D, 1}; pg8::StaticOrder S; S.init(MP / 256, 2 * FF / 256, 1, F.G, (int)blockIdx.x);
        pg8::EpiSwiglu E{ACT, (const float*)(ws + WS_SSQB)};
        pg8::gemm_phase<pg8::EpiSwiglu, true>(F.lds, g, S, E);
        sg_swiglu(args, F, (const bf16*)(ws + WS_W2T), (const float*)(ws + WS_SSQBS));
    }
    if constexpr (K == 10) {
        pg8::Gemm g{ACT, ACT, (const bf16*)(ws + WS_W2OT), FF, FF, FF, 1}; pg8::StaticOrder S; S.init(MP / 256, D / 256, 1, F.G, (int)blockIdx.x);
        pg8::EpiFinal E{XB, X, args.in[20], (unsigned*)(ws + WS_XSLOT), (unsigned*)(ws + WS_CTL) + CW_PAN, 0.5f};
        pg8::gemm_phase<pg8::EpiFinal, true>(F.lds, g, S, E);
        sg_resid(args, F, ACT, FF, (const bf16*)(ws + WS_W2OT), FF, nullptr, 0.5f, nullptr);
    }
    if constexpr (K == 11) {
        const f32x4* gf = (const f32x4*)args.in[20];
        f32x4 g4[4];
#pragma unroll
        for (int q = 0; q < 4; ++q) g4[q] = gf[4 * F.lane + q];
        for (int m0 = MP + gw; m0 < M; m0 += 4 * NGW) {
            v4u xv[4][2];
#pragma unroll
            for (int r = 0; r < 4; ++r) { const int m = m0 + r * NGW; if (m < M) { xv[r][0] = *(const v4u*)(XB + (size_t)m * D + 16 * F.lane); xv[r][1] = *(const v4u*)(XB + (size_t)m * D + 16 * F.lane + 8); } }
#pragma unroll
            for (int r = 0; r < 4; ++r) { const int m = m0 + r * NGW; if (m < M) {
                const v4u x0 = xv[r][0], x1 = xv[r][1];
                float v[16] = {bflo(x0.x), bfhi(x0.x), bflo(x0.y), bfhi(x0.y), bflo(x0.z), bfhi(x0.z), bflo(x0.w), bfhi(x0.w), bflo(x1.x), bfhi(x1.x), bflo(x1.y), bfhi(x1.y), bflo(x1.z), bfhi(x1.z), bflo(x1.w), bfhi(x1.w)};
                float s2 = 0.f;
#pragma unroll
                for (int j = 0; j < 16; ++j) s2 += v[j] * v[j];
                const float rs = __builtin_amdgcn_rsqf(wave_sum(s2) * (1.0f / D) + EPS);
                f32x4* yr = (f32x4*)(X + (size_t)m * D + 16 * F.lane);
#pragma unroll
                for (int q = 0; q < 4; ++q) yr[q] = (f32x4){v[4 * q] * rs * g4[q][0], v[4 * q + 1] * rs * g4[q][1], v[4 * q + 2] * rs * g4[q][2], v[4 * q + 3] * rs * g4[q][3]}; } }
        }
    }
}

#ifndef MK_SEQ
#define MK_SEQ P(0) S P(1) S P(2) S P(3) S P(4) S P(5) P(12) S P(6) S P(7) S P(8) S P(9) S P(10) S P(11)
#endif
__global__ void __launch_bounds__(NWAVES * 64, 2) mk_fwd(Args args) {
    extern __shared__ __attribute__((aligned(16))) unsigned char lds[];
    LAS unsigned char* ldsp = (LAS unsigned char*)lds;
    volatile LAS unsigned* MISC = (volatile LAS unsigned*)(ldsp + MISC_OFF);
    if (threadIdx.x < 32) MISC[threadIdx.x] = 0u;
    __syncthreads();
    XcdBarrier bar = xcd_barrier_post((unsigned*)(args.ws + WS_CTL) + 4096, MISC + 8);
#define P(k) if (args.ph_hi > (k)) run_phase<k>(args, ldsp);
#define S xcd_barrier(bar);
    MK_SEQ
#undef P
#undef S
}

extern "C" void kernel_launch(void* const* d_in, const int* in_sizes, int n_in, void* d_out, int out_size, void* d_ws, size_t ws_size, hipStream_t stream) {
    static int grid = 0;
    if (grid == 0) {
        if (n_in != 21 || in_sizes[0] != MP * D || (size_t)out_size != O_END || ws_size < WS_END) { fprintf(stderr, "kernel_launch: unexpected shapes (n_in %d in0 %d out %d ws %zu need %zu)\n", n_in, n_in > 0 ? in_sizes[0] : -1, out_size, ws_size, (size_t)WS_END); grid = -1; return; }
        int dev = 0, cus = 0, per_cu = 0;
        if (hipGetDevice(&dev) != hipSuccess || hipDeviceGetAttribute(&cus, hipDeviceAttributeMultiprocessorCount, dev) != hipSuccess) { grid = -1; return; }
        if (hipFuncSetAttribute((const void*)mk_fwd, hipFuncAttributeMaxDynamicSharedMemorySize, LDS_BYTES) != hipSuccess) { fprintf(stderr, "kernel_launch: hipFuncSetAttribute failed\n"); grid = -1; return; }
        if (hipOccupancyMaxActiveBlocksPerMultiprocessor(&per_cu, (const void*)mk_fwd, NWAVES * 64, LDS_BYTES) != hipSuccess || per_cu < 1) { fprintf(stderr, "kernel_launch: occupancy query says %d\n", per_cu); per_cu = 1; }
        (void)hipGetLastError();
        grid = cus;
    }
    if (grid < 0) return;
    Args a{};
    for (int i = 0; i < 21; ++i) a.in[i] = (const float*)d_in[i];
    a.out = (float*)d_out; a.ws = (unsigned char*)d_ws;
    if (hipMemsetAsync((char*)d_ws + WS_CTL, 0, 65536, stream) != hipSuccess) { fprintf(stderr, "kernel_launch: memset failed\n"); return; }
    a.ph_lo = 0; a.ph_hi = 13;
    void* kargs[] = {&a};
    hipError_t e = hipLaunchCooperativeKernel((const void*)mk_fwd, dim3(grid), dim3(NWAVES * 64), kargs, LDS_BYTES, stream);
    if (e != hipSuccess) fprintf(stderr, "kernel_launch: cooperative launch failed: %s\n", hipGetErrorString(e));
}
```

```cpp
#include <hip/hip_runtime.h>
#include <hip/hip_cooperative_groups.h>
#include <cstdio>
#include <cstdint>
namespace cg = cooperative_groups;


constexpr int D = 1024, NB = 8, SEQ = 4096, DEC_T = 32;
constexpr int MP = NB * SEQ, MS = NB * DEC_T, M = MP + MS;
constexpr int FF = 2816;
constexpr int GH = 4, GDK = 128, GDV = 256, GRANK = 16;
constexpr int SH = 16, SKV = 2, SHD = 64, WINDOW = 128;
constexpr float EPS = 1e-6f;
constexpr float LOG2E = 1.4426950408889634f;
constexpr int NA = 18 * 256;
constexpr int NBP = 8 * 256;
constexpr int S_GQ = 0, S_GK = 512, S_GV = 1024, S_GR = 2048, S_GLR = 3072, S_SQ = 3088, S_SK = 4112, S_SV = 4240, S_GG = 4368, S_GS = 5392, IN_W = 6416;

constexpr size_t O_Y = 0;
constexpr size_t O_SGP = (size_t)M * D;
constexpr size_t O_CKP = O_SGP + (size_t)NB * GH * GDK * GDV;
constexpr size_t O_CVP = O_CKP + (size_t)NB * WINDOW * SKV * SHD;
constexpr size_t O_SGS = O_CVP + (size_t)NB * WINDOW * SKV * SHD;
constexpr size_t O_CKS = O_SGS + (size_t)NB * GH * GDK * GDV;
constexpr size_t O_CVS = O_CKS + (size_t)NB * WINDOW * SKV * SHD;
constexpr size_t O_END = O_CVS + (size_t)NB * WINDOW * SKV * SHD;

constexpr size_t MiB = 1u << 20;
constexpr size_t R1 = (size_t)M * D * 2;
constexpr size_t WS_CTL = 0;
constexpr size_t WS_W1T = 1 * MiB;
constexpr size_t WS_W1OT = WS_W1T + (size_t)2 * FF * D * 2;
constexpr size_t WS_WAT = WS_W1OT + (size_t)D * FF * 2;
constexpr size_t WS_WBT = WS_WAT + (size_t)NA * D * 2;
constexpr size_t WS_WBRT = WS_WBT + (size_t)NBP * D * 2;
constexpr size_t WS_WOUTT = WS_WBRT + (size_t)D * 2 * D * 2;
constexpr size_t WS_W2T = WS_WOUTT + (size_t)D * D * 2;
constexpr size_t WS_W2OT = WS_W2T + (size_t)2 * FF * D * 2;
constexpr size_t WS_SSQ0 = WS_W2OT + (size_t)D * FF * 2;
constexpr size_t SSQ_BYTES = (size_t)M * 16 * 4;
constexpr size_t WS_SSQA = WS_SSQ0 + SSQ_BYTES;
constexpr size_t WS_SSQB = WS_SSQA + SSQ_BYTES;
constexpr int NUNIT_G = NB * 64 * GH + NB * GH;
constexpr size_t SSQS_BYTES = (size_t)MS * 64 * 4;
constexpr size_t WS_SSQ0S = WS_SSQB + SSQ_BYTES, WS_SSQAS = WS_SSQ0S + SSQS_BYTES, WS_SSQBS = WS_SSQAS + SSQS_BYTES;
constexpr size_t WS_GDEC = WS_SSQBS + SSQS_BYTES;
constexpr size_t WS_XB = (WS_GDEC + (size_t)NUNIT_G * 128 * 4 + 4095) & ~(size_t)4095;
constexpr size_t WS_T0 = WS_XB + R1;
constexpr size_t WS_T1 = WS_T0 + R1;
constexpr size_t WS_T2 = WS_T1 + R1;
constexpr size_t WS_T7 = WS_T2 + R1;
constexpr size_t WS_T8 = WS_T7 + R1;
constexpr size_t WS_SKV = WS_T8 + R1;
constexpr size_t WS_ABUF = WS_SKV + (size_t)M * 256 * 2;
constexpr size_t WS_GLR = WS_ABUF + (size_t)M * 256 * 2;
constexpr size_t WS_XSLOT = (WS_GLR + (size_t)M * 16 * 4 + 4095) & ~(size_t)4095;
constexpr size_t WS_END = WS_XSLOT + (size_t)(MP / 256) * 256 * 4 * 4;
constexpr int CW_PAN = 13312, CW_PAN_STRIDE = 16;
constexpr size_t WS_ACT = WS_T0;
static_assert((size_t)M * FF * 2 <= 5 * R1, "act overlay");
static_assert(WS_END <= 512 * MiB, "workspace map must fit 512 MiB");

constexpr int RING_BYTES = 131072;
constexpr int PHASE_LDS = 155648;
constexpr int MISC_OFF = PHASE_LDS + 320;
constexpr int LDS_BYTES = 159744;
constexpr int NWAVES = 8;

#define GAS __attribute__((address_space(1)))
#define LAS __attribute__((address_space(3)))
typedef unsigned short bf16;
typedef unsigned v4u __attribute__((ext_vector_type(4)));
typedef unsigned v2u __attribute__((ext_vector_type(2)));
typedef float f32x4 __attribute__((ext_vector_type(4)));
typedef float f32x16 __attribute__((ext_vector_type(16)));
typedef short bf16x8 __attribute__((ext_vector_type(8)));
typedef float f32x2_t __attribute__((ext_vector_type(2)));
typedef __bf16 bf16x2_t __attribute__((ext_vector_type(2)));
#define LDS_WAIT() asm volatile("s_waitcnt lgkmcnt(0)" ::: "memory")
#define VM_WAIT() asm volatile("s_waitcnt vmcnt(0)" ::: "memory")
#define LDS_BAR() do { asm volatile("s_waitcnt lgkmcnt(0)" ::: "memory"); __builtin_amdgcn_s_barrier(); asm volatile("" ::: "memory"); } while (0)
__device__ __forceinline__ unsigned pk2(float lo, float hi) { f32x2_t v = {lo, hi}; bf16x2_t b = __builtin_convertvector(v, bf16x2_t); return __builtin_bit_cast(unsigned, b); }
__device__ __forceinline__ unsigned short f2bf(float f) { return (unsigned short)(pk2(f, 0.f) & 0xffffu); }
__device__ __forceinline__ float bf2f(unsigned short b) { return __uint_as_float((unsigned)b << 16); }
__device__ __forceinline__ float bflo(unsigned w) { return __uint_as_float(w << 16); }
__device__ __forceinline__ float bfhi(unsigned w) { return __uint_as_float(w & 0xffff0000u); }
__device__ __forceinline__ float fast_exp2(float x) { return __builtin_amdgcn_exp2f(x); }
__device__ __forceinline__ float fast_exp(float x) { return __builtin_amdgcn_exp2f(x * LOG2E); }
__device__ __forceinline__ float fast_rcp(float x) { return __builtin_amdgcn_rcpf(x); }
__device__ __forceinline__ float sigmoidf_(float x) { return fast_rcp(1.0f + fast_exp(-x)); }
__device__ __forceinline__ float siluf_(float x) { return x * sigmoidf_(x); }
__device__ __forceinline__ float wave_sum(float v) {
#pragma unroll
    for (int o = 1; o < 64; o <<= 1) v += __shfl_xor(v, o);
    return v;
}
__device__ __forceinline__ void rows_rstd(float (&rs)[2][4], const float* ssqp, int row0, int fq) {
    f32x4 q[2][4];
#pragma unroll
    for (int ai = 0; ai < 2; ++ai)
#pragma unroll
        for (int m = 0; m < 4; ++m) q[ai][m] = *(const f32x4*)(ssqp + (size_t)(row0 + ai * 128 + m * 16) * 16 + fq * 4);
#pragma unroll
    for (int ai = 0; ai < 2; ++ai)
#pragma unroll
        for (int m = 0; m < 4; ++m) { float s = (q[ai][m].x + q[ai][m].y) + (q[ai][m].z + q[ai][m].w); s += __shfl_xor(s, 16); s += __shfl_xor(s, 32); rs[ai][m] = __builtin_amdgcn_rsqf(s * (1.0f / D) + EPS); }
}
__device__ __forceinline__ float row_rstd(const float* ssqp, int row) {
    const f32x4* p = (const f32x4*)(ssqp + (size_t)row * 16);
    const f32x4 a = p[0], b = p[1], c = p[2], d = p[3];
    const float s = ((a.x + a.y) + (a.z + a.w)) + ((b.x + b.y) + (b.z + b.w)) + ((c.x + c.y) + (c.z + c.w)) + ((d.x + d.y) + (d.z + d.w));
    return __builtin_amdgcn_rsqf(s * (1.0f / D) + EPS);
}

namespace pg8 {
#define PG8_LAS __attribute__((address_space(3)))
typedef unsigned short bf16_t;
typedef unsigned u32x4 __attribute__((ext_vector_type(4)));
constexpr int BM = 256, BK = 64, HALF = 128, HTB = HALF * BK * 2, STAGE_BYTES = 8 * HTB, NXCD = 8, WGM = 8;
__host__ __device__ __forceinline__ int lds_byte(int r, int c) { const int st = (r >> 4) * 2 + (c >> 5), rr = r & 15, cc = c & 31, ob = rr * 64 + cc * 2; return st * 1024 + (ob ^ (((ob >> 9) & 1) << 5)); }
__host__ __device__ __forceinline__ void stage_rc(int b, int& R, int& C) { const int st = b / 1024, sb = b % 1024, swz = sb ^ (((sb >> 9) & 1) << 5); R = (st >> 1) * 16 + swz / 64; C = (st & 1) * 32 + (swz % 64) / 2; }
__host__ __device__ __forceinline__ int perm32(int rho) { const int n = rho >> 4, i = rho & 15; return 8 * (i >> 2) + 4 * n + (i & 3); }

struct Unit { int pm, pn, sub; };
struct Gemm { const bf16_t* A0; const bf16_t* A1; const bf16_t* Bt; int lda, ldb, K, nsub; };

struct StaticOrder {
    int nM, nN, nwg, G, c, nsub;
    __device__ void init(int nM_, int nN_, int nsub_, int G_, int c_) { nM = nM_; nN = nN_; nwg = nM * nN; G = G_; c = c_; nsub = nsub_; }
    __device__ bool next(int i, Unit& u) const {
        const int ti = i / nsub; u.sub = i - ti * nsub;
        const long L = (long)ti * G + c; if (L >= nwg) return false;
        int wgid = (int)L; { const int q = nwg / NXCD, r = nwg % NXCD, xcd = wgid % NXCD, off = wgid / NXCD; wgid = (xcd < r ? xcd * (q + 1) : r * (q + 1) + (xcd - r) * q) + off; }
        const int nig = WGM * nN, gid = wgid / nig, fm = gid * WGM, gsz = (nM - fm) < WGM ? (nM - fm) : WGM;
        u.pm = fm + ((wgid % nig) % gsz); u.pn = (wgid % nig) / gsz; return true;
    }
};

typedef f32x4 Acc[2][2][4][2];

struct EpiSwiglu {
    static constexpr bool PERM = true, FUSED = false;
    bf16_t* O; const float* ssqp;
    __device__ __forceinline__ bool keep(const Unit&) const { return false; }
    __device__ __forceinline__ void operator()(Acc& acc, const Unit& u, int wr, int wc, int fr, int fq) const {
        const int row0 = u.pm * BM + wr * 64 + fr, col0 = u.pn * HALF + wc * 32 + 8 * fq;
        float rsa[2][4]; rows_rstd(rsa, ssqp, row0, fq);
#pragma unroll
        for (int ai = 0; ai < 2; ++ai)
#pragma unroll
            for (int m = 0; m < 4; ++m) {
                const int row = row0 + ai * HALF + m * 16; const float rs = rsa[ai][m];
                float o[8];
#pragma unroll
                for (int n = 0; n < 2; ++n)
#pragma unroll
                    for (int j = 0; j < 4; ++j) { const float g = acc[ai][0][m][n][j] * rs, up = acc[ai][1][m][n][j] * rs; o[n * 4 + j] = siluf_(g) * up; }
                u32x4 w; w.x = pk2(o[0], o[1]); w.y = pk2(o[2], o[3]); w.z = pk2(o[4], o[5]); w.w = pk2(o[6], o[7]);
                *(u32x4*)(O + (size_t)row * FF + col0) = w;
            }
    }
};
template <bool RES_BF16> struct EpiResid {
    static constexpr bool PERM = true, FUSED = false;
    const float* res_f32; bf16_t* XBo; float* ssqp; float alpha;
    __device__ __forceinline__ bool keep(const Unit&) const { return false; }
    __device__ __forceinline__ void operator()(Acc& acc, const Unit& u, int wr, int wc, int fr, int fq) const {
        const int col0 = u.pn * BM + wc * 32 + 8 * fq;
        const char* rbase = (const char*)XBo + (size_t)u.pm * BM * D * 2; const unsigned loff = (unsigned)((wr * 64 + fr) * D + col0) * 2u;
        u32x4 rb[2][4][2];
        if (RES_BF16) {
#pragma unroll
            for (int ai = 0; ai < 2; ++ai)
#pragma unroll
                for (int m = 0; m < 4; ++m)
#pragma unroll
                    for (int bj = 0; bj < 2; ++bj) rb[ai][m][bj] = *(const u32x4*)(rbase + (size_t)((ai * HALF + m * 16) * D + bj * HALF) * 2 + loff);
        }
#pragma unroll
        for (int ai = 0; ai < 2; ++ai)
#pragma unroll
            for (int m = 0; m < 4; ++m) {
                const int row = u.pm * BM + ai * HALF + wr * 64 + m * 16 + fr;
                float ss = 0.f;
#pragma unroll
                for (int bj = 0; bj < 2; ++bj) {
                    const size_t off = (size_t)row * D + col0 + bj * HALF;
                    f32x4 r0, r1;
                    if (RES_BF16) { const u32x4 q = rb[ai][m][bj]; r0 = (f32x4){bflo(q.x), bfhi(q.x), bflo(q.y), bfhi(q.y)}; r1 = (f32x4){bflo(q.z), bfhi(q.z), bflo(q.w), bfhi(q.w)}; }
                    else { r0 = *(const f32x4*)(res_f32 + off); r1 = *(const f32x4*)(res_f32 + off + 4); }
                    const f32x4 v0 = r0 + acc[ai][bj][m][0] * alpha, v1 = r1 + acc[ai][bj][m][1] * alpha;
                    u32x4 w; w.x = pk2(v0[0], v0[1]); w.y = pk2(v0[2], v0[3]); w.z = pk2(v1[0], v1[1]); w.w = pk2(v1[2], v1[3]);
                    *(u32x4*)((char*)rbase + (size_t)((ai * HALF + m * 16) * D + bj * HALF) * 2 + loff) = w;
                    ss += (v0[0] * v0[0] + v0[1] * v0[1]) + (v0[2] * v0[2] + v0[3] * v0[3]) + (v1[0] * v1[0] + v1[1] * v1[1]) + (v1[2] * v1[2] + v1[3] * v1[3]);
                }
                ss += __shfl_xor(ss, 16); ss += __shfl_xor(ss, 32);
                if (ssqp && fq == 0) ssqp[(size_t)row * 16 + u.pn * 4 + wc] = ss;
                if (!RES_BF16 && (m & 1)) asm volatile("" ::: "memory");
            }
    }
};
struct EpiProjA {
    static constexpr bool PERM = true, FUSED = false;
    bf16_t *QK, *V, *SQ, *GR, *SKVb; float* GLR; float* out; const float* ssqp;
    __device__ __forceinline__ bool keep(const Unit&) const { return false; }
    __device__ __forceinline__ void operator()(Acc& acc, const Unit& u, int wr, int wc, int fr, int fq) const {
        const int pn = u.pn;
        bf16_t* dst; int ld = D, cbase; float scale = 1.f; int mode = 0;
        if (pn < 4) { dst = QK; cbase = pn * BM; if (pn < 2) scale = 0.08838834764831845f; }
        else if (pn < 8) { dst = V; cbase = (pn - 4) * BM; }
        else if (pn < 12) { dst = SQ; cbase = (pn - 8) * BM; scale = 0.125f * LOG2E; }
        else if (pn < 16) { dst = GR; cbase = (pn - 12) * BM; mode = 1; }
        else if (pn == 16) { dst = SKVb; ld = 256; cbase = 0; mode = 2; }
        else { dst = SKVb; cbase = 0; mode = 3; }
        float rsa[2][4]; rows_rstd(rsa, ssqp, u.pm * BM + wr * 64 + fr, fq);
#pragma unroll
        for (int ai = 0; ai < 2; ++ai)
#pragma unroll
            for (int m = 0; m < 4; ++m) {
                const int row = u.pm * BM + ai * HALF + wr * 64 + m * 16 + fr; const float rs = rsa[ai][m] * scale;
#pragma unroll
                for (int bj = 0; bj < 2; ++bj) {
                    const int within = bj * HALF + wc * 32 + 8 * fq;
                    f32x4 v0 = acc[ai][bj][m][0] * rs, v1 = acc[ai][bj][m][1] * rs;
                    if (mode == 3) { if (within < GRANK) { *(f32x4*)(GLR + (size_t)row * 16 + within) = v0; *(f32x4*)(GLR + (size_t)row * 16 + within + 4) = v1; } continue; }
                    if (mode == 1) {
#pragma unroll
                        for (int j = 0; j < 4; ++j) { v0[j] = siluf_(v0[j]); v1[j] = siluf_(v1[j]); }
                    }
                    u32x4 w; w.x = pk2(v0[0], v0[1]); w.y = pk2(v0[2], v0[3]); w.z = pk2(v1[0], v1[1]); w.w = pk2(v1[2], v1[3]);
                    *(u32x4*)(dst + (size_t)row * ld + cbase + within) = w;
                    if (mode == 2) {
                        float* cp = nullptr;
                        if (u.pm >= MP / BM) { const int rs_ = row - MP, bs = rs_ >> 5, t = rs_ & 31; cp = out + (bj == 0 ? O_CKS : O_CVS) + ((size_t)(bs * WINDOW + 96 + t)) * 128 + (within & 127); }
                        else if ((u.pm & 15) == 15 && ai == 1) { const int b = row >> 12, t = row & 4095; cp = out + (bj == 0 ? O_CKP : O_CVP) + ((size_t)(b * WINDOW + (t - (SEQ - WINDOW)))) * 128 + (within & 127); }
                        if (cp) { *(f32x4*)cp = v0; *(f32x4*)(cp + 4) = v1; }
                    }
                }
            }
    }
};
struct EpiProjB {
    static constexpr bool PERM = true, FUSED = false;
    bf16_t *R, *SS; const float* ssqp;
    __device__ __forceinline__ bool keep(const Unit&) const { return false; }
    __device__ __forceinline__ void operator()(Acc& acc, const Unit& u, int wr, int wc, int fr, int fq) const {
        const int row0 = u.pm * BM + wr * 64 + fr, col0 = u.pn * HALF + wc * 32 + 8 * fq;
        float rsa[2][4]; rows_rstd(rsa, ssqp, row0, fq);
#pragma unroll
        for (int ai = 0; ai < 2; ++ai)
#pragma unroll
            for (int m = 0; m < 4; ++m) {
                const int row = row0 + ai * HALF + m * 16; const float rs = rsa[ai][m];
                float r[8], ss[8];
#pragma unroll
                for (int n = 0; n < 2; ++n)
#pragma unroll
                    for (int j = 0; j < 4; ++j) { const float eg = fast_exp(-acc[ai][0][m][n][j] * rs), es = fast_exp(-acc[ai][1][m][n][j] * rs);
                        ss[n * 4 + j] = fast_rcp(1.0f + es); r[n * 4 + j] = (1.0f + es) * fast_rcp(1.0f + eg); }
                u32x4 w; w.x = pk2(r[0], r[1]); w.y = pk2(r[2], r[3]); w.z = pk2(r[4], r[5]); w.w = pk2(r[6], r[7]);
                *(u32x4*)(R + (size_t)row * D + col0) = w;
                w.x = pk2(ss[0], ss[1]); w.y = pk2(ss[2], ss[3]); w.z = pk2(ss[4], ss[5]); w.w = pk2(ss[6], ss[7]);
                *(u32x4*)(SS + (size_t)row * D + col0) = w;
            }
    }
};
struct EpiBranch {
    static constexpr bool PERM = true, FUSED = false;
    const bf16_t *R, *SS; bf16_t* O;
    __device__ __forceinline__ bool keep(const Unit& u) const { return u.sub == 0; }
    __device__ __forceinline__ void operator()(Acc& acc, const Unit& u, int wr, int wc, int fr, int fq) const {
        const int col0 = u.pn * BM + wc * 32 + 8 * fq;
        const bf16_t* G = u.sub == 0 ? R : SS;
        const size_t tbase = (size_t)u.pm * BM * D * 2; const unsigned loff = (unsigned)((wr * 64 + fr) * D + col0) * 2u;
        const char* gbase = (const char*)G + tbase; char* obase = (char*)O + tbase;
        u32x4 gq[2][4][2];
#pragma unroll
        for (int ai = 0; ai < 2; ++ai)
#pragma unroll
            for (int m = 0; m < 4; ++m)
#pragma unroll
                for (int bj = 0; bj < 2; ++bj) gq[ai][m][bj] = *(const u32x4*)(gbase + (size_t)((ai * HALF + m * 16) * D + bj * HALF) * 2 + loff);
#pragma unroll
        for (int ai = 0; ai < 2; ++ai)
#pragma unroll
            for (int m = 0; m < 4; ++m) {
#pragma unroll
                for (int bj = 0; bj < 2; ++bj) {
                    const u32x4 s = gq[ai][m][bj];
                    const float gv[8] = {bflo(s.x), bfhi(s.x), bflo(s.y), bfhi(s.y), bflo(s.z), bfhi(s.z), bflo(s.w), bfhi(s.w)};
                    if (u.sub == 0) {
#pragma unroll
                        for (int j = 0; j < 4; ++j) { acc[ai][bj][m][0][j] *= gv[j]; acc[ai][bj][m][1][j] *= gv[4 + j]; }
                    } else {
                        float o[8];
#pragma unroll
                        for (int j = 0; j < 4; ++j) { o[j] = acc[ai][bj][m][0][j] * gv[j]; o[4 + j] = acc[ai][bj][m][1][j] * gv[4 + j]; }
                        u32x4 w; w.x = pk2(o[0], o[1]); w.y = pk2(o[2], o[3]); w.z = pk2(o[4], o[5]); w.w = pk2(o[6], o[7]);
                        *(u32x4*)(obase + (size_t)((ai * HALF + m * 16) * D + bj * HALF) * 2 + loff) = w;
                    }
                }
            }
    }
};
constexpr int EX_OFF = 131072;
struct EpiFinal {
    static constexpr bool PERM = true, FUSED = true;
    const bf16_t* XBr; float* Y; const float* gfin; unsigned* xslot; unsigned* cnt; float alpha;
    __device__ __forceinline__ bool keep(const Unit&) const { return false; }
    __device__ __forceinline__ void fused(Acc& acc, const Unit& u, int wr, int wc, int fr, int fq, PG8_LAS unsigned char* lds, int wid, int lane) const {
        PG8_LAS float* P = (PG8_LAS float*)(lds + EX_OFF); PG8_LAS float* Sx = (PG8_LAS float*)(lds + EX_OFF + 4096);
        const int col0 = u.pn * BM + wc * 32 + 8 * fq;
        const char* rbase = (const char*)XBr + (size_t)u.pm * BM * D * 2; const unsigned loff = (unsigned)((wr * 64 + fr) * D + col0) * 2u;
        u32x4 rq[2][4][2];
#pragma unroll
        for (int ai = 0; ai < 2; ++ai)
#pragma unroll
            for (int m = 0; m < 4; ++m)
#pragma unroll
                for (int bj = 0; bj < 2; ++bj) rq[ai][m][bj] = *(const u32x4*)(rbase + (size_t)((ai * HALF + m * 16) * D + bj * HALF) * 2 + loff);
#pragma unroll
        for (int ai = 0; ai < 2; ++ai)
#pragma unroll
            for (int m = 0; m < 4; ++m) {
                const int lr = ai * HALF + wr * 64 + m * 16 + fr;
                float ss = 0.f;
#pragma unroll
                for (int bj = 0; bj < 2; ++bj) {
                    const u32x4 rb = rq[ai][m][bj];
                    const f32x4 r0 = {bflo(rb.x), bfhi(rb.x), bflo(rb.y), bfhi(rb.y)}, r1 = {bflo(rb.z), bfhi(rb.z), bflo(rb.w), bfhi(rb.w)};
                    const f32x4 v0 = r0 + acc[ai][bj][m][0] * alpha, v1 = r1 + acc[ai][bj][m][1] * alpha;
                    acc[ai][bj][m][0] = v0; acc[ai][bj][m][1] = v1;
                    ss += (v0[0] * v0[0] + v0[1] * v0[1]) + (v0[2] * v0[2] + v0[3] * v0[3]) + (v1[0] * v1[0] + v1[1] * v1[1]) + (v1[2] * v1[2] + v1[3] * v1[3]);
                }
                ss += __shfl_xor(ss, 16); ss += __shfl_xor(ss, 32);
                if (fq == 0) P[lr * 4 + wc] = ss;
            }
        asm volatile("s_waitcnt lgkmcnt(0)" ::: "memory"); __builtin_amdgcn_s_barrier(); asm volatile("" ::: "memory");
        const int row = wid * 32 + (lane & 31);
        if (lane < 32) {
            const float s4 = (P[row * 4 + 0] + P[row * 4 + 1]) + (P[row * 4 + 2] + P[row * 4 + 3]);
            __hip_atomic_store(xslot + ((size_t)(u.pm * BM + row) * 4 + u.pn), __float_as_uint(s4), __ATOMIC_RELAXED, __HIP_MEMORY_SCOPE_AGENT);
        }
        asm volatile("s_waitcnt vmcnt(0)" ::: "memory");
        if (lane == 0) __hip_atomic_fetch_add(cnt + CW_PAN_STRIDE * u.pm, 1u, __ATOMIC_RELAXED, __HIP_MEMORY_SCOPE_AGENT);
        if (wid == 0) {
            unsigned spins = 0;
            while ((unsigned)__builtin_amdgcn_readfirstlane((int)__hip_atomic_load(cnt + CW_PAN_STRIDE * u.pm, __ATOMIC_RELAXED, __HIP_MEMORY_SCOPE_AGENT)) < 32u) { __builtin_amdgcn_s_sleep(2); if (++spins > (1u << 24)) break; }
            __builtin_amdgcn_fence(__ATOMIC_ACQUIRE, "agent");
        }
        asm volatile("s_waitcnt vmcnt(0) lgkmcnt(0)" ::: "memory"); __builtin_amdgcn_s_barrier(); asm volatile("" ::: "memory");
        if (lane < 32) {
            const unsigned* sl = xslot + (size_t)(u.pm * BM + row) * 4; float t = 0.f;
#pragma unroll
            for (int q = 0; q < 4; ++q) t += __uint_as_float(__hip_atomic_load(sl + q, __ATOMIC_RELAXED, __HIP_MEMORY_SCOPE_AGENT));
            Sx[row] = __builtin_amdgcn_rsqf(t * (1.0f / D) + EPS);
        }
        asm volatile("s_waitcnt lgkmcnt(0)" ::: "memory"); __builtin_amdgcn_s_barrier(); asm volatile("" ::: "memory");
        f32x4 gv[2][2];
#pragma unroll
        for (int bj = 0; bj < 2; ++bj) { gv[bj][0] = *(const f32x4*)(gfin + col0 + bj * HALF); gv[bj][1] = *(const f32x4*)(gfin + col0 + bj * HALF + 4); }
#pragma unroll
        for (int ai = 0; ai < 2; ++ai)
#pragma unroll
            for (int m = 0; m < 4; ++m) {
                const int lr = ai * HALF + wr * 64 + m * 16 + fr; const size_t grow = (size_t)(u.pm * BM + lr) * D; const float rs = Sx[lr];
#pragma unroll
                for (int bj = 0; bj < 2; ++bj) {
                    *(f32x4*)(Y + grow + col0 + bj * HALF) = acc[ai][bj][m][0] * rs * gv[bj][0];
                    *(f32x4*)(Y + grow + col0 + bj * HALF + 4) = acc[ai][bj][m][1] * rs * gv[bj][1];
                }
            }
    }
};

template <class Epi, bool ALIGN_EPI>
__device__ __forceinline__ void gemm_phase(PG8_LAS unsigned char* lds, const Gemm g, const StaticOrder& S, const Epi& E) {
    const int tid = threadIdx.x, wid = __builtin_amdgcn_readfirstlane(tid >> 6), lane = tid & 63, wr = wid >> 2, wc = wid & 3, fr = lane & 15, fq = lane >> 4;
    const int K = g.K, nt = K / BK;
    unsigned voffA[2], voffB[2];
#pragma unroll
    for (int i = 0; i < 2; ++i) { int R, C; stage_rc(tid * 16 + i * 8192, R, C); const int Rb = Epi::PERM ? ((R & ~31) + perm32(R & 31)) : R;
        voffA[i] = (unsigned)(R * g.lda + C) * 2u; voffB[i] = (unsigned)(Rb * g.ldb + C) * 2u; }
    const size_t kstep = (size_t)(BK * 2);
    const size_t hstepA = (size_t)HALF * g.lda * 2, hstepB = (size_t)HALF * g.ldb * 2;
    const size_t tstepA = 2 * hstepA, tstepB = 2 * hstepB;
    const unsigned ldsw = (unsigned)wid * 1024u;
    const int aoff = lds_byte(wr * 64 + fr, fq * 8), boff = lds_byte(wc * 32 + fr, fq * 8);
#define PG8_SA(b, h) (((b) * 2 + (h)) * HTB)
#define PG8_SB(b, h) ((4 + (b) * 2 + (h)) * HTB)
#define PG8_STAGE(bufoff, gbase, voff) do { _Pragma("unroll") for (int _i = 0; _i < 2; ++_i) \
        __builtin_amdgcn_global_load_lds((const unsigned*)((const char*)(gbase) + (voff)[_i]), (PG8_LAS unsigned*)(lds + (bufoff) + ldsw + _i * 8192), 16, 0, 0); } while (0)
#define PG8_LDA(dst, b, h) do { _Pragma("unroll") for (int m = 0; m < 4; ++m) _Pragma("unroll") for (int k = 0; k < 2; ++k) dst[m][k] = *(const PG8_LAS bf16x8*)(lds + PG8_SA(b, h) + aoff + m * 2048 + k * 1024); } while (0)
#define PG8_LDB(dst, b, h) do { _Pragma("unroll") for (int n = 0; n < 2; ++n) _Pragma("unroll") for (int k = 0; k < 2; ++k) dst[n][k] = *(const PG8_LAS bf16x8*)(lds + PG8_SB(b, h) + boff + n * 2048 + k * 1024); } while (0)
#define PG8_MMA(ai, bj, At, Bt) do { __builtin_amdgcn_s_setprio(1); _Pragma("unroll") for (int m = 0; m < 4; ++m) _Pragma("unroll") for (int n = 0; n < 2; ++n) _Pragma("unroll") for (int k = 0; k < 2; ++k) \
        acc[ai][bj][m][n] = __builtin_amdgcn_mfma_f32_16x16x32_bf16(Bt[n][k], At[m][k], acc[ai][bj][m][n], 0, 0, 0); __builtin_amdgcn_s_setprio(0); } while (0)
#define PG8_WAIT_V(n) asm volatile("s_waitcnt vmcnt(" #n ")" ::: "memory")
#define PG8_WAIT_L(n) asm volatile("s_waitcnt lgkmcnt(" #n ")" ::: "memory")
#define PG8_BAR __builtin_amdgcn_s_barrier()
#define PG8_SCHED __builtin_amdgcn_sched_barrier(0)
#define PG8_ABASE(u) ((const char*)((u).sub ? g.A1 : g.A0) + (size_t)(u).pm * tstepA)
#define PG8_BBASE(u) ((const char*)g.Bt + (size_t)(u).pn * tstepB + (size_t)(u).sub * K * 2)
    Unit cur, nxt; int ui = 0;
    if (!S.next(0, cur)) return;
    Acc acc;
#pragma unroll
    for (int a = 0; a < 2; ++a)
#pragma unroll
        for (int b = 0; b < 2; ++b)
#pragma unroll
            for (int m = 0; m < 4; ++m)
#pragma unroll
                for (int n = 0; n < 2; ++n) acc[a][b][m][n] = (f32x4){0.f, 0.f, 0.f, 0.f};
    bf16x8 At[4][2], B0[2][2], B1[2][2];
    const char* cA = PG8_ABASE(cur); const char* cB = PG8_BBASE(cur);
    PG8_STAGE(PG8_SB(0, 0), cB, voffB); PG8_STAGE(PG8_SB(0, 1), cB + hstepB, voffB); PG8_STAGE(PG8_SA(0, 0), cA, voffA); PG8_STAGE(PG8_SA(0, 1), cA + hstepA, voffA);
    if (wr == 1) PG8_BAR;
    PG8_WAIT_V(2); PG8_BAR;
    PG8_STAGE(PG8_SB(1, 0), cB + kstep, voffB); PG8_STAGE(PG8_SA(1, 0), cA + kstep, voffA); PG8_STAGE(PG8_SB(1, 1), cB + hstepB + kstep, voffB);
    PG8_WAIT_V(6); PG8_BAR;
    for (;;) {
        const bool has_next = S.next(ui + 1, nxt);
        const char* nA = has_next ? PG8_ABASE(nxt) : cA; const char* nB = has_next ? PG8_BBASE(nxt) : cB;
        for (int t = 0; t < nt; t += 2) {
            const bool last = (t == nt - 2);
            const char* a1 = cA + (size_t)(t + 1) * kstep;
            const char* a2 = last ? nA : cA + (size_t)(t + 2) * kstep; const char* b2 = last ? nB : cB + (size_t)(t + 2) * kstep;
            const char* a3 = a2 + kstep; const char* b3 = b2 + kstep;
            PG8_LDB(B0, 0, 0); PG8_LDB(B1, 0, 1); PG8_SCHED; PG8_LDA(At, 0, 0); PG8_STAGE(PG8_SA(1, 1), a1 + hstepA, voffA);
            PG8_WAIT_V(8); PG8_WAIT_L(0); PG8_BAR; PG8_MMA(0, 0, At, B0); PG8_MMA(0, 1, At, B1); PG8_BAR; PG8_SCHED;
            PG8_LDA(At, 0, 1); PG8_STAGE(PG8_SB(0, 0), b2, voffB); PG8_STAGE(PG8_SB(0, 1), b2 + hstepB, voffB); PG8_STAGE(PG8_SA(0, 0), a2, voffA);
            PG8_WAIT_V(8); PG8_WAIT_L(0); PG8_BAR; PG8_MMA(1, 0, At, B0); PG8_MMA(1, 1, At, B1); PG8_BAR; PG8_SCHED;
            PG8_LDB(B0, 1, 0); PG8_LDB(B1, 1, 1); PG8_SCHED; PG8_LDA(At, 1, 0); PG8_STAGE(PG8_SA(0, 1), a2 + hstepA, voffA);
            PG8_WAIT_V(8); PG8_WAIT_L(0); PG8_BAR; PG8_MMA(0, 0, At, B0); PG8_MMA(0, 1, At, B1); PG8_BAR; PG8_SCHED;
            PG8_LDA(At, 1, 1); PG8_STAGE(PG8_SB(1, 0), b3, voffB); PG8_STAGE(PG8_SB(1, 1), b3 + hstepB, voffB); PG8_STAGE(PG8_SA(1, 0), a3, voffA);
            PG8_WAIT_V(8); PG8_WAIT_L(0); PG8_BAR; PG8_MMA(1, 0, At, B0); PG8_MMA(1, 1, At, B1); PG8_BAR; PG8_SCHED;
        }
        if constexpr (ALIGN_EPI) { if (wr == 0) PG8_BAR; }
        if constexpr (Epi::FUSED) E.fused(acc, cur, wr, wc, fr, fq, lds, wid, lane); else E(acc, cur, wr, wc, fr, fq);
        if (!has_next) break;
        if (!E.keep(cur)) {
#pragma unroll
            for (int a = 0; a < 2; ++a)
#pragma unroll
                for (int b = 0; b < 2; ++b)
#pragma unroll
                    for (int m = 0; m < 4; ++m)
#pragma unroll
                        for (int n = 0; n < 2; ++n) acc[a][b][m][n] = (f32x4){0.f, 0.f, 0.f, 0.f};
        }
        cur = nxt; cA = nA; cB = nB; ++ui;
        if constexpr (ALIGN_EPI) { if (wr == 1) PG8_BAR; }
    }
    PG8_WAIT_V(0);
    if constexpr (!ALIGN_EPI) { if (wr == 0) PG8_BAR; }
    PG8_BAR;
#undef PG8_SA
#undef PG8_SB
#undef PG8_STAGE
#undef PG8_LDA
#undef PG8_LDB
#undef PG8_MMA
#undef PG8_WAIT_V
#undef PG8_WAIT_L
#undef PG8_BAR
#undef PG8_SCHED
#undef PG8_ABASE
#undef PG8_BBASE
}
}


#define XB_TMO      128
#define XB_XCNT(j)  (256  + 64 * (j))
#define XB_XSUB(j)  (1280 + 64 * (j))
#define XB_XGEN(j)  (2304 + 64 * (j))
#define XB_TOP      3328
#define XB_TOPGEN   3392
#define XCD_BAR_WORDS 3456
#define XB_SPIN_CAP (1u << 22)
__device__ __forceinline__ unsigned xb_ld(unsigned* p)              { return __hip_atomic_load(p, __ATOMIC_RELAXED, __HIP_MEMORY_SCOPE_AGENT); }
__device__ __forceinline__ unsigned xb_add(unsigned* p, unsigned v) { return __hip_atomic_fetch_add(p, v, __ATOMIC_RELAXED, __HIP_MEMORY_SCOPE_AGENT); }
__device__ __forceinline__ unsigned xb_xcc_id() { return (unsigned)__builtin_amdgcn_s_getreg((3 << 11) | 20) & 0xFu; }
#define XB_SPIN(cond, bar) do { unsigned _sp = 0; while (cond) { __builtin_amdgcn_s_sleep(1); \
    if ((++_sp & 255u) == 0u) { if (xb_ld(&(bar)[XB_TMO])) break; if (_sp > XB_SPIN_CAP) { atomicAdd(&(bar)[XB_TMO], 1u); break; } } } } while (0)
struct XcdBarrier { unsigned* bar; unsigned x; volatile LAS unsigned* st; };
__device__ __forceinline__ XcdBarrier xcd_barrier_post(unsigned* bar, volatile LAS unsigned* st) {
    XcdBarrier b; b.bar = bar; b.x = xb_xcc_id(); b.st = st;
    if (threadIdx.x == 0) (void)xb_add(&bar[XB_XCNT(b.x)], 1u);
    return b;
}
__device__ __forceinline__ void xcd_barrier_complete(unsigned* bar, unsigned x, unsigned& nloc, unsigned& nx) {
    const unsigned G = gridDim.x * gridDim.y * gridDim.z;
    unsigned sum, cnt, mine, sp = 0u;
    for (;;) {
        sum = 0u; cnt = 0u; mine = 0u;
#pragma unroll
        for (unsigned j = 0; j < 16; ++j) { const unsigned c = xb_ld(&bar[XB_XCNT(j)]); sum += c; cnt += (c > 0u) ? 1u : 0u; mine = (j == x) ? c : mine; }
        if (sum == G) break;
        __builtin_amdgcn_s_sleep(1);
        if ((++sp & 255u) == 0u) { if (xb_ld(&bar[XB_TMO])) break; if (sp > XB_SPIN_CAP) { atomicAdd(&bar[XB_TMO], 1u); break; } }
    }
    nloc = mine > 0u ? mine : 1u; nx = cnt > 0u ? cnt : 1u;
}
__device__ __forceinline__ void xcd_barrier(const XcdBarrier& b) {
    asm volatile("s_waitcnt vmcnt(0)" ::: "memory");
    __syncthreads();
    if (threadIdx.x == 0) {
        unsigned* bar = b.bar;
        __builtin_amdgcn_s_waitcnt(0);
        unsigned nloc = b.st[0], nx = b.st[1];
        if (nloc == 0u) { xcd_barrier_complete(bar, b.x, nloc, nx); b.st[0] = nloc; b.st[1] = nx; }
        const unsigned old = xb_add(&bar[XB_XSUB(b.x)], 1u);
        const unsigned gen = old / nloc;
        if (old + 1u == (gen + 1u) * nloc) {
            __builtin_amdgcn_fence(__ATOMIC_RELEASE, "agent");
            asm volatile("s_waitcnt vmcnt(0)" ::: "memory");
            const unsigned og = xb_add(&bar[XB_TOP], 1u);
            const unsigned target = (og / nx + 1u) * nx;
            if (og + 1u != target) XB_SPIN(xb_ld(&bar[XB_TOP]) < target, bar);
            xb_add(&bar[XB_XGEN(b.x)], 1u);
            __builtin_amdgcn_fence(__ATOMIC_ACQUIRE, "agent");
            asm volatile("s_waitcnt vmcnt(0)" ::: "memory");
        } else {
            XB_SPIN(xb_ld(&bar[XB_XGEN(b.x)]) == gen, bar);
            __builtin_amdgcn_fence(__ATOMIC_ACQUIRE, "agent");
            asm volatile("s_waitcnt vmcnt(0)" ::: "memory");
        }
    }
    __syncthreads();
}

struct Args { const float* in[21]; float* out; unsigned char* ws; int ph_lo, ph_hi; };
struct Frame {
    LAS unsigned char* lds;
    int tid, lane, wave, vcu, G;
    const float* const* in_unused;
    float* out; unsigned char* ws;
};

__device__ __forceinline__ void p0_item(const float* W, int N, int scol0, int nvalid, const float* gain, int gmask, bf16* WT, int ldk, int koff, int drow0, int k0, LAS float* scr, int lane) {
    const bool al16 = ((scol0 & 3) == 0) && ((N & 3) == 0) && nvalid == 32;
    if (al16) {
        f32x4 v[8];
#pragma unroll
        for (int i = 0; i < 8; ++i) { const int p_ = lane + 64 * i; v[i] = *(const f32x4*)(W + (size_t)(k0 + (p_ >> 3)) * N + scol0 + (p_ & 7) * 4); }
#pragma unroll
        for (int i = 0; i < 8; ++i) { const int p_ = lane + 64 * i, kk = p_ >> 3, c = (p_ & 7) * 4; const float g = gain ? gain[(k0 + kk) & gmask] : 1.0f;
            scr[kk * 33 + c] = v[i][0] * g; scr[kk * 33 + c + 1] = v[i][1] * g; scr[kk * 33 + c + 2] = v[i][2] * g; scr[kk * 33 + c + 3] = v[i][3] * g; }
    } else {
        float v[32];
#pragma unroll
        for (int i = 0; i < 32; ++i) { const int kk = 2 * i + (lane >> 5), c = lane & 31; v[i] = 0.f; if (c < nvalid) v[i] = W[(size_t)(k0 + kk) * N + scol0 + c]; }
#pragma unroll
        for (int i = 0; i < 32; ++i) { const int kk = 2 * i + (lane >> 5), c = lane & 31; scr[kk * 33 + c] = (gain && c < nvalid) ? v[i] * gain[(k0 + kk) & gmask] : v[i]; }
    }
    LDS_WAIT(); asm volatile("" ::: "memory");
    const int c8 = lane & 7;
#pragma unroll
    for (int j = 0; j < 4; ++j) { const int n = (lane >> 3) + 8 * j; const LAS float* s = scr + (8 * c8) * 33 + n;
        v4u o; o.x = pk2(s[0 * 33], s[1 * 33]); o.y = pk2(s[2 * 33], s[3 * 33]); o.z = pk2(s[4 * 33], s[5 * 33]); o.w = pk2(s[6 * 33], s[7 * 33]);
        *(v4u*)(WT + (size_t)(drow0 + n) * ldk + koff + k0 + 8 * c8) = o; }
    LDS_WAIT(); asm volatile("" ::: "memory");
}
__device__ __forceinline__ int map_ffn_in(int blk) { const int tile = blk >> 3, w = blk & 7; return w < 4 ? tile * 128 + w * 32 : FF + tile * 128 + (w - 4) * 32; }
__device__ __forceinline__ int map_proj_a(int blk, int& nvalid) {
    nvalid = 32;
    if (blk < 16) return S_GQ + 32 * blk;
    if (blk < 32) return S_GK + 32 * (blk - 16);
    if (blk < 64) return S_GV + 32 * (blk - 32);
    if (blk < 96) return S_SQ + 32 * (blk - 64);
    if (blk < 128) return S_GR + 32 * (blk - 96);
    if (blk < 132) return S_SK + 32 * (blk - 128);
    if (blk < 136) return S_SV + 32 * (blk - 132);
    if (blk == 136) { nvalid = GRANK; return S_GLR; }
    nvalid = 0; return 0;
}
__device__ __forceinline__ int map_proj_b(int blk) { const int tile = blk >> 3, w = blk & 7; return w < 4 ? S_GG + tile * 128 + w * 32 : S_GS + tile * 128 + (w - 4) * 32; }


constexpr int P0_I1 = (D / 64) * 176, P0_I1O = (FF / 64) * 32, P0_IA = (D / 64) * 144, P0_IB = (D / 64) * 64, P0_IBR = (D / 64) * 32, P0_IO = (D / 64) * 32;
constexpr int P0_NEARLY = P0_I1 + P0_I1O + P0_IA, P0_NLATE = P0_I1 + P0_I1O + P0_IB + 2 * P0_IBR + P0_IO;
__device__ __forceinline__ void p0_weight_item(const Args& a, int idx, LAS float* scr, int lane) {
    unsigned char* ws = a.ws;
    int r;
    if (idx < P0_NEARLY) {
        r = idx;
        if (r < P0_I1) { const int kb = r / 176, blk = r % 176; p0_item(a.in[6], 2 * FF, map_ffn_in(blk), 32, a.in[5], 1023, (bf16*)(ws + WS_W1T), D, 0, blk * 32, kb * 64, scr, lane); return; }
        r -= P0_I1;
        if (r < P0_I1O) { const int kb = r / 32, blk = r % 32; p0_item(a.in[7], D, blk * 32, 32, nullptr, 0, (bf16*)(ws + WS_W1OT), FF, 0, blk * 32, kb * 64, scr, lane); return; }
        r -= P0_I1O;
        { const int kb = r / 144, blk = r % 144; int nv; const int sc = map_proj_a(blk, nv); p0_item(a.in[9], IN_W, sc, nv, a.in[8], 1023, (bf16*)(ws + WS_WAT), D, 0, blk * 32, kb * 64, scr, lane); return; }
    }
    r = idx - P0_NEARLY;
    if (r < P0_I1) { const int kb = r / 176, blk = r % 176; p0_item(a.in[18], 2 * FF, map_ffn_in(blk), 32, a.in[17], 1023, (bf16*)(ws + WS_W2T), D, 0, blk * 32, kb * 64, scr, lane); return; }
    r -= P0_I1;
    if (r < P0_I1O) { const int kb = r / 32, blk = r % 32; p0_item(a.in[19], D, blk * 32, 32, nullptr, 0, (bf16*)(ws + WS_W2OT), FF, 0, blk * 32, kb * 64, scr, lane); return; }
    r -= P0_I1O;
    if (r < P0_IB) { const int kb = r / 64, blk = r % 64; p0_item(a.in[9], IN_W, map_proj_b(blk), 32, a.in[8], 1023, (bf16*)(ws + WS_WBT), D, 0, blk * 32, kb * 64, scr, lane); return; }
    r -= P0_IB;
    if (r < 2 * P0_IBR) { const int which = r / P0_IBR; r -= which * P0_IBR; const int kb = r / 32, blk = r % 32;
        p0_item(a.in[which ? 15 : 14], D, blk * 32, 32, which ? nullptr : a.in[12], 255, (bf16*)(ws + WS_WBRT), 2 * D, which * D, blk * 32, kb * 64, scr, lane); return; }
    r -= 2 * P0_IBR;
    { const int kb = r / 32, blk = r % 32; p0_item(a.in[16], D, blk * 32, 32, nullptr, 0, (bf16*)(ws + WS_WOUTT), D, 0, blk * 32, kb * 64, scr, lane); }
}
__device__ __forceinline__ void p0_prologue(const Args& a, Frame& F) {
    LAS float* scr = (LAS float*)(F.lds + F.wave * 16384);
    const int gw = F.vcu * NWAVES + F.wave, NGW = F.G * NWAVES;
    unsigned char* ws = a.ws;
    for (int it = gw; it < P0_NEARLY; it += NGW) p0_weight_item(a, it, scr, F.lane);
    bf16* XB = (bf16*)(ws + WS_XB); float* ssq0 = (float*)(ws + WS_SSQ0);
    for (int m0 = gw; m0 < M; m0 += 4 * NGW) {
        f32x4 v[4][4];
#pragma unroll
        for (int r = 0; r < 4; ++r) { const int m = m0 + r * NGW;
            if (m < M) { const f32x4* xr = (const f32x4*)(m < MP ? a.in[0] + (size_t)m * D : a.in[1] + (size_t)(m - MP) * D) + F.lane;
#pragma unroll
                for (int j = 0; j < 4; ++j) v[r][j] = xr[64 * j]; } }
#pragma unroll
        for (int r = 0; r < 4; ++r) { const int m = m0 + r * NGW;
            if (m < M) {
                float s = 0.f;
#pragma unroll
                for (int j = 0; j < 4; ++j) s += (v[r][j].x * v[r][j].x + v[r][j].y * v[r][j].y) + (v[r][j].z * v[r][j].z + v[r][j].w * v[r][j].w);
                s = wave_sum(s);
                unsigned long long* o8 = (unsigned long long*)(XB + (size_t)m * D) + F.lane;
#pragma unroll
                for (int j = 0; j < 4; ++j) o8[64 * j] = (unsigned long long)pk2(v[r][j].x, v[r][j].y) | ((unsigned long long)pk2(v[r][j].z, v[r][j].w) << 32);
                if (m < MP) { if (F.lane < 16) ssq0[(size_t)m * 16 + F.lane] = F.lane == 0 ? s : 0.f; }
                else ((float*)(ws + WS_SSQ0S))[(size_t)(m - MP) * 64 + F.lane] = F.lane == 0 ? s : 0.f;
            } }
    }
    const int gt = gw * 64 + F.lane, NGT = NGW * 64;
    for (int i = gt; i < 2 * NB * 96 * 32; i += NGT) {
        const int which = i / (NB * 96 * 32), r = i % (NB * 96 * 32), b = r / (96 * 32), rr = r % (96 * 32);
        const f32x4 v = *((const f32x4*)(a.in[which ? 4 : 3] + ((size_t)b * WINDOW + 32) * 128) + rr);
        *((f32x4*)(a.out + (which ? O_CVS : O_CKS) + (size_t)b * WINDOW * 128) + rr) = v;
    }
}

constexpr int SWA_KLD_B = 144;
constexpr int SWA_VLD_B = 392;
constexpr int SWA_K_OFF = 0, SWA_V_OFF = 192 * SWA_KLD_B;
__device__ __forceinline__ void swa_unit(const Args& a, Frame& F, int seq, int chunk, int kvh) {
    const int tid = F.tid, lane = F.lane, wave = F.wave, r32 = lane & 31, hi = lane >> 5;
    const bool samp = seq >= NB; const int b = samp ? seq - NB : seq;
    bf16* SQ = (bf16*)(a.ws + WS_T2); const bf16* SKVb = (const bf16*)(a.ws + WS_SKV);
    const int rowq0 = samp ? MP + b * DEC_T : b * SEQ + chunk * 64;
    const int ntb = samp ? 1 : 2, nkb = samp ? 5 : 6, kb0 = samp ? 0 : (chunk >= 2 ? 0 : (2 - chunk) * 2);
    const int nkeys = nkb * 32;
    LAS unsigned char* Kl = F.lds + SWA_K_OFF; LAS unsigned char* Vl = F.lds + SWA_V_OFF;
    __syncthreads();
    for (int it = tid; it < nkeys * 8; it += NWAVES * 64) {
        const int key = it >> 3, c8 = it & 7;
        if (key < kb0 * 32) continue;
        v4u kk, vv;
        if (samp && key < WINDOW) {
            const float* ck = a.in[3] + ((size_t)(b * WINDOW + key) * SKV + kvh) * SHD + c8 * 8; const float* cv = a.in[4] + ((size_t)(b * WINDOW + key) * SKV + kvh) * SHD + c8 * 8;
            const f32x4 k0 = *(const f32x4*)ck, k1 = *(const f32x4*)(ck + 4), v0 = *(const f32x4*)cv, v1 = *(const f32x4*)(cv + 4);
            kk.x = pk2(k0[0], k0[1]); kk.y = pk2(k0[2], k0[3]); kk.z = pk2(k1[0], k1[1]); kk.w = pk2(k1[2], k1[3]);
            vv.x = pk2(v0[0], v0[1]); vv.y = pk2(v0[2], v0[3]); vv.z = pk2(v1[0], v1[1]); vv.w = pk2(v1[2], v1[3]);
        } else {
            const int mrow = samp ? MP + b * DEC_T + (key - WINDOW) : b * SEQ + (chunk - 2) * 64 + key;
            kk = *(const v4u*)(SKVb + (size_t)mrow * 256 + kvh * 64 + c8 * 8); vv = *(const v4u*)(SKVb + (size_t)mrow * 256 + 128 + kvh * 64 + c8 * 8);
        }
        *(LAS v4u*)(Kl + key * SWA_KLD_B + c8 * 16) = kk;
        LAS unsigned short* vt = (LAS unsigned short*)(Vl + (c8 * 8) * SWA_VLD_B + key * 2);
        vt[0 * (SWA_VLD_B / 2)] = (unsigned short)(vv.x & 0xffff); vt[1 * (SWA_VLD_B / 2)] = (unsigned short)(vv.x >> 16);
        vt[2 * (SWA_VLD_B / 2)] = (unsigned short)(vv.y & 0xffff); vt[3 * (SWA_VLD_B / 2)] = (unsigned short)(vv.y >> 16);
        vt[4 * (SWA_VLD_B / 2)] = (unsigned short)(vv.z & 0xffff); vt[5 * (SWA_VLD_B / 2)] = (unsigned short)(vv.z >> 16);
        vt[6 * (SWA_VLD_B / 2)] = (unsigned short)(vv.w & 0xffff); vt[7 * (SWA_VLD_B / 2)] = (unsigned short)(vv.w >> 16);
    }
    __syncthreads();
    const int head = kvh * 8 + wave;
    const float sink2 = a.in[13][head] * LOG2E;
    for (int tb = 0; tb < ntb; ++tb) {
        bf16* qrow = SQ + (size_t)(rowq0 + tb * 32 + r32) * D + head * SHD;
        bf16x8 qf[4];
#pragma unroll
        for (int s = 0; s < 4; ++s) qf[s] = *(const bf16x8*)(qrow + s * 16 + hi * 8);
        f32x16 sacc[6];
#pragma unroll
        for (int kb = 0; kb < 6; ++kb) {
            if (kb >= kb0 && kb < nkb) {
                f32x16 c = {0.f, 0.f, 0.f, 0.f, 0.f, 0.f, 0.f, 0.f, 0.f, 0.f, 0.f, 0.f, 0.f, 0.f, 0.f, 0.f};
#pragma unroll
                for (int s = 0; s < 4; ++s) { const bf16x8 kf = *(const LAS bf16x8*)(Kl + (kb * 32 + r32) * SWA_KLD_B + s * 32 + hi * 16); c = __builtin_amdgcn_mfma_f32_32x32x16_bf16(kf, qf[s], c, 0, 0, 0); }
                sacc[kb] = c;
            }
        }
        float mx = sink2;
#pragma unroll
        for (int kb = 0; kb < 6; ++kb) if (kb >= kb0 && kb < nkb) {
#pragma unroll
            for (int r = 0; r < 16; ++r) mx = fmaxf(mx, sacc[kb][r]); }
        mx = fmaxf(mx, __shfl_xor(mx, 32));
        float l = 0.f;
#pragma unroll
        for (int kb = 0; kb < 6; ++kb) if (kb >= kb0 && kb < nkb) {
#pragma unroll
            for (int r = 0; r < 16; ++r) { const float p = fast_exp2(sacc[kb][r] - mx); sacc[kb][r] = p; l += p; } }
        l += __shfl_xor(l, 32); l += fast_exp2(sink2 - mx);
        f32x16 o[2];
#pragma unroll
        for (int db = 0; db < 2; ++db) o[db] = (f32x16){0.f, 0.f, 0.f, 0.f, 0.f, 0.f, 0.f, 0.f, 0.f, 0.f, 0.f, 0.f, 0.f, 0.f, 0.f, 0.f};
#pragma unroll
        for (int kb = 0; kb < 6; ++kb) if (kb >= kb0 && kb < nkb) {
#pragma unroll
            for (int s2 = 0; s2 < 2; ++s2) {
                v4u pw; pw.x = pk2(sacc[kb][8 * s2 + 0], sacc[kb][8 * s2 + 1]); pw.y = pk2(sacc[kb][8 * s2 + 2], sacc[kb][8 * s2 + 3]);
                pw.z = pk2(sacc[kb][8 * s2 + 4], sacc[kb][8 * s2 + 5]); pw.w = pk2(sacc[kb][8 * s2 + 6], sacc[kb][8 * s2 + 7]);
                const bf16x8 pb = __builtin_bit_cast(bf16x8, pw);
#pragma unroll
                for (int db = 0; db < 2; ++db) {
                    const LAS unsigned char* vp = Vl + (db * 32 + r32) * SWA_VLD_B + (kb * 32 + s2 * 16 + 4 * hi) * 2;
                    const v2u lo = *(const LAS v2u*)vp, hi8 = *(const LAS v2u*)(vp + 16);
                    v4u av; av.x = lo.x; av.y = lo.y; av.z = hi8.x; av.w = hi8.y;
                    o[db] = __builtin_amdgcn_mfma_f32_32x32x16_bf16(__builtin_bit_cast(bf16x8, av), pb, o[db], 0, 0, 0);
                }
            }
        }
        const float inv = fast_rcp(l);
#pragma unroll
        for (int db = 0; db < 2; ++db)
#pragma unroll
            for (int g4 = 0; g4 < 4; ++g4) {
                v2u w; w.x = pk2(o[db][4 * g4 + 0] * inv, o[db][4 * g4 + 1] * inv); w.y = pk2(o[db][4 * g4 + 2] * inv, o[db][4 * g4 + 3] * inv);
                *(v2u*)(qrow + db * 32 + 8 * g4 + 4 * hi) = w;
            }
    }
}

struct SwaRegs { v4u kk[3], vv[3]; };
__device__ __forceinline__ void swa_p_load(SwaRegs& R, const Args& a, int u, int tid) {
    const int b = u >> 7, chunk = (u >> 1) & 63, kvh = u & 1;
    const bf16* SKVb = (const bf16*)(a.ws + WS_SKV);
    const char* base = (const char*)(SKVb + ((size_t)b * SEQ + (size_t)(chunk - 2) * 64) * 256 + kvh * 64);
#pragma unroll
    for (int i = 0; i < 3; ++i) {
        const int it = tid + 512 * i, key = it >> 3, c8 = it & 7;
        R.kk[i] = (v4u){0u, 0u, 0u, 0u}; R.vv[i] = (v4u){0u, 0u, 0u, 0u};
        if (key + (chunk - 2) * 64 >= 0) { R.kk[i] = *(const v4u*)(base + (size_t)key * 512 + c8 * 16); R.vv[i] = *(const v4u*)(base + (size_t)key * 512 + 256 + c8 * 16); }
    }
}
__device__ __forceinline__ void swa_p_compute(SwaRegs& R, const Args& a, Frame& F, int u) {
    const int tid = F.tid, lane = F.lane, wave = F.wave, r32 = lane & 31, hi = lane >> 5;
    const int b = u >> 7, chunk = (u >> 1) & 63, kvh = u & 1;
    bf16* SQ = (bf16*)(a.ws + WS_T2);
    const int rowq0 = b * SEQ + chunk * 64, kb0 = chunk >= 2 ? 0 : (2 - chunk) * 2;
    LAS unsigned char* Kl = F.lds + SWA_K_OFF; LAS unsigned char* Vl = F.lds + SWA_V_OFF;
    const int head = kvh * 8 + wave;
    bf16* qrow0 = SQ + (size_t)(rowq0 + r32) * D + head * SHD;
    bf16x8 qf[2][4];
#pragma unroll
    for (int s = 0; s < 4; ++s) qf[0][s] = *(const bf16x8*)(qrow0 + s * 16 + hi * 8);
    const float sink2 = a.in[13][head] * LOG2E;
    LDS_BAR();
#pragma unroll
    for (int i = 0; i < 3; ++i) {
        const int it = tid + 512 * i, key = it >> 3, c8 = it & 7;
        *(LAS v4u*)(Kl + key * SWA_KLD_B + c8 * 16) = R.kk[i];
        LAS unsigned short* vt = (LAS unsigned short*)(Vl + (c8 * 8) * SWA_VLD_B + key * 2);
        const unsigned w_[4] = {R.vv[i].x, R.vv[i].y, R.vv[i].z, R.vv[i].w};
#pragma unroll
        for (int q = 0; q < 4; ++q) { vt[(2 * q) * (SWA_VLD_B / 2)] = (unsigned short)(w_[q] & 0xffffu); vt[(2 * q + 1) * (SWA_VLD_B / 2)] = (unsigned short)(w_[q] >> 16); }
    }
    LDS_BAR();
#pragma unroll
    for (int tb = 0; tb < 2; ++tb) {
        bf16* qrow = qrow0 + (size_t)tb * 32 * D;
        f32x16 sacc[6];
#pragma unroll
        for (int kb = 0; kb < 6; ++kb) {
            if (kb >= kb0) {
                f32x16 c = {0.f, 0.f, 0.f, 0.f, 0.f, 0.f, 0.f, 0.f, 0.f, 0.f, 0.f, 0.f, 0.f, 0.f, 0.f, 0.f};
                bf16x8 kf[4];
#pragma unroll
                for (int s = 0; s < 4; ++s) kf[s] = *(const LAS bf16x8*)(Kl + (kb * 32 + r32) * SWA_KLD_B + s * 32 + hi * 16);
#pragma unroll
                for (int s = 0; s < 4; ++s) c = __builtin_amdgcn_mfma_f32_32x32x16_bf16(kf[s], qf[tb][s], c, 0, 0, 0);
                sacc[kb] = c;
            }
        }
        if (tb == 0) {
#pragma unroll
            for (int s = 0; s < 4; ++s) qf[1][s] = *(const bf16x8*)(qrow0 + (size_t)32 * D + s * 16 + hi * 8);
        }
        float mx = sink2;
#pragma unroll
        for (int kb = 0; kb < 6; ++kb) if (kb >= kb0) {
#pragma unroll
            for (int r = 0; r < 16; ++r) mx = fmaxf(mx, sacc[kb][r]); }
        mx = fmaxf(mx, __shfl_xor(mx, 32));
        float l = 0.f;
#pragma unroll
        for (int kb = 0; kb < 6; ++kb) if (kb >= kb0) {
#pragma unroll
            for (int r = 0; r < 16; ++r) { const float p = fast_exp2(sacc[kb][r] - mx); sacc[kb][r] = p; l += p; } }
        l += __shfl_xor(l, 32); l += fast_exp2(sink2 - mx);
        f32x16 o[2];
#pragma unroll
        for (int db = 0; db < 2; ++db) o[db] = (f32x16){0.f, 0.f, 0.f, 0.f, 0.f, 0.f, 0.f, 0.f, 0.f, 0.f, 0.f, 0.f, 0.f, 0.f, 0.f, 0.f};
#pragma unroll
        for (int kb = 0; kb < 6; ++kb) if (kb >= kb0) {
            v2u vlo[2][2], vhi[2][2];
#pragma unroll
            for (int s2 = 0; s2 < 2; ++s2)
#pragma unroll
                for (int db = 0; db < 2; ++db) {
                    const LAS unsigned char* vp = Vl + (db * 32 + r32) * SWA_VLD_B + (kb * 32 + s2 * 16 + 4 * hi) * 2;
                    vlo[s2][db] = *(const LAS v2u*)vp; vhi[s2][db] = *(const LAS v2u*)(vp + 16);
                }
            bf16x8 pb[2];
#pragma unroll
            for (int s2 = 0; s2 < 2; ++s2) {
                v4u pw; pw.x = pk2(sacc[kb][8 * s2 + 0], sacc[kb][8 * s2 + 1]); pw.y = pk2(sacc[kb][8 * s2 + 2], sacc[kb][8 * s2 + 3]);
                pw.z = pk2(sacc[kb][8 * s2 + 4], sacc[kb][8 * s2 + 5]); pw.w = pk2(sacc[kb][8 * s2 + 6], sacc[kb][8 * s2 + 7]);
                pb[s2] = __builtin_bit_cast(bf16x8, pw);
            }
            asm volatile("s_waitcnt lgkmcnt(0)" ::: "memory"); __builtin_amdgcn_sched_barrier(0);
#pragma unroll
            for (int s2 = 0; s2 < 2; ++s2)
#pragma unroll
                for (int db = 0; db < 2; ++db) {
                    v4u av; av.x = vlo[s2][db].x; av.y = vlo[s2][db].y; av.z = vhi[s2][db].x; av.w = vhi[s2][db].y;
                    o[db] = __builtin_amdgcn_mfma_f32_32x32x16_bf16(__builtin_bit_cast(bf16x8, av), pb[s2], o[db], 0, 0, 0);
                }
            __builtin_amdgcn_sched_barrier(0);
        }
        const float inv = fast_rcp(l);
#pragma unroll
        for (int db = 0; db < 2; ++db)
#pragma unroll
            for (int g4 = 0; g4 < 4; ++g4) {
                v2u w; w.x = pk2(o[db][4 * g4 + 0] * inv, o[db][4 * g4 + 1] * inv); w.y = pk2(o[db][4 * g4 + 2] * inv, o[db][4 * g4 + 3] * inv);
                *(v2u*)(qrow + db * 32 + 8 * g4 + 4 * hi) = w;
            }
    }
}

constexpr int G1_GLR_OFF = 0, G1_TOT_OFF = 4096, G1_Q_OFF = 6144, G1_LD_B = 272, G1_K_OFF = G1_Q_OFF + 64 * G1_LD_B;
struct G1Regs { v4u qraw[2], kraw[2]; f32x4 gl; };
__device__ __forceinline__ void g1_load(G1Regs& R, const Args& a, int seq, int chunk, int h, int tid) {
    const bool samp = seq >= NB; const int b = samp ? seq - NB : seq;
    const int row0 = samp ? MP + b * DEC_T : b * SEQ + chunk * 64, L = samp ? DEC_T : 64;
    const bf16* QK = (const bf16*)(a.ws + WS_T0); const float* GLR = (const float*)(a.ws + WS_GLR);
#pragma unroll
    for (int j = 0; j < 2; ++j) { const int idx = tid + 512 * j, t = idx >> 4, c16 = idx & 15;
        R.qraw[j] = (v4u){0u, 0u, 0u, 0u}; R.kraw[j] = (v4u){0u, 0u, 0u, 0u};
        if (t < L) { const bf16* src = QK + (size_t)(row0 + t) * D + h * 128 + c16 * 8; R.qraw[j] = *(const v4u*)src; R.kraw[j] = *(const v4u*)(src + 512); } }
    R.gl = (f32x4){0.f, 0.f, 0.f, 0.f};
    if (tid < 256) { const int t = tid >> 2, c4 = tid & 3; if (t < L) R.gl = *(const f32x4*)(GLR + (size_t)(row0 + t) * 16 + c4 * 4); }
}
__device__ __forceinline__ void g1_compute(G1Regs& R, const float (&w)[16], float bias, const Args& a, Frame& F, int seq, int chunk, int h) {
    const int tid = F.tid, lane = F.lane, wave = F.wave, fr = lane & 15, fq = lane >> 4;
    const bool samp = seq >= NB; const int b = samp ? seq - NB : seq;
    const int row0 = samp ? MP + b * DEC_T : b * SEQ + chunk * 64, L = samp ? DEC_T : 64;
    const int uid = samp ? NB * 64 * GH + b * GH + h : (b * 64 + chunk) * GH + h;
    bf16* QK = (bf16*)(a.ws + WS_T0); bf16* KT = (bf16*)(a.ws + WS_T7); bf16* ABUF = (bf16*)(a.ws + WS_ABUF);
    float* gdec = (float*)(a.ws + WS_GDEC);
    LAS float* glr_l = (LAS float*)(F.lds + G1_GLR_OFF); LAS float* tot = (LAS float*)(F.lds + G1_TOT_OFF);
    LAS unsigned char* ql = F.lds + G1_Q_OFF; LAS unsigned char* kl = F.lds + G1_K_OFF;
    const int d = tid & 127, strip = tid >> 7, t0 = strip * 16;
    LDS_BAR();
#pragma unroll
    for (int j = 0; j < 2; ++j) { const int idx = tid + 512 * j, t = idx >> 4, c16 = idx & 15; *(LAS v4u*)(ql + t * G1_LD_B + c16 * 16) = R.qraw[j]; *(LAS v4u*)(kl + t * G1_LD_B + c16 * 16) = R.kraw[j]; }
    if (tid < 256) *(LAS f32x4*)(glr_l + (tid >> 2) * 16 + (tid & 3) * 4) = R.gl;
    LDS_BAR();
    float bc[16]; float run = 0.f;
#pragma unroll
    for (int i = 0; i < 16; ++i) {
        const int t = t0 + i; float lg = bias;
#pragma unroll
        for (int r4 = 0; r4 < 4; ++r4) { const f32x4 gv = *(const LAS f32x4*)(glr_l + t * 16 + r4 * 4); lg += gv[0] * w[r4 * 4] + gv[1] * w[r4 * 4 + 1] + gv[2] * w[r4 * 4 + 2] + gv[3] * w[r4 * 4 + 3]; }
        const float ls = fminf(lg, 0.f) - __logf(1.0f + __expf(-fabsf(lg)));
        run += (t < L) ? ls * (1.0f / 16.0f) : 0.f; bc[i] = run;
    }
    tot[strip * 128 + d] = run;
    LDS_BAR();
    float off = 0.f, bL = 0.f;
#pragma unroll
    for (int s = 0; s < 4; ++s) { const float tv = tot[s * 128 + d]; bL += tv; if (s < strip) off += tv; }
    unsigned short kp[16];
    const float ebL = __expf(bL);
#pragma unroll
    for (int i = 0; i < 16; ++i) {
        const int t = t0 + i; const float bt = bc[i] + off;
        LAS unsigned short* qe = (LAS unsigned short*)(ql + t * G1_LD_B + d * 2); LAS unsigned short* ke = (LAS unsigned short*)(kl + t * G1_LD_B + d * 2);
        const float q = bf2f(*qe), k = bf2f(*ke);
        const float eb = __expf(bt), ebi = fast_rcp(eb);
        kp[i] = f2bf(k * (ebL * ebi));
        *qe = f2bf(q * eb); *ke = f2bf(k * ebi);
    }
    { v4u o0, o1; o0.x = kp[0] | ((unsigned)kp[1] << 16); o0.y = kp[2] | ((unsigned)kp[3] << 16); o0.z = kp[4] | ((unsigned)kp[5] << 16); o0.w = kp[6] | ((unsigned)kp[7] << 16);
      o1.x = kp[8] | ((unsigned)kp[9] << 16); o1.y = kp[10] | ((unsigned)kp[11] << 16); o1.z = kp[12] | ((unsigned)kp[13] << 16); o1.w = kp[14] | ((unsigned)kp[15] << 16);
      v4u* kd = (v4u*)(KT + ((size_t)uid * 128 + d) * 64 + t0); kd[0] = o0; kd[1] = o1; }
    if (strip == 0) gdec[(size_t)uid * 128 + d] = ebL;
    LDS_BAR();
#pragma unroll
    for (int j = 0; j < 2; ++j) { const int idx = tid + 512 * j, t = idx >> 4, c16 = idx & 15;
        if (t < L) *(v4u*)(QK + (size_t)(row0 + t) * D + h * 128 + c16 * 8) = *(const LAS v4u*)(ql + t * G1_LD_B + c16 * 16); }
    const int sb = wave >> 1;
    bf16x8 kf[4];
#pragma unroll
    for (int kd = 0; kd < 4; ++kd) kf[kd] = *(const LAS bf16x8*)(kl + (sb * 16 + fr) * G1_LD_B + (kd * 32 + 8 * fq) * 2);
#pragma unroll
    for (int x = 0; x < 2; ++x) {
        const int tb = 2 * (wave & 1) + x;
        f32x4 c = {0.f, 0.f, 0.f, 0.f};
#pragma unroll
        for (int kd = 0; kd < 4; ++kd) { const bf16x8 qf = *(const LAS bf16x8*)(ql + (tb * 16 + fr) * G1_LD_B + (kd * 32 + 8 * fq) * 2); c = __builtin_amdgcn_mfma_f32_16x16x32_bf16(kf[kd], qf, c, 0, 0, 0); }
        const int t = tb * 16 + fr, s0 = sb * 16 + 4 * fq;
        float v[4];
#pragma unroll
        for (int j = 0; j < 4; ++j) v[j] = (t >= s0 + j) ? c[j] : 0.f;
        if (t < L) { v2u o; o.x = pk2(v[0], v[1]); o.y = pk2(v[2], v[3]); *(v2u*)(ABUF + (size_t)(row0 + t) * 256 + h * 64 + s0) = o; }
    }
}

constexpr int H2_A_OFF = 0, H2_A_LD = 160, H2_Q_OFF = 64 * H2_A_LD, H2_Q_LD = 288, H2_KT_OFF = H2_Q_OFF + 64 * H2_Q_LD, H2_KT_LD = 160, H2_VT_OFF = H2_KT_OFF + 128 * H2_KT_LD, H2_VT_LD = 160,
              H2_ST_OFF = H2_VT_OFF + 64 * H2_VT_LD, H2_ST_LD = 288, H2_END = H2_ST_OFF + 64 * H2_ST_LD;
constexpr int H2_BUF = 77824;
static_assert(H2_END <= H2_BUF && 2 * H2_BUF <= PHASE_LDS, "G2 LDS map");
struct H2Regs { v4u a; v4u q[2]; v4u kt[2]; v4u v; f32x4 g4; };
struct H2Off { unsigned a, q, k, v, g, o; };
template <bool SAMP> __device__ __forceinline__ void h2_load(H2Regs& R, const Args& a, const H2Off& O, int row0, int uid, int h, int es, int tid, int lane) {
    const char* bA = (const char*)(a.ws + WS_ABUF) + ((size_t)row0 * 256 + h * 64) * 2;
    const char* bQ = (const char*)(a.ws + WS_T0) + ((size_t)row0 * D + h * 128) * 2;
    const char* bK = (const char*)(a.ws + WS_T7) + (size_t)uid * 16384;
    const char* bV = (const char*)(a.ws + WS_T1) + ((size_t)row0 * D + h * 256 + es * 64) * 2;
    const char* bG = (const char*)(a.ws + WS_GDEC) + (size_t)uid * 512;
    const v4u z = {0u, 0u, 0u, 0u};
    R.a = z; if (!SAMP || (tid >> 3) < DEC_T) R.a = *(const v4u*)(bA + O.a);
#pragma unroll
    for (int j = 0; j < 2; ++j) { R.q[j] = z; if (!SAMP || j == 0) R.q[j] = *(const v4u*)(bQ + O.q + j * 65536); }
#pragma unroll
    for (int j = 0; j < 2; ++j) R.kt[j] = *(const v4u*)(bK + O.k + j * 8192);
    R.v = z; if (!SAMP || lane < DEC_T) R.v = *(const v4u*)(bV + O.v);
    R.g4 = *(const f32x4*)(bG + O.g);
}
__device__ __forceinline__ void h2_stage(const H2Regs& R, LAS unsigned char* lds, int tid, int lane, int wave) {
    { const int t = tid >> 3, ch = tid & 7; *(LAS v4u*)(lds + H2_A_OFF + t * H2_A_LD + ch * 16) = R.a; }
#pragma unroll
    for (int j = 0; j < 2; ++j) { const int p = tid + 512 * j; *(LAS v4u*)(lds + H2_Q_OFF + (p >> 4) * H2_Q_LD + (p & 15) * 16) = R.q[j]; *(LAS v4u*)(lds + H2_KT_OFF + (p >> 3) * H2_KT_LD + (p & 7) * 16) = R.kt[j]; }
    { LAS unsigned short* vt = (LAS unsigned short*)(lds + H2_VT_OFF + (wave * 8) * H2_VT_LD + lane * 2); const unsigned w_[4] = {R.v.x, R.v.y, R.v.z, R.v.w};
#pragma unroll
      for (int i = 0; i < 4; ++i) { vt[(2 * i) * (H2_VT_LD / 2)] = (unsigned short)(w_[i] & 0xffffu); vt[(2 * i + 1) * (H2_VT_LD / 2)] = (unsigned short)(w_[i] >> 16); } }
}
template <bool SAMP> __device__ __forceinline__ void g2_item(const Args& a, Frame& F, int bh, int es) {
    const int tid = F.tid, lane = F.lane, wave = F.wave, fr = lane & 15, fq = lane >> 4;
    constexpr int nch = SAMP ? 1 : 64; const int b = bh >> 2, h = bh & 3;
    const int tb = wave >> 1, eb0 = (wave & 1) * 2;
    bf16* OG = (bf16*)(a.ws + WS_T1);
    LAS unsigned char* lds0 = F.lds;
    H2Off OF; OF.a = (unsigned)((tid >> 3) * 512 + (tid & 7) * 16); OF.q = (unsigned)((tid >> 4) * 2048 + (tid & 15) * 16); OF.k = (unsigned)(tid * 16);
    OF.v = (unsigned)(lane * 2048 + wave * 16); OF.g = (unsigned)((16 * wave + 4 * fq) * 4); OF.o = (unsigned)(((tb * 16 + fr) * D + eb0 * 16 + 4 * fq) * 2);
    f32x4 S[4];
#pragma unroll
    for (int eb = 0; eb < 4; ++eb)
#pragma unroll
        for (int r = 0; r < 4; ++r) S[eb][r] = SAMP ? a.in[2][((size_t)bh * 128 + 16 * wave + 4 * fq + r) * 256 + es * 64 + eb * 16 + fr] : 0.f;
    H2Regs R0, R1, R2;
#define H2_LOADC(R, cc) do { const int c_ = (cc) < nch ? (cc) : nch - 1; \
        h2_load<SAMP>(R, a, OF, SAMP ? MP + b * DEC_T : b * SEQ + c_ * 64, SAMP ? NB * 64 * GH + bh : (b * 64 + c_) * GH + h, h, es, tid, lane); } while (0)
#define H2_STEP(R, NXT, cc, PAR) do { \
        const int row0 = SAMP ? MP + b * DEC_T : b * SEQ + (cc) * 64; \
        LAS unsigned char* lds = lds0 + (PAR) * H2_BUF; \
        asm volatile("" : "+v"(R.a), "+v"(R.q[0]), "+v"(R.q[1]), "+v"(R.kt[0]), "+v"(R.kt[1]), "+v"(R.v), "+v"(R.g4)); \
        h2_stage(R, lds, tid, lane, wave); \
        const f32x4 g4 = R.g4; \
        _Pragma("unroll") for (int eb = 0; eb < 4; ++eb) { v2u o; o.x = pk2(S[eb][0], S[eb][1]); o.y = pk2(S[eb][2], S[eb][3]); *(LAS v2u*)(lds + H2_ST_OFF + (eb * 16 + fr) * H2_ST_LD + (16 * wave + 4 * fq) * 2) = o; } \
        LDS_BAR(); \
        if (!SAMP) H2_LOADC(NXT, (cc) + 2); \
        { bf16x8 afr[2], qfr[4], vo[2][2], sf[2][4]; \
          _Pragma("unroll") for (int ks = 0; ks < 2; ++ks) afr[ks] = *(const LAS bf16x8*)(lds + H2_A_OFF + (tb * 16 + fr) * H2_A_LD + ks * 64 + fq * 16); \
          _Pragma("unroll") for (int kd = 0; kd < 4; ++kd) qfr[kd] = *(const LAS bf16x8*)(lds + H2_Q_OFF + (tb * 16 + fr) * H2_Q_LD + kd * 64 + fq * 16); \
          _Pragma("unroll") for (int j = 0; j < 2; ++j) { \
              _Pragma("unroll") for (int ks = 0; ks < 2; ++ks) vo[j][ks] = *(const LAS bf16x8*)(lds + H2_VT_OFF + ((eb0 + j) * 16 + fr) * H2_VT_LD + ks * 64 + fq * 16); \
              _Pragma("unroll") for (int kd = 0; kd < 4; ++kd) sf[j][kd] = *(const LAS bf16x8*)(lds + H2_ST_OFF + ((eb0 + j) * 16 + fr) * H2_ST_LD + kd * 64 + fq * 16); } \
          asm volatile("s_waitcnt lgkmcnt(0)" ::: "memory"); __builtin_amdgcn_sched_barrier(0); \
          f32x4 acc0 = {0.f, 0.f, 0.f, 0.f}, acc1 = {0.f, 0.f, 0.f, 0.f}; \
          _Pragma("unroll") for (int ks = 0; ks < 2; ++ks) { acc0 = __builtin_amdgcn_mfma_f32_16x16x32_bf16(vo[0][ks], afr[ks], acc0, 0, 0, 0); acc1 = __builtin_amdgcn_mfma_f32_16x16x32_bf16(vo[1][ks], afr[ks], acc1, 0, 0, 0); } \
          _Pragma("unroll") for (int kd = 0; kd < 4; ++kd) { acc0 = __builtin_amdgcn_mfma_f32_16x16x32_bf16(sf[0][kd], qfr[kd], acc0, 0, 0, 0); acc1 = __builtin_amdgcn_mfma_f32_16x16x32_bf16(sf[1][kd], qfr[kd], acc1, 0, 0, 0); } \
          __builtin_amdgcn_sched_barrier(0); \
          bf16x8 kfr[2], vb[4][2]; \
          _Pragma("unroll") for (int ks = 0; ks < 2; ++ks) kfr[ks] = *(const LAS bf16x8*)(lds + H2_KT_OFF + (16 * wave + fr) * H2_KT_LD + ks * 64 + fq * 16); \
          _Pragma("unroll") for (int eb = 0; eb < 4; ++eb) _Pragma("unroll") for (int ks = 0; ks < 2; ++ks) vb[eb][ks] = *(const LAS bf16x8*)(lds + H2_VT_OFF + (eb * 16 + fr) * H2_VT_LD + ks * 64 + fq * 16); \
          _Pragma("unroll") for (int eb = 0; eb < 4; ++eb) S[eb] = S[eb] * g4; \
          asm volatile("s_waitcnt lgkmcnt(0)" ::: "memory"); __builtin_amdgcn_sched_barrier(0); \
          _Pragma("unroll") for (int ks = 0; ks < 2; ++ks) _Pragma("unroll") for (int eb = 0; eb < 4; ++eb) S[eb] = __builtin_amdgcn_mfma_f32_16x16x32_bf16(kfr[ks], vb[eb][ks], S[eb], 0, 0, 0); \
          if (!SAMP || tb < 2) { v2u o; o.x = pk2(acc0[0], acc0[1]); o.y = pk2(acc0[2], acc0[3]); *(v2u*)((char*)OG + ((size_t)row0 * D + h * 256 + es * 64) * 2 + OF.o) = o; \
                                 o.x = pk2(acc1[0], acc1[1]); o.y = pk2(acc1[2], acc1[3]); *(v2u*)((char*)OG + ((size_t)row0 * D + h * 256 + es * 64) * 2 + OF.o + 32) = o; } } \
    } while (0)
    H2_LOADC(R0, 0); if (!SAMP) H2_LOADC(R1, 1);
    LDS_BAR();
    if (SAMP) { H2_STEP(R0, R2, 0, 0); }
    else {
        H2_STEP(R0, R2, 0, 0); H2_STEP(R1, R0, 1, 1);
        for (int c = 2; c < 62; c += 6) { H2_STEP(R2, R1, c, 0); H2_STEP(R0, R2, c + 1, 1); H2_STEP(R1, R0, c + 2, 0); H2_STEP(R2, R1, c + 3, 1); H2_STEP(R0, R2, c + 4, 0); H2_STEP(R1, R0, c + 5, 1); }
        H2_STEP(R2, R1, 62, 0); H2_STEP(R0, R2, 63, 1);
    }
#undef H2_STEP
#undef H2_LOADC
    float* so = a.out + (SAMP ? O_SGS : O_SGP);
#pragma unroll
    for (int eb = 0; eb < 4; ++eb)
#pragma unroll
        for (int r = 0; r < 4; ++r) so[((size_t)bh * 128 + 16 * wave + 4 * fq + r) * 256 + es * 64 + eb * 16 + fr] = S[eb][r];
}

template <int RM, int RN> struct SgFrag { bf16x8 a[RM][2], b[RN][2]; };
template <int RM, int RN> __device__ __forceinline__ void sg_ld(SgFrag<RM, RN>& f, const bf16* ap, int arow16, const bf16* (&bp)[RN], int k0) {
#pragma unroll
    for (int r = 0; r < RM; ++r) { f.a[r][0] = *(const bf16x8*)(ap + (size_t)r * arow16 + k0); f.a[r][1] = *(const bf16x8*)(ap + (size_t)r * arow16 + k0 + 32); }
#pragma unroll
    for (int n = 0; n < RN; ++n) { f.b[n][0] = *(const bf16x8*)(bp[n] + k0); f.b[n][1] = *(const bf16x8*)(bp[n] + k0 + 32); }
}
template <int RM, int RN> __device__ __forceinline__ void sg_mm(f32x4 (&c)[RM][RN], const SgFrag<RM, RN>& f) {
#pragma unroll
    for (int j = 0; j < 2; ++j)
#pragma unroll
        for (int r = 0; r < RM; ++r)
#pragma unroll
            for (int n = 0; n < RN; ++n) c[r][n] = __builtin_amdgcn_mfma_f32_16x16x32_bf16(f.b[n][j], f.a[r][j], c[r][n], 0, 0, 0);
}
template <int RM, int RN, class Hook> __device__ __forceinline__ void sg_kloop2(f32x4 (&c)[RM][RN], const bf16* ap, int arow16, const bf16* (&bp)[RN], int K, Hook&& hook) {
    SgFrag<RM, RN> f0, f1;
    sg_ld<RM, RN>(f0, ap, arow16, bp, 0);
    hook();
    int k0 = 0;
    for (; k0 + 128 <= K; k0 += 128) {
        sg_ld<RM, RN>(f1, ap, arow16, bp, k0 + 64);
        sg_mm<RM, RN>(c, f0);
        if (k0 + 128 < K) sg_ld<RM, RN>(f0, ap, arow16, bp, k0 + 128);
        sg_mm<RM, RN>(c, f1);
    }
    if (k0 < K) sg_mm<RM, RN>(c, f0);
}
struct SgSsq { f32x4 a, b, c, d; };
__device__ __forceinline__ void sg_ssq_ld(SgSsq& q, const float* ssqs, int lr, int fq) { const f32x4* p = (const f32x4*)(ssqs + (size_t)lr * 64 + fq * 16); q.a = p[0]; q.b = p[1]; q.c = p[2]; q.d = p[3]; }
__device__ __forceinline__ float sg_ssq_rstd(const SgSsq& q) {
    float s = ((q.a.x + q.a.y) + (q.a.z + q.a.w)) + ((q.b.x + q.b.y) + (q.b.z + q.b.w)) + ((q.c.x + q.c.y) + (q.c.z + q.c.w)) + ((q.d.x + q.d.y) + (q.d.z + q.d.w));
    s += __shfl_xor(s, 16); s += __shfl_xor(s, 32);
    return __builtin_amdgcn_rsqf(s * (1.0f / D) + EPS);
}
__device__ __forceinline__ float sg_rstd(const float* ssqs, int lr, int fq) {
    const f32x4* p = (const f32x4*)(ssqs + (size_t)lr * 64 + fq * 16);
    const f32x4 a = p[0], b = p[1], c = p[2], d = p[3];
    float s = ((a.x + a.y) + (a.z + a.w)) + ((b.x + b.y) + (b.z + b.w)) + ((c.x + c.y) + (c.z + c.w)) + ((d.x + d.y) + (d.z + d.w));
    s += __shfl_xor(s, 16); s += __shfl_xor(s, 32);
    return __builtin_amdgcn_rsqf(s * (1.0f / D) + EPS);
}
__device__ __forceinline__ void sg_swiglu(const Args& a, Frame& F, const bf16* Wt, const float* ssqs) {
    const int gw = F.vcu * NWAVES + F.wave, NGW = F.G * NWAVES, fr = F.lane & 15, fq = F.lane >> 4;
    const bf16* XB = (const bf16*)(a.ws + WS_XB); bf16* ACT = (bf16*)(a.ws + WS_ACT);
    LAS f32x4* xch = (LAS f32x4*)F.lds;
    for (int it = gw; it < 2 * 4 * (FF / 16); it += NGW) {
        const int id = it >> 1, kh = it & 1, mq = id & 3, jb = id >> 2, g0 = 16 * jb;
        const int grow = 256 * (g0 >> 7) + (g0 & 127);
        const bf16* bp[2] = {Wt + (size_t)(grow + fr) * D + kh * (D / 2) + 8 * fq, Wt + (size_t)(grow + 128 + fr) * D + kh * (D / 2) + 8 * fq};
        f32x4 c[4][2];
#pragma unroll
        for (int r = 0; r < 4; ++r) { c[r][0] = (f32x4){0.f, 0.f, 0.f, 0.f}; c[r][1] = (f32x4){0.f, 0.f, 0.f, 0.f}; }
        SgSsq q[4]; float rsv[4] = {0.f, 0.f, 0.f, 0.f};
        if (!kh) {
#pragma unroll
            for (int r = 0; r < 4; ++r) sg_ssq_ld(q[r], ssqs, mq * 64 + r * 16 + fr, fq);
        }
        sg_kloop2<4, 2>(c, XB + (size_t)(MP + mq * 64 + fr) * D + kh * (D / 2) + 8 * fq, 16 * D, bp, D / 2, [&] { if (!kh) {
#pragma unroll
            for (int r = 0; r < 4; ++r) rsv[r] = sg_ssq_rstd(q[r]); } });
        __syncthreads();
        if (kh) {
#pragma unroll
            for (int r = 0; r < 4; ++r) { xch[((F.wave >> 1) * 8 + 2 * r) * 64 + F.lane] = c[r][0]; xch[((F.wave >> 1) * 8 + 2 * r + 1) * 64 + F.lane] = c[r][1]; }
        }
        __syncthreads();
        if (!kh) {
#pragma unroll
            for (int r = 0; r < 4; ++r) {
                const int lr = mq * 64 + r * 16 + fr, m = MP + lr;
                const f32x4 g = c[r][0] + xch[((F.wave >> 1) * 8 + 2 * r) * 64 + F.lane], up = c[r][1] + xch[((F.wave >> 1) * 8 + 2 * r + 1) * 64 + F.lane];
                const float rs = rsv[r];
                float o[4];
#pragma unroll
                for (int j = 0; j < 4; ++j) o[j] = siluf_(g[j] * rs) * (up[j] * rs);
                v2u w; w.x = pk2(o[0], o[1]); w.y = pk2(o[2], o[3]);
                *(v2u*)(ACT + (size_t)m * FF + g0 + 4 * fq) = w;
            }
        }
    }
}
__device__ __forceinline__ void sg_resid(const Args& a, Frame& F, const bf16* A, int lda, const bf16* Wt, int K, const float* res_f32, float alpha, float* ssqs_out) {
    const int fr = F.lane & 15, fq = F.lane >> 4;
    bf16* XB = (bf16*)(a.ws + WS_XB);
    LAS f32x4* xch = (LAS f32x4*)F.lds;
    const int ng = K >> 6, gb = ng >> 3, gr = ng & 7;
    const int ks = (F.wave * gb + (F.wave < gr ? F.wave : gr)) * 64, Ks = (gb + (F.wave < gr ? 1 : 0)) * 64;
    for (int u = F.vcu; u < 8 * (D / 32); u += F.G) {
        const int mp = u & 7, np = u >> 3;
        const bf16* bp[2] = {Wt + (size_t)(32 * np + fr) * K + ks + 8 * fq, Wt + (size_t)(32 * np + 16 + fr) * K + ks + 8 * fq};
        f32x4 c[2][2] = {{{0.f, 0.f, 0.f, 0.f}, {0.f, 0.f, 0.f, 0.f}}, {{0.f, 0.f, 0.f, 0.f}, {0.f, 0.f, 0.f, 0.f}}};
        sg_kloop2<2, 2>(c, A + (size_t)(MP + mp * 32 + fr) * lda + ks + 8 * fq, 16 * lda, bp, Ks, [] {});
        __syncthreads();
#pragma unroll
        for (int r = 0; r < 2; ++r) { xch[(F.wave * 4 + 2 * r) * 64 + F.lane] = c[r][0]; xch[(F.wave * 4 + 2 * r + 1) * 64 + F.lane] = c[r][1]; }
        __syncthreads();
        if (F.wave < 4) {
            f32x4 s = xch[F.wave * 64 + F.lane];
#pragma unroll
            for (int q = 1; q < 8; ++q) s += xch[(q * 4 + F.wave) * 64 + F.lane];
            const int r = F.wave >> 1, nb = 2 * np + (F.wave & 1), lr = mp * 32 + r * 16 + fr, m = MP + lr, n0 = 16 * nb + 4 * fq;
            f32x4 rr;
            if (res_f32) rr = *(const f32x4*)(res_f32 + (size_t)lr * D + n0);
            else { const v2u rb = *(const v2u*)(XB + (size_t)m * D + n0); rr = (f32x4){bflo(rb.x), bfhi(rb.x), bflo(rb.y), bfhi(rb.y)}; }
            const f32x4 v = rr + s * alpha;
            { v2u w; w.x = pk2(v[0], v[1]); w.y = pk2(v[2], v[3]); *(v2u*)(XB + (size_t)m * D + n0) = w; }
            if (ssqs_out) { float ss = (v[0] * v[0] + v[1] * v[1]) + (v[2] * v[2] + v[3] * v[3]); ss += __shfl_xor(ss, 16); ss += __shfl_xor(ss, 32); if (fq == 0) ssqs_out[(size_t)lr * 64 + nb] = ss; }
        }
    }
}
__device__ __forceinline__ void sg_proj(const Args& a, Frame& F) {
    const int gw = F.vcu * NWAVES + F.wave, NGW = F.G * NWAVES, fr = F.lane & 15, fq = F.lane >> 4;
    unsigned char* ws = a.ws;
    const bf16* XB = (const bf16*)(ws + WS_XB); const bf16* Wt = (const bf16*)(ws + WS_WAT); const float* ssqs = (const float*)(ws + WS_SSQAS);
    constexpr int NBLK = (NA - 240) / 16, NPAIR = (NBLK + 1) / 2;
    LAS f32x4* xch = (LAS f32x4*)F.lds;
    for (int it = gw; it < 2 * 4 * NPAIR; it += NGW) {
        const int id = it >> 1, kh = it & 1, mq = id & 3, jp = id >> 2;
        const bf16* bp[2] = {Wt + (size_t)(32 * jp + fr) * D + kh * (D / 2) + 8 * fq, Wt + (size_t)(32 * jp + 16 + fr) * D + kh * (D / 2) + 8 * fq};
        f32x4 c[4][2];
#pragma unroll
        for (int r = 0; r < 4; ++r) { c[r][0] = (f32x4){0.f, 0.f, 0.f, 0.f}; c[r][1] = (f32x4){0.f, 0.f, 0.f, 0.f}; }
        SgSsq q[4]; float rsv[4] = {0.f, 0.f, 0.f, 0.f};
        if (!kh) {
#pragma unroll
            for (int r = 0; r < 4; ++r) sg_ssq_ld(q[r], ssqs, mq * 64 + r * 16 + fr, fq);
        }
        sg_kloop2<4, 2>(c, XB + (size_t)(MP + mq * 64 + fr) * D + kh * (D / 2) + 8 * fq, 16 * D, bp, D / 2, [&] { if (!kh) {
#pragma unroll
            for (int r = 0; r < 4; ++r) rsv[r] = sg_ssq_rstd(q[r]); } });
        __syncthreads();
        if (kh) {
#pragma unroll
            for (int r = 0; r < 4; ++r) { xch[((F.wave >> 1) * 8 + 2 * r) * 64 + F.lane] = c[r][0]; xch[((F.wave >> 1) * 8 + 2 * r + 1) * 64 + F.lane] = c[r][1]; }
        }
        __syncthreads();
        if (kh) continue;
#pragma unroll
        for (int r = 0; r < 4; ++r) {
            const int lr = mq * 64 + r * 16 + fr, m = MP + lr;
            const float rs = rsv[r];
#pragma unroll
            for (int n = 0; n < 2; ++n) {
                const int n0 = 32 * jp + 16 * n, nq = n0 + 4 * fq;
                if (n0 >= 16 * NBLK) continue;
                f32x4 v = (c[r][n] + xch[((F.wave >> 1) * 8 + 2 * r + n) * 64 + F.lane]) * rs;
                if (n0 >= 4352) {
                    *(f32x4*)((float*)(ws + WS_GLR) + (size_t)m * 16 + 4 * fq) = v;
                } else if (n0 >= 4096) {
                    v2u w; w.x = pk2(v[0], v[1]); w.y = pk2(v[2], v[3]);
                    *(v2u*)((bf16*)(ws + WS_SKV) + (size_t)m * 256 + (nq - 4096)) = w;
                    const int bs = lr >> 5, t = lr & 31;
                    *(f32x4*)(a.out + (nq < 4224 ? O_CKS : O_CVS) + ((size_t)(bs * WINDOW + 96 + t)) * 128 + ((nq - 4096) & 127)) = v;
                } else {
                    bf16* dst; int col;
                    if (n0 < 1024) { dst = (bf16*)(ws + WS_T0); col = nq; if (n0 < 512) v = v * 0.08838834764831845f; }
                    else if (n0 < 2048) { dst = (bf16*)(ws + WS_T1); col = nq - 1024; }
                    else if (n0 < 3072) { dst = (bf16*)(ws + WS_T2); col = nq - 2048; v = v * (0.125f * LOG2E); }
                    else { dst = (bf16*)(ws + WS_T8); col = nq - 3072;
#pragma unroll
                        for (int j = 0; j < 4; ++j) v[j] = siluf_(v[j]); }
                    v2u w; w.x = pk2(v[0], v[1]); w.y = pk2(v[2], v[3]);
                    *(v2u*)(dst + (size_t)m * D + col) = w;
                }
            }
        }
    }
}
__device__ __forceinline__ void sg_gates(const Args& a, Frame& F) {
    const int fr = F.lane & 15, fq = F.lane >> 4;
    unsigned char* ws = a.ws;
    const bf16* XB = (const bf16*)(ws + WS_XB); const bf16* Wt = (const bf16*)(ws + WS_WBT); const float* ssqs = (const float*)(ws + WS_SSQAS);
    bf16* R = (bf16*)(ws + WS_T0); bf16* SS = (bf16*)(ws + WS_T7);
    LAS f32x4* xch = (LAS f32x4*)F.lds;
    const int ks = F.wave * (D / 8);
    for (int u = F.vcu; u < 4 * (D / 16); u += F.G) {
        const int mq = u & 3, nb = u >> 2, n0 = 16 * nb;
        const int grow = 256 * (n0 >> 7) + (n0 & 127);
        const bf16* bp[2] = {Wt + (size_t)(grow + fr) * D + ks + 8 * fq, Wt + (size_t)(grow + 128 + fr) * D + ks + 8 * fq};
        f32x4 c[4][2];
#pragma unroll
        for (int r = 0; r < 4; ++r) { c[r][0] = (f32x4){0.f, 0.f, 0.f, 0.f}; c[r][1] = (f32x4){0.f, 0.f, 0.f, 0.f}; }
        SgSsq q; float rs = 0.f;
        if (F.wave < 4) sg_ssq_ld(q, ssqs, mq * 64 + F.wave * 16 + fr, fq);
        sg_kloop2<4, 2>(c, XB + (size_t)(MP + mq * 64 + fr) * D + ks + 8 * fq, 16 * D, bp, D / 8, [&] { if (F.wave < 4) rs = sg_ssq_rstd(q); });
        __syncthreads();
#pragma unroll
        for (int r = 0; r < 4; ++r) { xch[(F.wave * 8 + 2 * r) * 64 + F.lane] = c[r][0]; xch[(F.wave * 8 + 2 * r + 1) * 64 + F.lane] = c[r][1]; }
        __syncthreads();
        if (F.wave < 4) {
            f32x4 cg = xch[(2 * F.wave) * 64 + F.lane], cs = xch[(2 * F.wave + 1) * 64 + F.lane];
#pragma unroll
            for (int q = 1; q < 8; ++q) { cg += xch[(q * 8 + 2 * F.wave) * 64 + F.lane]; cs += xch[(q * 8 + 2 * F.wave + 1) * 64 + F.lane]; }
            const int lr = mq * 64 + F.wave * 16 + fr, m = MP + lr;
            float r[4], ss[4];
#pragma unroll
            for (int j = 0; j < 4; ++j) { const float eg = fast_exp(-cg[j] * rs), es = fast_exp(-cs[j] * rs); ss[j] = fast_rcp(1.0f + es); r[j] = (1.0f + es) * fast_rcp(1.0f + eg); }
            v2u w; w.x = pk2(r[0], r[1]); w.y = pk2(r[2], r[3]); *(v2u*)(R + (size_t)m * D + n0 + 4 * fq) = w;
            w.x = pk2(ss[0], ss[1]); w.y = pk2(ss[2], ss[3]); *(v2u*)(SS + (size_t)m * D + n0 + 4 * fq) = w;
        }
    }
}
__device__ __forceinline__ void sg_branch(const Args& a, Frame& F) {
    const int fr = F.lane & 15, fq = F.lane >> 4;
    unsigned char* ws = a.ws;
    const bf16* Wt = (const bf16*)(ws + WS_WBRT);
    const bf16* GG = (const bf16*)(ws + WS_T0); const bf16* GS = (const bf16*)(ws + WS_T7); bf16* O = (bf16*)(ws + WS_T8);
    LAS f32x4* xch = (LAS f32x4*)F.lds;
    const int half = F.wave >> 2, kq = (F.wave & 3) * (D / 4);
    const bf16* Asrc = (const bf16*)(ws + (half ? WS_T2 : WS_T1));
    for (int u = F.vcu; u < 8 * (D / 32); u += F.G) {
        const int mp = u & 7, np = u >> 3;
        const bf16* bp[2] = {Wt + (size_t)(32 * np + fr) * (2 * D) + half * D + kq + 8 * fq, Wt + (size_t)(32 * np + 16 + fr) * (2 * D) + half * D + kq + 8 * fq};
        f32x4 c[2][2] = {{{0.f, 0.f, 0.f, 0.f}, {0.f, 0.f, 0.f, 0.f}}, {{0.f, 0.f, 0.f, 0.f}, {0.f, 0.f, 0.f, 0.f}}};
        sg_kloop2<2, 2>(c, Asrc + (size_t)(MP + mp * 32 + fr) * D + kq + 8 * fq, 16 * D, bp, D / 4, [] {});
        __syncthreads();
#pragma unroll
        for (int r = 0; r < 2; ++r) { xch[(F.wave * 4 + 2 * r) * 64 + F.lane] = c[r][0]; xch[(F.wave * 4 + 2 * r + 1) * 64 + F.lane] = c[r][1]; }
        __syncthreads();
        if (F.wave < 4) {
            f32x4 ca = xch[F.wave * 64 + F.lane], cb = xch[(16 + F.wave) * 64 + F.lane];
#pragma unroll
            for (int q = 1; q < 4; ++q) { ca += xch[(q * 4 + F.wave) * 64 + F.lane]; cb += xch[((4 + q) * 4 + F.wave) * 64 + F.lane]; }
            const int r = F.wave >> 1, m = MP + mp * 32 + r * 16 + fr, n0 = 16 * (2 * np + (F.wave & 1)) + 4 * fq;
            const v2u g = *(const v2u*)(GG + (size_t)m * D + n0), sv = *(const v2u*)(GS + (size_t)m * D + n0);
            const float rr[4] = {bflo(g.x), bfhi(g.x), bflo(g.y), bfhi(g.y)}, ss[4] = {bflo(sv.x), bfhi(sv.x), bflo(sv.y), bfhi(sv.y)};
            v2u w; w.x = pk2((ca[0] * rr[0] + cb[0]) * ss[0], (ca[1] * rr[1] + cb[1]) * ss[1]); w.y = pk2((ca[2] * rr[2] + cb[2]) * ss[2], (ca[3] * rr[3] + cb[3]) * ss[3]);
            *(v2u*)(O + (size_t)m * D + n0) = w;
        }
    }
}

template <int K> __device__ __forceinline__ void run_phase(const Args& args, LAS unsigned char* ldsp) {
    Frame F;
    { int t = threadIdx.x; asm volatile("" : "+v"(t)); F.tid = t; }
    F.lds = ldsp; F.lane = F.tid & 63; F.wave = __builtin_amdgcn_readfirstlane(F.tid >> 6);
    F.G = gridDim.x; { const int bx = blockIdx.x; F.vcu = (F.G % 8 == 0) ? (bx % 8) * (F.G / 8) + bx / 8 : bx; }
    F.out = args.out; F.ws = args.ws;
    unsigned char* ws = args.ws;
    const int gw = F.vcu * NWAVES + F.wave, NGW = F.G * NWAVES;
    bf16* XB = (bf16*)(ws + WS_XB); bf16* ACT = (bf16*)(ws + WS_ACT);
    float* X = args.out + O_Y;
    (void)gw; (void)NGW; (void)XB; (void)ACT; (void)X;
    if constexpr (K == 0) { p0_prologue(args, F); }
    if constexpr (K == 1) {
        pg8::Gemm g{XB, XB, (const bf16*)(ws + WS_W1T), D, D, D, 1}; pg8::StaticOrder S; S.init(MP / 256, 2 * FF / 256, 1, F.G, (int)blockIdx.x);
        pg8::EpiSwiglu E{ACT, (const float*)(ws + WS_SSQ0)};
        pg8::gemm_phase<pg8::EpiSwiglu, true>(F.lds, g, S, E);
        sg_swiglu(args, F, (const bf16*)(ws + WS_W1T), (const float*)(ws + WS_SSQ0S));
    }
    if constexpr (K == 2) {
        pg8::Gemm g{ACT, ACT, (const bf16*)(ws + WS_W1OT), FF, FF, FF, 1}; pg8::StaticOrder S; S.init(MP / 256, D / 256, 1, F.G, (int)blockIdx.x);
        pg8::EpiResid<true> E{nullptr, XB, (float*)(ws + WS_SSQA), 0.5f};
        pg8::gemm_phase<pg8::EpiResid<true>, true>(F.lds, g, S, E);
        sg_resid(args, F, ACT, FF, (const bf16*)(ws + WS_W1OT), FF, nullptr, 0.5f, (float*)(ws + WS_SSQAS));
    }
    if constexpr (K == 3) {
        pg8::Gemm g{XB, XB, (const bf16*)(ws + WS_WAT), D, D, D, 1}; pg8::StaticOrder S; S.init(MP / 256, NA / 256, 1, F.G, (int)blockIdx.x);
        pg8::EpiProjA E{(bf16*)(ws + WS_T0), (bf16*)(ws + WS_T1), (bf16*)(ws + WS_T2), (bf16*)(ws + WS_T8), (bf16*)(ws + WS_SKV), (float*)(ws + WS_GLR), args.out, (const float*)(ws + WS_SSQA)};
        pg8::gemm_phase<pg8::EpiProjA, true>(F.lds, g, S, E);
        sg_proj(args, F);
    }
    if constexpr (K == 4) {
#define G1_SEQ(u) ((u) < NB * 64 * GH ? (u) >> 8 : NB + (((u) - NB * 64 * GH) >> 2))
#define G1_CHK(u) ((u) < NB * 64 * GH ? ((u) >> 2) & 63 : 0)
        const int hh = F.vcu & 3, dcol = F.tid & 127;
        float w[16];
#pragma unroll
        for (int r = 0; r < 16; ++r) w[r] = args.in[10][r * 512 + hh * 128 + dcol];
        const float bias = args.in[11][hh * 128 + dcol];
        G1Regs RA, RB;
        int u = F.vcu;
        if (u < NUNIT_G) g1_load(RA, args, G1_SEQ(u), G1_CHK(u), hh, F.tid);
        while (u < NUNIT_G) {
            const int u1 = u + F.G; if (u1 < NUNIT_G) g1_load(RB, args, G1_SEQ(u1), G1_CHK(u1), hh, F.tid);
            g1_compute(RA, w, bias, args, F, G1_SEQ(u), G1_CHK(u), hh);
            if (u1 >= NUNIT_G) break;
            const int u2 = u1 + F.G; if (u2 < NUNIT_G) g1_load(RA, args, G1_SEQ(u2), G1_CHK(u2), hh, F.tid);
            g1_compute(RB, w, bias, args, F, G1_SEQ(u1), G1_CHK(u1), hh);
            u = u2;
        }
#undef G1_SEQ
#undef G1_CHK
    }
    if constexpr (K == 5) {
        const int nh = F.G >> 1;
        constexpr int NSWA_P = NB * 64 * SKV, NSWA_S = NB * SKV;
        if ((F.vcu & 1) == 0) {
            for (int it = F.vcu >> 1; it < NB * GH * 4; it += nh) { g2_item<false>(args, F, it >> 2, it & 3); g2_item<true>(args, F, it >> 2, it & 3); }
        } else {
            for (int us = F.vcu >> 1; us < NSWA_S; us += nh) swa_unit(args, F, NB + (us >> 1), 0, us & 1);
        }
    }
    if constexpr (K == 12) {
        constexpr int NSWA_P = NB * 64 * SKV;
        unsigned* qhead = (unsigned*)(ws + WS_CTL) + 12288;
        volatile LAS unsigned* qslot = (volatile LAS unsigned*)(F.lds + MISC_OFF) + 16;
        unsigned t0 = 0, t1 = 0;
        if (F.tid == 0) { t0 = __hip_atomic_fetch_add(qhead, 1u, __ATOMIC_RELAXED, __HIP_MEMORY_SCOPE_AGENT); t1 = __hip_atomic_fetch_add(qhead, 1u, __ATOMIC_RELAXED, __HIP_MEMORY_SCOPE_AGENT); qslot[0] = t0; qslot[1] = t1; }
        __syncthreads();
        int u = (int)qslot[0], u1 = (int)qslot[1];
        SwaRegs RA, RB;
        if (u < NSWA_P) swa_p_load(RA, args, u, F.tid);
        while (u < NSWA_P) {
            unsigned tn = 0;
            if (F.tid == 0) tn = __hip_atomic_fetch_add(qhead, 1u, __ATOMIC_RELAXED, __HIP_MEMORY_SCOPE_AGENT);
            if (u1 < NSWA_P) swa_p_load(RB, args, u1, F.tid);
            swa_p_compute(RA, args, F, u);
            if (F.tid == 0) qslot[2] = tn;
            LDS_BAR();
            const int u2 = (int)qslot[2];
            if (u1 >= NSWA_P) break;
            if (F.tid == 0) tn = __hip_atomic_fetch_add(qhead, 1u, __ATOMIC_RELAXED, __HIP_MEMORY_SCOPE_AGENT);
            if (u2 < NSWA_P) swa_p_load(RA, args, u2, F.tid);
            swa_p_compute(RB, args, F, u1);
            if (F.tid == 0) qslot[3] = tn;
            LDS_BAR();
            u = u2; u1 = (int)qslot[3];
        }
        if (F.vcu & 1) {
            LDS_BAR();
            LAS float* scr = (LAS float*)(F.lds + F.wave * 16384);
            for (int l = (F.vcu >> 1) * NWAVES + F.wave; l < P0_NLATE; l += (F.G >> 1) * NWAVES) p0_weight_item(args, P0_NEARLY + l, scr, F.lane);
        }
    }
    if constexpr (K == 6) {
        bf16* OG = (bf16*)(ws + WS_T1); const bf16* GR = (const bf16*)(ws + WS_T8);
        for (int m0 = gw; m0 < M; m0 += 4 * NGW) {
            v4u ov[4][2], gv4[4][2];
#pragma unroll
            for (int r = 0; r < 4; ++r) { const int m = m0 + r * NGW; if (m < M) {
                ov[r][0] = *(const v4u*)(OG + (size_t)m * D + 16 * F.lane); ov[r][1] = *(const v4u*)(OG + (size_t)m * D + 16 * F.lane + 8);
                gv4[r][0] = *(const v4u*)(GR + (size_t)m * D + 16 * F.lane); gv4[r][1] = *(const v4u*)(GR + (size_t)m * D + 16 * F.lane + 8); } }
#pragma unroll
            for (int r = 0; r < 4; ++r) { const int m = m0 + r * NGW; if (m < M) {
                const v4u o0 = ov[r][0], o1 = ov[r][1], g0 = gv4[r][0], g1 = gv4[r][1];
                float ovf[16] = {bflo(o0.x), bfhi(o0.x), bflo(o0.y), bfhi(o0.y), bflo(o0.z), bfhi(o0.z), bflo(o0.w), bfhi(o0.w), bflo(o1.x), bfhi(o1.x), bflo(o1.y), bfhi(o1.y), bflo(o1.z), bfhi(o1.z), bflo(o1.w), bfhi(o1.w)};
                const float gvf[16] = {bflo(g0.x), bfhi(g0.x), bflo(g0.y), bfhi(g0.y), bflo(g0.z), bfhi(g0.z), bflo(g0.w), bfhi(g0.w), bflo(g1.x), bfhi(g1.x), bflo(g1.y), bfhi(g1.y), bflo(g1.z), bfhi(g1.z), bflo(g1.w), bfhi(g1.w)};
                float ss = 0.f;
#pragma unroll
                for (int j = 0; j < 16; ++j) ss += ovf[j] * ovf[j];
                ss += __shfl_xor(ss, 1); ss += __shfl_xor(ss, 2); ss += __shfl_xor(ss, 4); ss += __shfl_xor(ss, 8);
                const float rs = __builtin_amdgcn_rsqf(ss * (1.0f / GDV) + EPS);
#pragma unroll
                for (int j = 0; j < 16; ++j) ovf[j] = ovf[j] * rs * gvf[j];
                v4u w0, w1;
                w0.x = pk2(ovf[0], ovf[1]); w0.y = pk2(ovf[2], ovf[3]); w0.z = pk2(ovf[4], ovf[5]); w0.w = pk2(ovf[6], ovf[7]);
                w1.x = pk2(ovf[8], ovf[9]); w1.y = pk2(ovf[10], ovf[11]); w1.z = pk2(ovf[12], ovf[13]); w1.w = pk2(ovf[14], ovf[15]);
                *(v4u*)(OG + (size_t)m * D + 16 * F.lane) = w0; *(v4u*)(OG + (size_t)m * D + 16 * F.lane + 8) = w1; } }
        }
        __syncthreads();
        pg8::Gemm g{XB, XB, (const bf16*)(ws + WS_WBT), D, D, D, 1}; pg8::StaticOrder S; S.init(MP / 256, NBP / 256, 1, F.G, (int)blockIdx.x);
        pg8::EpiProjB E{(bf16*)(ws + WS_T0), (bf16*)(ws + WS_T7), (const float*)(ws + WS_SSQA)};
        pg8::gemm_phase<pg8::EpiProjB, true>(F.lds, g, S, E);
        sg_gates(args, F);
    }
    if constexpr (K == 7) {
        pg8::Gemm g{(const bf16*)(ws + WS_T1), (const bf16*)(ws + WS_T2), (const bf16*)(ws + WS_WBRT), D, 2 * D, D, 2}; pg8::StaticOrder S; S.init(MP / 256, D / 256, 2, F.G, (int)blockIdx.x);
        pg8::EpiBranch E{(const bf16*)(ws + WS_T0), (const bf16*)(ws + WS_T7), (bf16*)(ws + WS_T8)};
        pg8::gemm_phase<pg8::EpiBranch, true>(F.lds, g, S, E);
        sg_branch(args, F);
    }
    if constexpr (K == 8) {
        pg8::Gemm g{(const bf16*)(ws + WS_T8), (const bf16*)(ws + WS_T8), (const bf16*)(ws + WS_WOUTT), D, D, D, 1}; pg8::StaticOrder S; S.init(MP / 256, D / 256, 1, F.G, (int)blockIdx.x);
        pg8::EpiResid<true> E{nullptr, XB, (float*)(ws + WS_SSQB), 1.0f};
        pg8::gemm_phase<pg8::EpiResid<true>, true>(F.lds, g, S, E);
        sg_resid(args, F, (const bf16*)(ws + WS_T8), D, (const bf16*)(ws + WS_WOUTT), D, nullptr, 1.0f, (float*)(ws + WS_SSQBS));
    }
    if constexpr (K == 9) {
        pg8::Gemm g{XB, XB, (const bf16*)(ws + WS_W2T), D, D, D, 1}; pg8::StaticOrder S; S.init(MP / 256, 2 * FF / 256, 1, F.G, (int)blockIdx.x);
        pg8::EpiSwiglu E{ACT, (const float*)(ws + WS_SSQB)};
        pg8::gemm_phase<pg8::EpiSwiglu, true>(F.lds, g, S, E);
        sg_swiglu(args, F, (const bf16*)(ws + WS_W2T), (const float*)(ws + WS_SSQBS));
    }
    if constexpr (K == 10) {
        pg8::Gemm g{ACT, ACT, (const bf16*)(ws + WS_W2OT), FF, FF, FF, 1}; pg8::StaticOrder S; S.init(MP / 256, D / 256, 1, F.G, (int)blockIdx.x);
        pg8::EpiFinal E{XB, X, args.in[20], (unsigned*)(ws + WS_XSLOT), (unsigned*)(ws + WS_CTL) + CW_PAN, 0.5f};
        pg8::gemm_phase<pg8::EpiFinal, true>(F.lds, g, S, E);
        sg_resid(args, F, ACT, FF, (const bf16*)(ws + WS_W2OT), FF, nullptr, 0.5f, nullptr);
    }
    if constexpr (K == 11) {
        const f32x4* gf = (const f32x4*)args.in[20];
        f32x4 g4[4];
#pragma unroll
        for (int q = 0; q < 4; ++q) g4[q] = gf[4 * F.lane + q];
        for (int m0 = MP + gw; m0 < M; m0 += 4 * NGW) {
            v4u xv[4][2];
#pragma unroll
            for (int r = 0; r < 4; ++r) { const int m = m0 + r * NGW; if (m < M) { xv[r][0] = *(const v4u*)(XB + (size_t)m * D + 16 * F.lane); xv[r][1] = *(const v4u*)(XB + (size_t)m * D + 16 * F.lane + 8); } }
#pragma unroll
            for (int r = 0; r < 4; ++r) { const int m = m0 + r * NGW; if (m < M) {
                const v4u x0 = xv[r][0], x1 = xv[r][1];
                float v[16] = {bflo(x0.x), bfhi(x0.x), bflo(x0.y), bfhi(x0.y), bflo(x0.z), bfhi(x0.z), bflo(x0.w), bfhi(x0.w), bflo(x1.x), bfhi(x1.x), bflo(x1.y), bfhi(x1.y), bflo(x1.z), bfhi(x1.z), bflo(x1.w), bfhi(x1.w)};
                float s2 = 0.f;
#pragma unroll
                for (int j = 0; j < 16; ++j) s2 += v[j] * v[j];
                const float rs = __builtin_amdgcn_rsqf(wave_sum(s2) * (1.0f / D) + EPS);
                f32x4* yr = (f32x4*)(X + (size_t)m * D + 16 * F.lane);
#pragma unroll
                for (int q = 0; q < 4; ++q) yr[q] = (f32x4){v[4 * q] * rs * g4[q][0], v[4 * q + 1] * rs * g4[q][1], v[4 * q + 2] * rs * g4[q][2], v[4 * q + 3] * rs * g4[q][3]}; } }
        }
    }
}

#ifndef MK_SEQ
#define MK_SEQ P(0) S P(1) S P(2) S P(3) S P(4) S P(5) P(12) S P(6) S P(7) S P(8) S P(9) S P(10) S P(11)
#endif
__global__ void __launch_bounds__(NWAVES * 64, 2) mk_fwd(Args args) {
    extern __shared__ __attribute__((aligned(16))) unsigned char lds[];
    LAS unsigned char* ldsp = (LAS unsigned char*)lds;
    volatile LAS unsigned* MISC = (volatile LAS unsigned*)(ldsp + MISC_OFF);
    if (threadIdx.x < 32) MISC[threadIdx.x] = 0u;
    __syncthreads();
    XcdBarrier bar = xcd_barrier_post((unsigned*)(args.ws + WS_CTL) + 4096, MISC + 8);
#define P(k) if (args.ph_hi > (k)) run_phase<k>(args, ldsp);
#define S xcd_barrier(bar);
    MK_SEQ
#undef P
#undef S
}

extern "C" void kernel_launch(void* const* d_in, const int* in_sizes, int n_in, void* d_out, int out_size, void* d_ws, size_t ws_size, hipStream_t stream) {
    static int grid = 0;
    if (grid == 0) {
        if (n_in != 21 || in_sizes[0] != MP * D || (size_t)out_size != O_END || ws_size < WS_END) { fprintf(stderr, "kernel_launch: unexpected shapes (n_in %d in0 %d out %d ws %zu need %zu)\n", n_in, n_in > 0 ? in_sizes[0] : -1, out_size, ws_size, (size_t)WS_END); grid = -1; return; }
        int dev = 0, cus = 0, per_cu = 0;
        if (hipGetDevice(&dev) != hipSuccess || hipDeviceGetAttribute(&cus, hipDeviceAttributeMultiprocessorCount, dev) != hipSuccess) { grid = -1; return; }
        if (hipFuncSetAttribute((const void*)mk_fwd, hipFuncAttributeMaxDynamicSharedMemorySize, LDS_BYTES) != hipSuccess) { fprintf(stderr, "kernel_launch: hipFuncSetAttribute failed\n"); grid = -1; return; }
        if (hipOccupancyMaxActiveBlocksPerMultiprocessor(&per_cu, (const void*)mk_fwd, NWAVES * 64, LDS_BYTES) != hipSuccess || per_cu < 1) { fprintf(stderr, "kernel_launch: occupancy query says %d\n", per_cu); per_cu = 1; }
        (void)hipGetLastError();
        grid = cus;
    }
    if (grid < 0) return;
    Args a{};
    for (int i = 0; i < 21; ++i) a.in[i] = (const float*)d_in[i];
    a.out = (float*)d_out; a.ws = (unsigned char*)d_ws;
    if (hipMemsetAsync((char*)d_ws + WS_CTL, 0, 65536, stream) != hipSuccess) { fprintf(stderr, "kernel_launch: memset failed\n"); return; }
    a.ph_lo = 0; a.ph_hi = 13;
    void* kargs[] = {&a};
    hipError_t e = hipLaunchCooperativeKernel((const void*)mk_fwd, dim3(grid), dim3(NWAVES * 64), kargs, LDS_BYTES, stream);
    if (e != hipSuccess) fprintf(stderr, "kernel_launch: cooperative launch failed: %s\n", hipGetErrorString(e));
}
```

```cpp
#include <hip/hip_runtime.h>
#include <hip/hip_cooperative_groups.h>
#include <cstdio>
#include <cstdint>
namespace cg = cooperative_groups;


constexpr int D = 1024, NB = 8, SEQ = 4096, DEC_T = 32;
constexpr int MP = NB * SEQ, MS = NB * DEC_T, M = MP + MS;
constexpr int FF = 2816;
constexpr int GH = 4, GDK = 128, GDV = 256, GRANK = 16;
constexpr int SH = 16, SKV = 2, SHD = 64, WINDOW = 128;
constexpr float EPS = 1e-6f;
constexpr float LOG2E = 1.4426950408889634f;
constexpr int NA = 18 * 256;
constexpr int NBP = 8 * 256;
constexpr int S_GQ = 0, S_GK = 512, S_GV = 1024, S_GR = 2048, S_GLR = 3072, S_SQ = 3088, S_SK = 4112, S_SV = 4240, S_GG = 4368, S_GS = 5392, IN_W = 6416;

constexpr size_t O_Y = 0;
constexpr size_t O_SGP = (size_t)M * D;
constexpr size_t O_CKP = O_SGP + (size_t)NB * GH * GDK * GDV;
constexpr size_t O_CVP = O_CKP + (size_t)NB * WINDOW * SKV * SHD;
constexpr size_t O_SGS = O_CVP + (size_t)NB * WINDOW * SKV * SHD;
constexpr size_t O_CKS = O_SGS + (size_t)NB * GH * GDK * GDV;
constexpr size_t O_CVS = O_CKS + (size_t)NB * WINDOW * SKV * SHD;
constexpr size_t O_END = O_CVS + (size_t)NB * WINDOW * SKV * SHD;

constexpr size_t MiB = 1u << 20;
constexpr size_t R1 = (size_t)M * D * 2;
constexpr size_t WS_CTL = 0;
constexpr size_t WS_W1T = 1 * MiB;
constexpr size_t WS_W1OT = WS_W1T + (size_t)2 * FF * D * 2;
constexpr size_t WS_WAT = WS_W1OT + (size_t)D * FF * 2;
constexpr size_t WS_WBT = WS_WAT + (size_t)NA * D * 2;
constexpr size_t WS_WBRT = WS_WBT + (size_t)NBP * D * 2;
constexpr size_t WS_WOUTT = WS_WBRT + (size_t)D * 2 * D * 2;
constexpr size_t WS_W2T = WS_WOUTT + (size_t)D * D * 2;
constexpr size_t WS_W2OT = WS_W2T + (size_t)2 * FF * D * 2;
constexpr size_t WS_SSQ0 = WS_W2OT + (size_t)D * FF * 2;
constexpr size_t SSQ_BYTES = (size_t)M * 16 * 4;
constexpr size_t WS_SSQA = WS_SSQ0 + SSQ_BYTES;
constexpr size_t WS_SSQB = WS_SSQA + SSQ_BYTES;
constexpr int NUNIT_G = NB * 64 * GH + NB * GH;
constexpr size_t SSQS_BYTES = (size_t)MS * 64 * 4;
constexpr size_t WS_SSQ0S = WS_SSQB + SSQ_BYTES, WS_SSQAS = WS_SSQ0S + SSQS_BYTES, WS_SSQBS = WS_SSQAS + SSQS_BYTES;
constexpr size_t WS_GDEC = WS_SSQBS + SSQS_BYTES;
constexpr size_t WS_XB = (WS_GDEC + (size_t)NUNIT_G * 128 * 4 + 4095) & ~(size_t)4095;
constexpr size_t WS_T0 = WS_XB + R1;
constexpr size_t WS_T1 = WS_T0 + R1;
constexpr size_t WS_T2 = WS_T1 + R1;
constexpr size_t WS_T7 = WS_T2 + R1;
constexpr size_t WS_T8 = WS_T7 + R1;
constexpr size_t WS_SKV = WS_T8 + R1;
constexpr size_t WS_ABUF = WS_SKV + (size_t)M * 256 * 2;
constexpr size_t WS_GLR = WS_ABUF + (size_t)M * 256 * 2;
constexpr size_t WS_XSLOT = (WS_GLR + (size_t)M * 16 * 4 + 4095) & ~(size_t)4095;
constexpr size_t WS_END = WS_XSLOT + (size_t)(MP / 256) * 256 * 4 * 4;
constexpr int CW_PAN = 13312, CW_PAN_STRIDE = 16, CW_G1S = 12352;
constexpr size_t WS_ACT = WS_T0;
static_assert((size_t)M * FF * 2 <= 5 * R1, "act overlay");
static_assert(WS_END <= 512 * MiB, "workspace map must fit 512 MiB");

constexpr int RING_BYTES = 131072;
constexpr int PHASE_LDS = 155648;
constexpr int MISC_OFF = PHASE_LDS + 320;
constexpr int LDS_BYTES = 159744;
constexpr int NWAVES = 8;

#define GAS __attribute__((address_space(1)))
#define LAS __attribute__((address_space(3)))
typedef unsigned short bf16;
typedef unsigned v4u __attribute__((ext_vector_type(4)));
typedef unsigned v2u __attribute__((ext_vector_type(2)));
typedef float f32x4 __attribute__((ext_vector_type(4)));
typedef float f32x16 __attribute__((ext_vector_type(16)));
typedef short bf16x8 __attribute__((ext_vector_type(8)));
typedef float f32x2_t __attribute__((ext_vector_type(2)));
typedef __bf16 bf16x2_t __attribute__((ext_vector_type(2)));
#define LDS_WAIT() asm volatile("s_waitcnt lgkmcnt(0)" ::: "memory")
#define VM_WAIT() asm volatile("s_waitcnt vmcnt(0)" ::: "memory")
#define LDS_BAR() do { asm volatile("s_waitcnt lgkmcnt(0)" ::: "memory"); __builtin_amdgcn_s_barrier(); asm volatile("" ::: "memory"); } while (0)
__device__ __forceinline__ unsigned pk2(float lo, float hi) { f32x2_t v = {lo, hi}; bf16x2_t b = __builtin_convertvector(v, bf16x2_t); return __builtin_bit_cast(unsigned, b); }
__device__ __forceinline__ unsigned short f2bf(float f) { return (unsigned short)(pk2(f, 0.f) & 0xffffu); }
__device__ __forceinline__ float bf2f(unsigned short b) { return __uint_as_float((unsigned)b << 16); }
__device__ __forceinline__ float bflo(unsigned w) { return __uint_as_float(w << 16); }
__device__ __forceinline__ float bfhi(unsigned w) { return __uint_as_float(w & 0xffff0000u); }
__device__ __forceinline__ float fast_exp2(float x) { return __builtin_amdgcn_exp2f(x); }
__device__ __forceinline__ float fast_exp(float x) { return __builtin_amdgcn_exp2f(x * LOG2E); }
__device__ __forceinline__ float fast_rcp(float x) { return __builtin_amdgcn_rcpf(x); }
__device__ __forceinline__ float sigmoidf_(float x) { return fast_rcp(1.0f + fast_exp(-x)); }
__device__ __forceinline__ float siluf_(float x) { return x * sigmoidf_(x); }
__device__ __forceinline__ float wave_sum(float v) {
#pragma unroll
    for (int o = 1; o < 64; o <<= 1) v += __shfl_xor(v, o);
    return v;
}
__device__ __forceinline__ void rows_rstd(float (&rs)[2][4], const float* ssqp, int row0, int fq) {
    f32x4 q[2][4];
#pragma unroll
    for (int ai = 0; ai < 2; ++ai)
#pragma unroll
        for (int m = 0; m < 4; ++m) q[ai][m] = *(const f32x4*)(ssqp + (size_t)(row0 + ai * 128 + m * 16) * 16 + fq * 4);
#pragma unroll
    for (int ai = 0; ai < 2; ++ai)
#pragma unroll
        for (int m = 0; m < 4; ++m) { float s = (q[ai][m].x + q[ai][m].y) + (q[ai][m].z + q[ai][m].w); s += __shfl_xor(s, 16); s += __shfl_xor(s, 32); rs[ai][m] = __builtin_amdgcn_rsqf(s * (1.0f / D) + EPS); }
}
__device__ __forceinline__ float row_rstd(const float* ssqp, int row) {
    const f32x4* p = (const f32x4*)(ssqp + (size_t)row * 16);
    const f32x4 a = p[0], b = p[1], c = p[2], d = p[3];
    const float s = ((a.x + a.y) + (a.z + a.w)) + ((b.x + b.y) + (b.z + b.w)) + ((c.x + c.y) + (c.z + c.w)) + ((d.x + d.y) + (d.z + d.w));
    return __builtin_amdgcn_rsqf(s * (1.0f / D) + EPS);
}

namespace pg8 {
#define PG8_LAS __attribute__((address_space(3)))
typedef unsigned short bf16_t;
typedef unsigned u32x4 __attribute__((ext_vector_type(4)));
constexpr int BM = 256, BK = 64, HALF = 128, HTB = HALF * BK * 2, STAGE_BYTES = 8 * HTB, NXCD = 8, WGM = 8;
__host__ __device__ __forceinline__ int lds_byte(int r, int c) { const int st = (r >> 4) * 2 + (c >> 5), rr = r & 15, cc = c & 31, ob = rr * 64 + cc * 2; return st * 1024 + (ob ^ (((ob >> 9) & 1) << 5)); }
__host__ __device__ __forceinline__ void stage_rc(int b, int& R, int& C) { const int st = b / 1024, sb = b % 1024, swz = sb ^ (((sb >> 9) & 1) << 5); R = (st >> 1) * 16 + swz / 64; C = (st & 1) * 32 + (swz % 64) / 2; }
__host__ __device__ __forceinline__ int perm32(int rho) { const int n = rho >> 4, i = rho & 15; return 8 * (i >> 2) + 4 * n + (i & 3); }

__device__ __forceinline__ size_t xb_off(int pm, int rr, int cc) { return ((size_t)(pm * (1024 / BK) + (cc >> 6))) * (2 * HTB) + (size_t)((rr >> 7) * HTB + lds_byte(rr & 127, cc & 63)); }
__device__ __forceinline__ size_t xb_piece(int pm, int pn, int wr, int wc, int ai, int m, int bj) {
    return ((size_t)(pm * (1024 / BK) + pn * 4 + bj * 2 + (wc >> 1))) * (2 * HTB) + (size_t)(ai * HTB + (((wr * 4 + m) * 2 + (wc & 1)) << 10));
}
struct Unit { int pm, pn, sub; };
struct Gemm { const bf16_t* A0; const bf16_t* A1; const bf16_t* Bt; int lda, ldb, K, nsub; };

struct StaticOrder {
    int nM, nN, nwg, G, c, nsub;
    __device__ void init(int nM_, int nN_, int nsub_, int G_, int c_) { nM = nM_; nN = nN_; nwg = nM * nN; G = G_; c = c_; nsub = nsub_; }
    __device__ bool next(int i, Unit& u) const {
        const int ti = i / nsub; u.sub = i - ti * nsub;
        const long L = (long)ti * G + c; if (L >= nwg) return false;
        int wgid = (int)L; { const int q = nwg / NXCD, r = nwg % NXCD, xcd = wgid % NXCD, off = wgid / NXCD; wgid = (xcd < r ? xcd * (q + 1) : r * (q + 1) + (xcd - r) * q) + off; }
        const int nig = WGM * nN, gid = wgid / nig, fm = gid * WGM, gsz = (nM - fm) < WGM ? (nM - fm) : WGM;
        u.pm = fm + ((wgid % nig) % gsz); u.pn = (wgid % nig) / gsz; return true;
    }
};

typedef f32x4 Acc[2][2][4][2];

struct EpiSwiglu {
    static constexpr bool PERM = true, FUSED = false, RSTD_LDS = true;
    bf16_t* O; const float* ssqp;
    __device__ __forceinline__ bool keep(const Unit&) const { return false; }
    __device__ __forceinline__ void operator()(Acc& acc, const Unit& u, int wr, int wc, int fr, int fq, const float (&rsa)[2][4]) const {
        const int row0 = u.pm * BM + wr * 64 + fr, col0 = u.pn * HALF + wc * 32 + 8 * fq;
#pragma unroll
        for (int ai = 0; ai < 2; ++ai)
#pragma unroll
            for (int m = 0; m < 4; ++m) {
                const int row = row0 + ai * HALF + m * 16; const float rs = rsa[ai][m];
                float o[8];
#pragma unroll
                for (int n = 0; n < 2; ++n)
#pragma unroll
                    for (int j = 0; j < 4; ++j) { const float g = acc[ai][0][m][n][j] * rs, up = acc[ai][1][m][n][j] * rs; o[n * 4 + j] = siluf_(g) * up; }
                u32x4 w; w.x = pk2(o[0], o[1]); w.y = pk2(o[2], o[3]); w.z = pk2(o[4], o[5]); w.w = pk2(o[6], o[7]);
                const int rr = row & (BM - 1);
                *(u32x4*)((char*)O + ((size_t)(u.pm * (FF / BK) + (col0 >> 6))) * (2 * HTB) + (rr >> 7) * HTB + lds_byte(rr & 127, col0 & 63)) = w;
            }
    }
};
template <bool RES_BF16> struct EpiResid {
    static constexpr bool PERM = true, FUSED = false, RSTD_LDS = false;
    const float* res_f32; bf16_t* XBo; float* ssqp; float alpha;
    __device__ __forceinline__ bool keep(const Unit&) const { return false; }
    __device__ __forceinline__ void operator()(Acc& acc, const Unit& u, int wr, int wc, int fr, int fq) const {
        const int col0 = u.pn * BM + wc * 32 + 8 * fq;
        const unsigned xlo = (unsigned)lds_byte(fr, 8 * fq);
        u32x4 rb[2][4][2];
        if (RES_BF16) {
#pragma unroll
            for (int ai = 0; ai < 2; ++ai)
#pragma unroll
                for (int m = 0; m < 4; ++m)
#pragma unroll
                    for (int bj = 0; bj < 2; ++bj) rb[ai][m][bj] = *(const u32x4*)((const char*)XBo + xb_piece(u.pm, u.pn, wr, wc, ai, m, bj) + xlo);
        }
#pragma unroll
        for (int ai = 0; ai < 2; ++ai)
#pragma unroll
            for (int m = 0; m < 4; ++m) {
                const int row = u.pm * BM + ai * HALF + wr * 64 + m * 16 + fr;
                float ss = 0.f;
#pragma unroll
                for (int bj = 0; bj < 2; ++bj) {
                    const size_t off = (size_t)row * D + col0 + bj * HALF;
                    f32x4 r0, r1;
                    if (RES_BF16) { const u32x4 q = rb[ai][m][bj]; r0 = (f32x4){bflo(q.x), bfhi(q.x), bflo(q.y), bfhi(q.y)}; r1 = (f32x4){bflo(q.z), bfhi(q.z), bflo(q.w), bfhi(q.w)}; }
                    else { r0 = *(const f32x4*)(res_f32 + off); r1 = *(const f32x4*)(res_f32 + off + 4); }
                    const f32x4 v0 = r0 + acc[ai][bj][m][0] * alpha, v1 = r1 + acc[ai][bj][m][1] * alpha;
                    u32x4 w; w.x = pk2(v0[0], v0[1]); w.y = pk2(v0[2], v0[3]); w.z = pk2(v1[0], v1[1]); w.w = pk2(v1[2], v1[3]);
                    *(u32x4*)((char*)XBo + xb_piece(u.pm, u.pn, wr, wc, ai, m, bj) + xlo) = w;
                    ss += (v0[0] * v0[0] + v0[1] * v0[1]) + (v0[2] * v0[2] + v0[3] * v0[3]) + (v1[0] * v1[0] + v1[1] * v1[1]) + (v1[2] * v1[2] + v1[3] * v1[3]);
                }
                ss += __shfl_xor(ss, 16); ss += __shfl_xor(ss, 32);
                if (ssqp && fq == 0) ssqp[(size_t)row * 16 + u.pn * 4 + wc] = ss;
                if (!RES_BF16 && (m & 1)) asm volatile("" ::: "memory");
            }
    }
};
struct EpiProjA {
    static constexpr bool PERM = true, FUSED = false, RSTD_LDS = true;
    bf16_t *QK, *V, *SQ, *GR, *SKVb; float* GLR; float* out; const float* ssqp;
    __device__ __forceinline__ bool keep(const Unit&) const { return false; }
    __device__ __forceinline__ void operator()(Acc& acc, const Unit& u, int wr, int wc, int fr, int fq, const float (&rsa)[2][4]) const {
        const int pn = u.pn;
        bf16_t* dst; int ld = D, cbase; float scale = 1.f; int mode = 0;
        if (pn < 4) { dst = QK; cbase = pn * BM; if (pn < 2) scale = 0.08838834764831845f; }
        else if (pn < 8) { dst = V; cbase = (pn - 4) * BM; }
        else if (pn < 12) { dst = SQ; cbase = (pn - 8) * BM; scale = 0.125f * LOG2E; }
        else if (pn < 16) { dst = GR; cbase = (pn - 12) * BM; mode = 1; }
        else if (pn == 16) { dst = SKVb; ld = 256; cbase = 0; mode = 2; }
        else { dst = SKVb; cbase = 0; mode = 3; }
#pragma unroll
        for (int ai = 0; ai < 2; ++ai)
#pragma unroll
            for (int m = 0; m < 4; ++m) {
                const int row = u.pm * BM + ai * HALF + wr * 64 + m * 16 + fr; const float rs = rsa[ai][m] * scale;
#pragma unroll
                for (int bj = 0; bj < 2; ++bj) {
                    const int within = bj * HALF + wc * 32 + 8 * fq;
                    f32x4 v0 = acc[ai][bj][m][0] * rs, v1 = acc[ai][bj][m][1] * rs;
                    if (mode == 3) { if (within < GRANK) { *(f32x4*)(GLR + (size_t)row * 16 + within) = v0; *(f32x4*)(GLR + (size_t)row * 16 + within + 4) = v1; } continue; }
                    if (mode == 1) {
#pragma unroll
                        for (int j = 0; j < 4; ++j) { v0[j] = siluf_(v0[j]); v1[j] = siluf_(v1[j]); }
                    }
                    u32x4 w; w.x = pk2(v0[0], v0[1]); w.y = pk2(v0[2], v0[3]); w.z = pk2(v1[0], v1[1]); w.w = pk2(v1[2], v1[3]);
                    *(u32x4*)(dst + (size_t)row * ld + cbase + within) = w;
                    if (mode == 2) {
                        float* cp = nullptr;
                        if (u.pm >= MP / BM) { const int rs_ = row - MP, bs = rs_ >> 5, t = rs_ & 31; cp = out + (bj == 0 ? O_CKS : O_CVS) + ((size_t)(bs * WINDOW + 96 + t)) * 128 + (within & 127); }
                        else if ((u.pm & 15) == 15 && ai == 1) { const int b = row >> 12, t = row & 4095; cp = out + (bj == 0 ? O_CKP : O_CVP) + ((size_t)(b * WINDOW + (t - (SEQ - WINDOW)))) * 128 + (within & 127); }
                        if (cp) { *(f32x4*)cp = v0; *(f32x4*)(cp + 4) = v1; }
                    }
                }
            }
    }
};
struct EpiProjB {
    static constexpr bool PERM = true, FUSED = false, RSTD_LDS = true;
    bf16_t *R, *SS; const float* ssqp;
    __device__ __forceinline__ bool keep(const Unit&) const { return false; }
    __device__ __forceinline__ void operator()(Acc& acc, const Unit& u, int wr, int wc, int fr, int fq, const float (&rsa)[2][4]) const {
        const int row0 = u.pm * BM + wr * 64 + fr, col0 = u.pn * HALF + wc * 32 + 8 * fq;
#pragma unroll
        for (int ai = 0; ai < 2; ++ai)
#pragma unroll
            for (int m = 0; m < 4; ++m) {
                const int row = row0 + ai * HALF + m * 16; const float rs = rsa[ai][m];
                float r[8], ss[8];
#pragma unroll
                for (int n = 0; n < 2; ++n)
#pragma unroll
                    for (int j = 0; j < 4; ++j) { const float eg = fast_exp(-acc[ai][0][m][n][j] * rs), es = fast_exp(-acc[ai][1][m][n][j] * rs);
                        ss[n * 4 + j] = fast_rcp(1.0f + es); r[n * 4 + j] = (1.0f + es) * fast_rcp(1.0f + eg); }
                const size_t po = ((size_t)(u.pm * 8 + u.pn) << 16) + (size_t)((((wr * 4 + wc) * 8 + ai * 4 + m) << 10) + (fq * 16 + fr) * 16);
                u32x4 w; w.x = pk2(r[0], r[1]); w.y = pk2(r[2], r[3]); w.z = pk2(r[4], r[5]); w.w = pk2(r[6], r[7]);
                *(u32x4*)((char*)R + po) = w;
                w.x = pk2(ss[0], ss[1]); w.y = pk2(ss[2], ss[3]); w.z = pk2(ss[4], ss[5]); w.w = pk2(ss[6], ss[7]);
                *(u32x4*)((char*)SS + po) = w;
            }
    }
};
struct EpiBranch {
    static constexpr bool PERM = true, FUSED = false, RSTD_LDS = false;
    const bf16_t *R, *SS; bf16_t* O;
    __device__ __forceinline__ bool keep(const Unit& u) const { return u.sub == 0; }
    __device__ __forceinline__ void operator()(Acc& acc, const Unit& u, int wr, int wc, int fr, int fq) const {
        const int col0 = u.pn * BM + wc * 32 + 8 * fq;
        const bf16_t* G = u.sub == 0 ? R : SS;
        const unsigned xlo = (unsigned)lds_byte(fr, 8 * fq);
        const size_t tbase = (size_t)u.pm * BM * D * 2; const unsigned loff = (unsigned)((wr * 64 + fr) * D + col0) * 2u;
        const char* gbase = (const char*)G + tbase; char* obase = (char*)O + tbase;
        u32x4 gq[2][4][2];
#pragma unroll
        for (int ai = 0; ai < 2; ++ai)
#pragma unroll
            for (int m = 0; m < 4; ++m)
#pragma unroll
                for (int bj = 0; bj < 2; ++bj) gq[ai][m][bj] = *(const u32x4*)((const char*)G + ((size_t)(u.pm * 8 + 2 * u.pn + bj) << 16) + (size_t)((((wr * 4 + wc) * 8 + ai * 4 + m) << 10) + (fq * 16 + fr) * 16));
#pragma unroll
        for (int ai = 0; ai < 2; ++ai)
#pragma unroll
            for (int m = 0; m < 4; ++m) {
#pragma unroll
                for (int bj = 0; bj < 2; ++bj) {
                    const u32x4 s = gq[ai][m][bj];
                    const float gv[8] = {bflo(s.x), bfhi(s.x), bflo(s.y), bfhi(s.y), bflo(s.z), bfhi(s.z), bflo(s.w), bfhi(s.w)};
                    if (u.sub == 0) {
#pragma unroll
                        for (int j = 0; j < 4; ++j) { acc[ai][bj][m][0][j] *= gv[j]; acc[ai][bj][m][1][j] *= gv[4 + j]; }
                    } else {
                        float o[8];
#pragma unroll
                        for (int j = 0; j < 4; ++j) { o[j] = acc[ai][bj][m][0][j] * gv[j]; o[4 + j] = acc[ai][bj][m][1][j] * gv[4 + j]; }
                        u32x4 w; w.x = pk2(o[0], o[1]); w.y = pk2(o[2], o[3]); w.z = pk2(o[4], o[5]); w.w = pk2(o[6], o[7]);
                        *(u32x4*)((char*)O + xb_piece(u.pm, u.pn, wr, wc, ai, m, bj) + xlo) = w;
                    }
                }
            }
    }
};
constexpr int EX_OFF = 131072;
struct EpiFinal {
    static constexpr bool PERM = true, FUSED = true, RSTD_LDS = false;
    const bf16_t* XBr; float* Y; const float* gfin; unsigned* xslot; unsigned* cnt; float alpha;
    __device__ __forceinline__ bool keep(const Unit&) const { return false; }
    __device__ __forceinline__ void fused(Acc& acc, const Unit& u, int wr, int wc, int fr, int fq, PG8_LAS unsigned char* lds, int wid, int lane) const {
        PG8_LAS float* P = (PG8_LAS float*)(lds + EX_OFF); PG8_LAS float* Sx = (PG8_LAS float*)(lds + EX_OFF + 4096);
        const int col0 = u.pn * BM + wc * 32 + 8 * fq;
        const unsigned xlo = (unsigned)lds_byte(fr, 8 * fq);
        u32x4 rq[2][4][2];
#pragma unroll
        for (int ai = 0; ai < 2; ++ai)
#pragma unroll
            for (int m = 0; m < 4; ++m)
#pragma unroll
                for (int bj = 0; bj < 2; ++bj) rq[ai][m][bj] = *(const u32x4*)((const char*)XBr + xb_piece(u.pm, u.pn, wr, wc, ai, m, bj) + xlo);
#pragma unroll
        for (int ai = 0; ai < 2; ++ai)
#pragma unroll
            for (int m = 0; m < 4; ++m) {
                const int lr = ai * HALF + wr * 64 + m * 16 + fr;
                float ss = 0.f;
#pragma unroll
                for (int bj = 0; bj < 2; ++bj) {
                    const u32x4 rb = rq[ai][m][bj];
                    const f32x4 r0 = {bflo(rb.x), bfhi(rb.x), bflo(rb.y), bfhi(rb.y)}, r1 = {bflo(rb.z), bfhi(rb.z), bflo(rb.w), bfhi(rb.w)};
                    const f32x4 v0 = r0 + acc[ai][bj][m][0] * alpha, v1 = r1 + acc[ai][bj][m][1] * alpha;
                    acc[ai][bj][m][0] = v0; acc[ai][bj][m][1] = v1;
                    ss += (v0[0] * v0[0] + v0[1] * v0[1]) + (v0[2] * v0[2] + v0[3] * v0[3]) + (v1[0] * v1[0] + v1[1] * v1[1]) + (v1[2] * v1[2] + v1[3] * v1[3]);
                }
                ss += __shfl_xor(ss, 16); ss += __shfl_xor(ss, 32);
                if (fq == 0) P[lr * 4 + wc] = ss;
            }
        asm volatile("s_waitcnt lgkmcnt(0)" ::: "memory"); __builtin_amdgcn_s_barrier(); asm volatile("" ::: "memory");
        const int row = wid * 32 + (lane & 31);
        if (lane < 32) {
            const float s4 = (P[row * 4 + 0] + P[row * 4 + 1]) + (P[row * 4 + 2] + P[row * 4 + 3]);
            __hip_atomic_store(xslot + ((size_t)(u.pm * BM + row) * 4 + u.pn), __float_as_uint(s4), __ATOMIC_RELAXED, __HIP_MEMORY_SCOPE_AGENT);
        }
        asm volatile("s_waitcnt vmcnt(0)" ::: "memory");
        if (lane == 0) __hip_atomic_fetch_add(cnt + CW_PAN_STRIDE * u.pm, 1u, __ATOMIC_RELAXED, __HIP_MEMORY_SCOPE_AGENT);
        if (wid == 0) {
            unsigned spins = 0;
            while ((unsigned)__builtin_amdgcn_readfirstlane((int)__hip_atomic_load(cnt + CW_PAN_STRIDE * u.pm, __ATOMIC_RELAXED, __HIP_MEMORY_SCOPE_AGENT)) < 32u) { __builtin_amdgcn_s_sleep(2); if (++spins > (1u << 24)) break; }
            __builtin_amdgcn_fence(__ATOMIC_ACQUIRE, "agent");
        }
        asm volatile("s_waitcnt vmcnt(0) lgkmcnt(0)" ::: "memory"); __builtin_amdgcn_s_barrier(); asm volatile("" ::: "memory");
        if (lane < 32) {
            const unsigned* sl = xslot + (size_t)(u.pm * BM + row) * 4; float t = 0.f;
#pragma unroll
            for (int q = 0; q < 4; ++q) t += __uint_as_float(__hip_atomic_load(sl + q, __ATOMIC_RELAXED, __HIP_MEMORY_SCOPE_AGENT));
            Sx[row] = __builtin_amdgcn_rsqf(t * (1.0f / D) + EPS);
        }
        asm volatile("s_waitcnt lgkmcnt(0)" ::: "memory"); __builtin_amdgcn_s_barrier(); asm volatile("" ::: "memory");
        f32x4 gv[2][2];
#pragma unroll
        for (int bj = 0; bj < 2; ++bj) { gv[bj][0] = *(const f32x4*)(gfin + col0 + bj * HALF); gv[bj][1] = *(const f32x4*)(gfin + col0 + bj * HALF + 4); }
#pragma unroll
        for (int ai = 0; ai < 2; ++ai)
#pragma unroll
            for (int m = 0; m < 4; ++m) {
                const int lr = ai * HALF + wr * 64 + m * 16 + fr; const size_t grow = (size_t)(u.pm * BM + lr) * D; const float rs = Sx[lr];
#pragma unroll
                for (int bj = 0; bj < 2; ++bj) {
                    *(f32x4*)(Y + grow + col0 + bj * HALF) = acc[ai][bj][m][0] * rs * gv[bj][0];
                    *(f32x4*)(Y + grow + col0 + bj * HALF + 4) = acc[ai][bj][m][1] * rs * gv[bj][1];
                }
            }
    }
};

template <class Epi, bool ALIGN_EPI, bool ABLK = false>
__device__ __forceinline__ void gemm_phase(PG8_LAS unsigned char* lds, const Gemm g, const StaticOrder& S, const Epi& E) {
    const int tid = threadIdx.x, wid = __builtin_amdgcn_readfirstlane(tid >> 6), lane = tid & 63, wr = wid >> 2, wc = wid & 3, fr = lane & 15, fq = lane >> 4;
    const int K = g.K, nt = K / BK;
    unsigned voffA[2], voffB[2];
#pragma unroll
    for (int i = 0; i < 2; ++i) { int R, C; stage_rc(tid * 16 + i * 8192, R, C); const int Rb = Epi::PERM ? ((R & ~31) + perm32(R & 31)) : R;
        voffA[i] = ABLK ? (unsigned)(tid * 16 + i * 8192) : (unsigned)(R * g.lda + C) * 2u; voffB[i] = (unsigned)(Rb * g.ldb + C) * 2u; }
    const size_t kstepB = (size_t)(BK * 2), kstepA = ABLK ? (size_t)(2 * HTB) : (size_t)(BK * 2);
    const size_t hstepA = ABLK ? (size_t)HTB : (size_t)HALF * g.lda * 2, hstepB = (size_t)HALF * g.ldb * 2;
    const size_t tstepA = ABLK ? (size_t)(g.K / BK) * (2 * HTB) : 2 * hstepA, tstepB = 2 * hstepB;
    const unsigned ldsw = (unsigned)wid * 1024u;
    const int aoff = lds_byte(wr * 64 + fr, fq * 8), boff = lds_byte(wc * 32 + fr, fq * 8);
#define PG8_SA(b, h) (((b) * 2 + (h)) * HTB)
#define PG8_SB(b, h) ((4 + (b) * 2 + (h)) * HTB)
#define PG8_STAGE(bufoff, gbase, voff) do { _Pragma("unroll") for (int _i = 0; _i < 2; ++_i) \
        __builtin_amdgcn_global_load_lds((const unsigned*)((const char*)(gbase) + (voff)[_i]), (PG8_LAS unsigned*)(lds + (bufoff) + ldsw + _i * 8192), 16, 0, 0); } while (0)
#define PG8_LDA(dst, b, h) do { _Pragma("unroll") for (int m = 0; m < 4; ++m) _Pragma("unroll") for (int k = 0; k < 2; ++k) dst[m][k] = *(const PG8_LAS bf16x8*)(lds + PG8_SA(b, h) + aoff + m * 2048 + k * 1024); } while (0)
#define PG8_LDB(dst, b, h) do { _Pragma("unroll") for (int n = 0; n < 2; ++n) _Pragma("unroll") for (int k = 0; k < 2; ++k) dst[n][k] = *(const PG8_LAS bf16x8*)(lds + PG8_SB(b, h) + boff + n * 2048 + k * 1024); } while (0)
#define PG8_MMA(ai, bj, At, Bt) do { __builtin_amdgcn_s_setprio(1); _Pragma("unroll") for (int m = 0; m < 4; ++m) _Pragma("unroll") for (int n = 0; n < 2; ++n) _Pragma("unroll") for (int k = 0; k < 2; ++k) \
        acc[ai][bj][m][n] = __builtin_amdgcn_mfma_f32_16x16x32_bf16(Bt[n][k], At[m][k], acc[ai][bj][m][n], 0, 0, 0); __builtin_amdgcn_s_setprio(0); } while (0)
#define PG8_WAIT_V(n) asm volatile("s_waitcnt vmcnt(" #n ")" ::: "memory")
#define PG8_WAIT_L(n) asm volatile("s_waitcnt lgkmcnt(" #n ")" ::: "memory")
#define PG8_BAR __builtin_amdgcn_s_barrier()
#define PG8_SCHED __builtin_amdgcn_sched_barrier(0)
#define PG8_ABASE(u) ((const char*)((u).sub ? g.A1 : g.A0) + (size_t)(u).pm * tstepA)
#define PG8_BBASE(u) ((const char*)g.Bt + (size_t)(u).pn * tstepB + (size_t)(u).sub * K * 2)
    Unit cur, nxt; int ui = 0;
    if (!S.next(0, cur)) return;
    Acc acc;
#pragma unroll
    for (int a = 0; a < 2; ++a)
#pragma unroll
        for (int b = 0; b < 2; ++b)
#pragma unroll
            for (int m = 0; m < 4; ++m)
#pragma unroll
                for (int n = 0; n < 2; ++n) acc[a][b][m][n] = (f32x4){0.f, 0.f, 0.f, 0.f};
    bf16x8 At[4][2], B0[2][2], B1[2][2];
    const char* cA = PG8_ABASE(cur); const char* cB = PG8_BBASE(cur);
    constexpr int RS_MAXT = 12;
    PG8_LAS float* RS = (PG8_LAS float*)(lds + EX_OFF);
    f32x4 rq[RS_MAXT][2];
    if constexpr (Epi::RSTD_LDS) {
#pragma unroll
        for (int i = 0; i < RS_MAXT; ++i) { Unit t; if (S.next(i, t)) { const float* p = E.ssqp + (size_t)(t.pm * BM + wid * 32 + (lane & 31)) * 16 + (lane >> 5) * 8; rq[i][0] = *(const f32x4*)p; rq[i][1] = *(const f32x4*)(p + 4); } }
    }
    PG8_STAGE(PG8_SB(0, 0), cB, voffB); PG8_STAGE(PG8_SB(0, 1), cB + hstepB, voffB); PG8_STAGE(PG8_SA(0, 0), cA, voffA); PG8_STAGE(PG8_SA(0, 1), cA + hstepA, voffA);
    if constexpr (Epi::RSTD_LDS) {
        const int prow = wid * 32 + (lane & 31), slot = (((prow >> 6) & 1) * 16 + (prow & 15)) * 8 + (prow >> 7) * 4 + ((prow >> 4) & 3);
#pragma unroll
        for (int i = 0; i < RS_MAXT; ++i) { Unit t; if (S.next(i, t)) {
            float sm = ((rq[i][0].x + rq[i][0].y) + (rq[i][0].z + rq[i][0].w)) + ((rq[i][1].x + rq[i][1].y) + (rq[i][1].z + rq[i][1].w));
            sm += __shfl_xor(sm, 32);
            if (lane < 32) RS[i * 256 + slot] = __builtin_amdgcn_rsqf(sm * (1.0f / D) + EPS); } }
    }
    if (wr == 1) PG8_BAR;
    PG8_WAIT_V(2); PG8_BAR;
    PG8_STAGE(PG8_SB(1, 0), cB + kstepB, voffB); PG8_STAGE(PG8_SA(1, 0), cA + kstepA, voffA); PG8_STAGE(PG8_SB(1, 1), cB + hstepB + kstepB, voffB);
    PG8_WAIT_V(6); PG8_BAR;
    for (;;) {
        const bool has_next = S.next(ui + 1, nxt);
        const char* nA = has_next ? PG8_ABASE(nxt) : cA; const char* nB = has_next ? PG8_BBASE(nxt) : cB;
        for (int t = 0; t < nt; t += 2) {
            const bool last = (t == nt - 2);
            const char* a1 = cA + (size_t)(t + 1) * kstepA;
            const char* a2 = last ? nA : cA + (size_t)(t + 2) * kstepA; const char* b2 = last ? nB : cB + (size_t)(t + 2) * kstepB;
            const char* a3 = a2 + kstepA; const char* b3 = b2 + kstepB;
            PG8_LDB(B0, 0, 0); PG8_LDB(B1, 0, 1); PG8_SCHED; PG8_LDA(At, 0, 0); PG8_STAGE(PG8_SA(1, 1), a1 + hstepA, voffA);
            PG8_WAIT_V(8); PG8_WAIT_L(0); PG8_BAR; PG8_MMA(0, 0, At, B0); PG8_MMA(0, 1, At, B1); PG8_BAR; PG8_SCHED;
            PG8_LDA(At, 0, 1); PG8_STAGE(PG8_SB(0, 0), b2, voffB); PG8_STAGE(PG8_SB(0, 1), b2 + hstepB, voffB); PG8_STAGE(PG8_SA(0, 0), a2, voffA);
            PG8_WAIT_V(8); PG8_WAIT_L(0); PG8_BAR; PG8_MMA(1, 0, At, B0); PG8_MMA(1, 1, At, B1); PG8_BAR; PG8_SCHED;
            PG8_LDB(B0, 1, 0); PG8_LDB(B1, 1, 1); PG8_SCHED; PG8_LDA(At, 1, 0); PG8_STAGE(PG8_SA(0, 1), a2 + hstepA, voffA);
            PG8_WAIT_V(8); PG8_WAIT_L(0); PG8_BAR; PG8_MMA(0, 0, At, B0); PG8_MMA(0, 1, At, B1); PG8_BAR; PG8_SCHED;
            PG8_LDA(At, 1, 1); PG8_STAGE(PG8_SB(1, 0), b3, voffB); PG8_STAGE(PG8_SB(1, 1), b3 + hstepB, voffB); PG8_STAGE(PG8_SA(1, 0), a3, voffA);
            PG8_WAIT_V(8); PG8_WAIT_L(0); PG8_BAR; PG8_MMA(1, 0, At, B0); PG8_MMA(1, 1, At, B1); PG8_BAR; PG8_SCHED;
        }
        if constexpr (ALIGN_EPI) { if (wr == 0) PG8_BAR; }
        if constexpr (Epi::FUSED) E.fused(acc, cur, wr, wc, fr, fq, lds, wid, lane);
        else if constexpr (Epi::RSTD_LDS) {
            float rsa[2][4];
            if (ui < RS_MAXT) { const f32x4 r0 = *(const PG8_LAS f32x4*)(RS + ui * 256 + (wr * 16 + fr) * 8), r1 = *(const PG8_LAS f32x4*)(RS + ui * 256 + (wr * 16 + fr) * 8 + 4);
#pragma unroll
                for (int m = 0; m < 4; ++m) { rsa[0][m] = r0[m]; rsa[1][m] = r1[m]; } }
            else rows_rstd(rsa, E.ssqp, cur.pm * BM + wr * 64 + fr, fq);
            E(acc, cur, wr, wc, fr, fq, rsa);
        } else E(acc, cur, wr, wc, fr, fq);
        if (!has_next) break;
        if (!E.keep(cur)) {
#pragma unroll
            for (int a = 0; a < 2; ++a)
#pragma unroll
                for (int b = 0; b < 2; ++b)
#pragma unroll
                    for (int m = 0; m < 4; ++m)
#pragma unroll
                        for (int n = 0; n < 2; ++n) acc[a][b][m][n] = (f32x4){0.f, 0.f, 0.f, 0.f};
        }
        cur = nxt; cA = nA; cB = nB; ++ui;
        if constexpr (ALIGN_EPI) { if (wr == 1) PG8_BAR; }
    }
    PG8_WAIT_V(0);
    if constexpr (!ALIGN_EPI) { if (wr == 0) PG8_BAR; }
    PG8_BAR;
#undef PG8_SA
#undef PG8_SB
#undef PG8_STAGE
#undef PG8_LDA
#undef PG8_LDB
#undef PG8_MMA
#undef PG8_WAIT_V
#undef PG8_WAIT_L
#undef PG8_BAR
#undef PG8_SCHED
#undef PG8_ABASE
#undef PG8_BBASE
}
}


#define XB_TMO      128
#define XB_XCNT(j)  (256  + 64 * (j))
#define XB_XSUB(j)  (1280 + 64 * (j))
#define XB_XGEN(j)  (2304 + 64 * (j))
#define XB_TOP      3328
#define XB_TOPGEN   3392
#define XCD_BAR_WORDS 3456
#define XB_SPIN_CAP (1u << 22)
__device__ __forceinline__ unsigned xb_ld(unsigned* p)              { return __hip_atomic_load(p, __ATOMIC_RELAXED, __HIP_MEMORY_SCOPE_AGENT); }
__device__ __forceinline__ unsigned xb_add(unsigned* p, unsigned v) { return __hip_atomic_fetch_add(p, v, __ATOMIC_RELAXED, __HIP_MEMORY_SCOPE_AGENT); }
__device__ __forceinline__ unsigned xb_xcc_id() { return (unsigned)__builtin_amdgcn_s_getreg((3 << 11) | 20) & 0xFu; }
#define XB_SPIN(cond, bar) do { unsigned _sp = 0; while (cond) { __builtin_amdgcn_s_sleep(1); \
    if ((++_sp & 255u) == 0u) { if (xb_ld(&(bar)[XB_TMO])) break; if (_sp > XB_SPIN_CAP) { atomicAdd(&(bar)[XB_TMO], 1u); break; } } } } while (0)
struct XcdBarrier { unsigned* bar; unsigned x; volatile LAS unsigned* st; };
__device__ __forceinline__ XcdBarrier xcd_barrier_post(unsigned* bar, volatile LAS unsigned* st) {
    XcdBarrier b; b.bar = bar; b.x = xb_xcc_id(); b.st = st;
    if (threadIdx.x == 0) (void)xb_add(&bar[XB_XCNT(b.x)], 1u);
    return b;
}
__device__ __forceinline__ void xcd_barrier_complete(unsigned* bar, unsigned x, unsigned& nloc, unsigned& nx) {
    const unsigned G = gridDim.x * gridDim.y * gridDim.z;
    unsigned sum, cnt, mine, sp = 0u;
    for (;;) {
        sum = 0u; cnt = 0u; mine = 0u;
#pragma unroll
        for (unsigned j = 0; j < 16; ++j) { const unsigned c = xb_ld(&bar[XB_XCNT(j)]); sum += c; cnt += (c > 0u) ? 1u : 0u; mine = (j == x) ? c : mine; }
        if (sum == G) break;
        __builtin_amdgcn_s_sleep(1);
        if ((++sp & 255u) == 0u) { if (xb_ld(&bar[XB_TMO])) break; if (sp > XB_SPIN_CAP) { atomicAdd(&bar[XB_TMO], 1u); break; } }
    }
    nloc = mine > 0u ? mine : 1u; nx = cnt > 0u ? cnt : 1u;
}
__device__ __forceinline__ void xcd_barrier(const XcdBarrier& b) {
    asm volatile("s_waitcnt vmcnt(0)" ::: "memory");
    __syncthreads();
    if (threadIdx.x == 0) {
        unsigned* bar = b.bar;
        __builtin_amdgcn_s_waitcnt(0);
        unsigned nloc = b.st[0], nx = b.st[1];
        if (nloc == 0u) { xcd_barrier_complete(bar, b.x, nloc, nx); b.st[0] = nloc; b.st[1] = nx; }
        const unsigned old = xb_add(&bar[XB_XSUB(b.x)], 1u);
        const unsigned gen = old / nloc;
        if (old + 1u == (gen + 1u) * nloc) {
            __builtin_amdgcn_fence(__ATOMIC_RELEASE, "agent");
            asm volatile("s_waitcnt vmcnt(0)" ::: "memory");
            const unsigned og = xb_add(&bar[XB_TOP], 1u);
            const unsigned target = (og / nx + 1u) * nx;
            if (og + 1u != target) XB_SPIN(xb_ld(&bar[XB_TOP]) < target, bar);
            xb_add(&bar[XB_XGEN(b.x)], 1u);
            __builtin_amdgcn_fence(__ATOMIC_ACQUIRE, "agent");
            asm volatile("s_waitcnt vmcnt(0)" ::: "memory");
        } else {
            XB_SPIN(xb_ld(&bar[XB_XGEN(b.x)]) == gen, bar);
            __builtin_amdgcn_fence(__ATOMIC_ACQUIRE, "agent");
            asm volatile("s_waitcnt vmcnt(0)" ::: "memory");
        }
    }
    __syncthreads();
}

struct Args { const float* in[21]; float* out; unsigned char* ws; int ph_lo, ph_hi; };
struct Frame {
    LAS unsigned char* lds;
    int tid, lane, wave, vcu, G;
    const float* const* in_unused;
    float* out; unsigned char* ws;
};

__device__ __forceinline__ void p0_item(const float* W, int N, int scol0, int nvalid, const float* gain, int gmask, bf16* WT, int ldk, int koff, int drow0, int k0, LAS float* scr, int lane) {
    const bool al16 = ((scol0 & 3) == 0) && ((N & 3) == 0) && nvalid == 32;
    if (al16) {
        f32x4 v[8];
#pragma unroll
        for (int i = 0; i < 8; ++i) { const int p_ = lane + 64 * i; v[i] = __builtin_nontemporal_load((const f32x4*)(W + (size_t)(k0 + (p_ >> 3)) * N + scol0 + (p_ & 7) * 4)); }
#pragma unroll
        for (int i = 0; i < 8; ++i) { const int p_ = lane + 64 * i, kk = p_ >> 3, c = (p_ & 7) * 4; const float g = gain ? gain[(k0 + kk) & gmask] : 1.0f;
            scr[kk * 33 + c] = v[i][0] * g; scr[kk * 33 + c + 1] = v[i][1] * g; scr[kk * 33 + c + 2] = v[i][2] * g; scr[kk * 33 + c + 3] = v[i][3] * g; }
    } else {
        float v[32];
#pragma unroll
        for (int i = 0; i < 32; ++i) { const int kk = 2 * i + (lane >> 5), c = lane & 31; v[i] = 0.f; if (c < nvalid) v[i] = W[(size_t)(k0 + kk) * N + scol0 + c]; }
#pragma unroll
        for (int i = 0; i < 32; ++i) { const int kk = 2 * i + (lane >> 5), c = lane & 31; scr[kk * 33 + c] = (gain && c < nvalid) ? v[i] * gain[(k0 + kk) & gmask] : v[i]; }
    }
    LDS_WAIT(); asm volatile("" ::: "memory");
    const int c8 = lane & 7;
#pragma unroll
    for (int j = 0; j < 4; ++j) { const int n = (lane >> 3) + 8 * j; const LAS float* s = scr + (8 * c8) * 33 + n;
        v4u o; o.x = pk2(s[0 * 33], s[1 * 33]); o.y = pk2(s[2 * 33], s[3 * 33]); o.z = pk2(s[4 * 33], s[5 * 33]); o.w = pk2(s[6 * 33], s[7 * 33]);
        *(v4u*)(WT + (size_t)(drow0 + n) * ldk + koff + k0 + 8 * c8) = o; }
    LDS_WAIT(); asm volatile("" ::: "memory");
}
__device__ __forceinline__ int map_ffn_in(int blk) { const int tile = blk >> 3, w = blk & 7; return w < 4 ? tile * 128 + w * 32 : FF + tile * 128 + (w - 4) * 32; }
__device__ __forceinline__ int map_proj_a(int blk, int& nvalid) {
    nvalid = 32;
    if (blk < 16) return S_GQ + 32 * blk;
    if (blk < 32) return S_GK + 32 * (blk - 16);
    if (blk < 64) return S_GV + 32 * (blk - 32);
    if (blk < 96) return S_SQ + 32 * (blk - 64);
    if (blk < 128) return S_GR + 32 * (blk - 96);
    if (blk < 132) return S_SK + 32 * (blk - 128);
    if (blk < 136) return S_SV + 32 * (blk - 132);
    if (blk == 136) { nvalid = GRANK; return S_GLR; }
    nvalid = 0; return 0;
}
__device__ __forceinline__ int map_proj_b(int blk) { const int tile = blk >> 3, w = blk & 7; return w < 4 ? S_GG + tile * 128 + w * 32 : S_GS + tile * 128 + (w - 4) * 32; }


constexpr int P0_I1 = (D / 64) * 176, P0_I1O = (FF / 64) * 32, P0_IA = (D / 64) * 144, P0_IB = (D / 64) * 64, P0_IBR = (D / 64) * 32, P0_IO = (D / 64) * 32;
constexpr int P0_NEARLY = P0_I1 + P0_I1O + P0_IA, P0_NLATE = P0_I1 + P0_I1O + P0_IB + 2 * P0_IBR + P0_IO;
__device__ __forceinline__ void p0_weight_item(const Args& a, int idx, LAS float* scr, int lane) {
    unsigned char* ws = a.ws;
    int r;
    if (idx < P0_NEARLY) {
        r = idx;
        if (r < P0_I1) { const int kb = r / 176, blk = r % 176; p0_item(a.in[6], 2 * FF, map_ffn_in(blk), 32, a.in[5], 1023, (bf16*)(ws + WS_W1T), D, 0, blk * 32, kb * 64, scr, lane); return; }
        r -= P0_I1;
        if (r < P0_I1O) { const int kb = r / 32, blk = r % 32; p0_item(a.in[7], D, blk * 32, 32, nullptr, 0, (bf16*)(ws + WS_W1OT), FF, 0, blk * 32, kb * 64, scr, lane); return; }
        r -= P0_I1O;
        { const int kb = r / 144, blk = r % 144; int nv; const int sc = map_proj_a(blk, nv); p0_item(a.in[9], IN_W, sc, nv, a.in[8], 1023, (bf16*)(ws + WS_WAT), D, 0, blk * 32, kb * 64, scr, lane); return; }
    }
    r = idx - P0_NEARLY;
    if (r < P0_I1) { const int kb = r / 176, blk = r % 176; p0_item(a.in[18], 2 * FF, map_ffn_in(blk), 32, a.in[17], 1023, (bf16*)(ws + WS_W2T), D, 0, blk * 32, kb * 64, scr, lane); return; }
    r -= P0_I1;
    if (r < P0_I1O) { const int kb = r / 32, blk = r % 32; p0_item(a.in[19], D, blk * 32, 32, nullptr, 0, (bf16*)(ws + WS_W2OT), FF, 0, blk * 32, kb * 64, scr, lane); return; }
    r -= P0_I1O;
    if (r < P0_IB) { const int kb = r / 64, blk = r % 64; p0_item(a.in[9], IN_W, map_proj_b(blk), 32, a.in[8], 1023, (bf16*)(ws + WS_WBT), D, 0, blk * 32, kb * 64, scr, lane); return; }
    r -= P0_IB;
    if (r < 2 * P0_IBR) { const int which = r / P0_IBR; r -= which * P0_IBR; const int kb = r / 32, blk = r % 32;
        p0_item(a.in[which ? 15 : 14], D, blk * 32, 32, which ? nullptr : a.in[12], 255, (bf16*)(ws + WS_WBRT), 2 * D, which * D, blk * 32, kb * 64, scr, lane); return; }
    r -= 2 * P0_IBR;
    { const int kb = r / 32, blk = r % 32; p0_item(a.in[16], D, blk * 32, 32, nullptr, 0, (bf16*)(ws + WS_WOUTT), D, 0, blk * 32, kb * 64, scr, lane); }
}
__device__ __forceinline__ void p0_prologue(const Args& a, Frame& F) {
    LAS float* scr = (LAS float*)(F.lds + F.wave * 16384);
    const int gw = F.vcu * NWAVES + F.wave, NGW = F.G * NWAVES;
    unsigned char* ws = a.ws;
    for (int it = gw; it < P0_NEARLY; it += NGW) p0_weight_item(a, it, scr, F.lane);
    bf16* XB = (bf16*)(ws + WS_XB); float* ssq0 = (float*)(ws + WS_SSQ0);
#define P0_XDONE(V, m) do { \
        float s_ = 0.f; \
        _Pragma("unroll") for (int j = 0; j < 4; ++j) s_ += (V[j].x * V[j].x + V[j].y * V[j].y) + (V[j].z * V[j].z + V[j].w * V[j].w); \
        s_ = wave_sum(s_); \
        _Pragma("unroll") for (int j = 0; j < 4; ++j) { const int k_ = 4 * (F.lane + 64 * j); \
            unsigned long long* o8 = (m) < MP ? (unsigned long long*)((char*)XB + ((size_t)(((m) >> 8) * (D / 64) + (k_ >> 6))) * 32768 + ((((m) & 255) >> 7) * 16384) + pg8::lds_byte((m) & 127, k_ & 63)) \
                                              : (unsigned long long*)(XB + (size_t)(m) * D + k_); \
            *o8 = (unsigned long long)pk2(V[j].x, V[j].y) | ((unsigned long long)pk2(V[j].z, V[j].w) << 32); } \
        if ((m) < MP) { if (F.lane < 16) ssq0[(size_t)(m) * 16 + F.lane] = F.lane == 0 ? s_ : 0.f; } \
        else ((float*)(ws + WS_SSQ0S))[(size_t)((m) - MP) * 64 + F.lane] = F.lane == 0 ? s_ : 0.f; } while (0)
    const int nfull = P0_NEARLY % NGW; int sidx = gw - nfull; if (sidx < 0) sidx += NGW;
    const int ms = MP + sidx; const bool hasS = ms < M;
    f32x4 vs[4];
    if (hasS) { const f32x4* xr = (const f32x4*)(a.in[1] + (size_t)sidx * D) + F.lane;
#pragma unroll
        for (int j = 0; j < 4; ++j) vs[j] = __builtin_nontemporal_load(xr + 64 * j); }
    for (int m0 = 4 * gw; m0 < MP; m0 += 4 * NGW) {
        f32x4 v[4][4];
#pragma unroll
        for (int r = 0; r < 4; ++r) { const int m = m0 + r;
            if (m < MP) { const f32x4* xr = (const f32x4*)(a.in[0] + (size_t)m * D) + F.lane;
#pragma unroll
                for (int j = 0; j < 4; ++j) v[r][j] = __builtin_nontemporal_load(xr + 64 * j); } }
#pragma unroll
        for (int r = 0; r < 4; ++r) { const int m = m0 + r; if (m < MP) P0_XDONE(v[r], m); }
    }
    if (hasS) P0_XDONE(vs, ms);
    for (int m = ms + NGW; m < M; m += NGW) {
        const f32x4* xr = (const f32x4*)(a.in[1] + (size_t)(m - MP) * D) + F.lane;
        f32x4 v1[4];
#pragma unroll
        for (int j = 0; j < 4; ++j) v1[j] = xr[64 * j];
        P0_XDONE(v1, m);
    }
#undef P0_XDONE
    const int gt = gw * 64 + F.lane, NGT = NGW * 64;
    for (int i = gt; i < 2 * NB * 96 * 32; i += NGT) {
        const int which = i / (NB * 96 * 32), r = i % (NB * 96 * 32), b = r / (96 * 32), rr = r % (96 * 32);
        const f32x4 v = *((const f32x4*)(a.in[which ? 4 : 3] + ((size_t)b * WINDOW + 32) * 128) + rr);
        *((f32x4*)(a.out + (which ? O_CVS : O_CKS) + (size_t)b * WINDOW * 128) + rr) = v;
    }
}

constexpr int SWA_KLD_B = 144;
constexpr int SWA_VLD_B = 392;
constexpr int SWA_K_OFF = 0, SWA_V_OFF = 192 * SWA_KLD_B;
__device__ __forceinline__ void swa_unit(const Args& a, Frame& F, int seq, int chunk, int kvh) {
    const int tid = F.tid, lane = F.lane, wave = F.wave, r32 = lane & 31, hi = lane >> 5;
    const bool samp = seq >= NB; const int b = samp ? seq - NB : seq;
    bf16* SQ = (bf16*)(a.ws + WS_T2); const bf16* SKVb = (const bf16*)(a.ws + WS_SKV);
    const int rowq0 = samp ? MP + b * DEC_T : b * SEQ + chunk * 64;
    const int ntb = samp ? 1 : 2, nkb = samp ? 5 : 6, kb0 = samp ? 0 : (chunk >= 2 ? 0 : (2 - chunk) * 2);
    const int nkeys = nkb * 32;
    LAS unsigned char* Kl = F.lds + SWA_K_OFF; LAS unsigned char* Vl = F.lds + SWA_V_OFF;
    __syncthreads();
    for (int it = tid; it < nkeys * 8; it += NWAVES * 64) {
        const int key = it >> 3, c8 = it & 7;
        if (key < kb0 * 32) continue;
        v4u kk, vv;
        if (samp && key < WINDOW) {
            const float* ck = a.in[3] + ((size_t)(b * WINDOW + key) * SKV + kvh) * SHD + c8 * 8; const float* cv = a.in[4] + ((size_t)(b * WINDOW + key) * SKV + kvh) * SHD + c8 * 8;
            const f32x4 k0 = *(const f32x4*)ck, k1 = *(const f32x4*)(ck + 4), v0 = *(const f32x4*)cv, v1 = *(const f32x4*)(cv + 4);
            kk.x = pk2(k0[0], k0[1]); kk.y = pk2(k0[2], k0[3]); kk.z = pk2(k1[0], k1[1]); kk.w = pk2(k1[2], k1[3]);
            vv.x = pk2(v0[0], v0[1]); vv.y = pk2(v0[2], v0[3]); vv.z = pk2(v1[0], v1[1]); vv.w = pk2(v1[2], v1[3]);
        } else {
            const int mrow = samp ? MP + b * DEC_T + (key - WINDOW) : b * SEQ + (chunk - 2) * 64 + key;
            kk = *(const v4u*)(SKVb + (size_t)mrow * 256 + kvh * 64 + c8 * 8); vv = *(const v4u*)(SKVb + (size_t)mrow * 256 + 128 + kvh * 64 + c8 * 8);
        }
        *(LAS v4u*)(Kl + key * SWA_KLD_B + c8 * 16) = kk;
        LAS unsigned short* vt = (LAS unsigned short*)(Vl + (c8 * 8) * SWA_VLD_B + key * 2);
        vt[0 * (SWA_VLD_B / 2)] = (unsigned short)(vv.x & 0xffff); vt[1 * (SWA_VLD_B / 2)] = (unsigned short)(vv.x >> 16);
        vt[2 * (SWA_VLD_B / 2)] = (unsigned short)(vv.y & 0xffff); vt[3 * (SWA_VLD_B / 2)] = (unsigned short)(vv.y >> 16);
        vt[4 * (SWA_VLD_B / 2)] = (unsigned short)(vv.z & 0xffff); vt[5 * (SWA_VLD_B / 2)] = (unsigned short)(vv.z >> 16);
        vt[6 * (SWA_VLD_B / 2)] = (unsigned short)(vv.w & 0xffff); vt[7 * (SWA_VLD_B / 2)] = (unsigned short)(vv.w >> 16);
    }
    __syncthreads();
    const int head = kvh * 8 + wave;
    const float sink2 = a.in[13][head] * LOG2E;
    for (int tb = 0; tb < ntb; ++tb) {
        bf16* qrow = SQ + (size_t)(rowq0 + tb * 32 + r32) * D + head * SHD;
        bf16x8 qf[4];
#pragma unroll
        for (int s = 0; s < 4; ++s) qf[s] = *(const bf16x8*)(qrow + s * 16 + hi * 8);
        f32x16 sacc[6];
#pragma unroll
        for (int kb = 0; kb < 6; ++kb) {
            if (kb >= kb0 && kb < nkb) {
                f32x16 c = {0.f, 0.f, 0.f, 0.f, 0.f, 0.f, 0.f, 0.f, 0.f, 0.f, 0.f, 0.f, 0.f, 0.f, 0.f, 0.f};
#pragma unroll
                for (int s = 0; s < 4; ++s) { const bf16x8 kf = *(const LAS bf16x8*)(Kl + (kb * 32 + r32) * SWA_KLD_B + s * 32 + hi * 16); c = __builtin_amdgcn_mfma_f32_32x32x16_bf16(kf, qf[s], c, 0, 0, 0); }
                sacc[kb] = c;
            }
        }
        float mx = sink2;
#pragma unroll
        for (int kb = 0; kb < 6; ++kb) if (kb >= kb0 && kb < nkb) {
#pragma unroll
            for (int r = 0; r < 16; ++r) mx = fmaxf(mx, sacc[kb][r]); }
        mx = fmaxf(mx, __shfl_xor(mx, 32));
        float l = 0.f;
#pragma unroll
        for (int kb = 0; kb < 6; ++kb) if (kb >= kb0 && kb < nkb) {
#pragma unroll
            for (int r = 0; r < 16; ++r) { const float p = fast_exp2(sacc[kb][r] - mx); sacc[kb][r] = p; l += p; } }
        l += __shfl_xor(l, 32); l += fast_exp2(sink2 - mx);
        f32x16 o[2];
#pragma unroll
        for (int db = 0; db < 2; ++db) o[db] = (f32x16){0.f, 0.f, 0.f, 0.f, 0.f, 0.f, 0.f, 0.f, 0.f, 0.f, 0.f, 0.f, 0.f, 0.f, 0.f, 0.f};
#pragma unroll
        for (int kb = 0; kb < 6; ++kb) if (kb >= kb0 && kb < nkb) {
#pragma unroll
            for (int s2 = 0; s2 < 2; ++s2) {
                v4u pw; pw.x = pk2(sacc[kb][8 * s2 + 0], sacc[kb][8 * s2 + 1]); pw.y = pk2(sacc[kb][8 * s2 + 2], sacc[kb][8 * s2 + 3]);
                pw.z = pk2(sacc[kb][8 * s2 + 4], sacc[kb][8 * s2 + 5]); pw.w = pk2(sacc[kb][8 * s2 + 6], sacc[kb][8 * s2 + 7]);
                const bf16x8 pb = __builtin_bit_cast(bf16x8, pw);
#pragma unroll
                for (int db = 0; db < 2; ++db) {
                    const LAS unsigned char* vp = Vl + (db * 32 + r32) * SWA_VLD_B + (kb * 32 + s2 * 16 + 4 * hi) * 2;
                    const v2u lo = *(const LAS v2u*)vp, hi8 = *(const LAS v2u*)(vp + 16);
                    v4u av; av.x = lo.x; av.y = lo.y; av.z = hi8.x; av.w = hi8.y;
                    o[db] = __builtin_amdgcn_mfma_f32_32x32x16_bf16(__builtin_bit_cast(bf16x8, av), pb, o[db], 0, 0, 0);
                }
            }
        }
        const float inv = fast_rcp(l);
#pragma unroll
        for (int db = 0; db < 2; ++db)
#pragma unroll
            for (int g4 = 0; g4 < 4; ++g4) {
                v2u w; w.x = pk2(o[db][4 * g4 + 0] * inv, o[db][4 * g4 + 1] * inv); w.y = pk2(o[db][4 * g4 + 2] * inv, o[db][4 * g4 + 3] * inv);
                *(v2u*)(qrow + db * 32 + 8 * g4 + 4 * hi) = w;
            }
    }
}

struct SwaRegs { v4u kk[3], vv[3]; };
__device__ __forceinline__ void swa_p_load(SwaRegs& R, const Args& a, int u, int tid) {
    const int b = u >> 7, chunk = (u >> 1) & 63, kvh = u & 1;
    const bf16* SKVb = (const bf16*)(a.ws + WS_SKV);
    const char* base = (const char*)(SKVb + ((size_t)b * SEQ + (size_t)(chunk - 2) * 64) * 256 + kvh * 64);
#pragma unroll
    for (int i = 0; i < 3; ++i) {
        const int it = tid + 512 * i, key = it >> 3, c8 = it & 7;
        R.kk[i] = (v4u){0u, 0u, 0u, 0u}; R.vv[i] = (v4u){0u, 0u, 0u, 0u};
        if (key + (chunk - 2) * 64 >= 0) { R.kk[i] = *(const v4u*)(base + (size_t)key * 512 + c8 * 16); R.vv[i] = *(const v4u*)(base + (size_t)key * 512 + 256 + c8 * 16); }
    }
}
__device__ __forceinline__ void swa_p_compute(SwaRegs& R, const Args& a, Frame& F, int u) {
    const int tid = F.tid, lane = F.lane, wave = F.wave, r32 = lane & 31, hi = lane >> 5;
    const int b = u >> 7, chunk = (u >> 1) & 63, kvh = u & 1;
    bf16* SQ = (bf16*)(a.ws + WS_T2);
    const int rowq0 = b * SEQ + chunk * 64, kb0 = chunk >= 2 ? 0 : (2 - chunk) * 2;
    LAS unsigned char* Kl = F.lds + SWA_K_OFF; LAS unsigned char* Vl = F.lds + SWA_V_OFF;
    const int head = kvh * 8 + wave;
    bf16* qrow0 = SQ + (size_t)(rowq0 + r32) * D + head * SHD;
    bf16x8 qf[2][4];
#pragma unroll
    for (int s = 0; s < 4; ++s) qf[0][s] = *(const bf16x8*)(qrow0 + s * 16 + hi * 8);
    const float sink2 = a.in[13][head] * LOG2E;
    LDS_BAR();
#pragma unroll
    for (int i = 0; i < 3; ++i) {
        const int it = tid + 512 * i, key = it >> 3, c8 = it & 7;
        *(LAS v4u*)(Kl + key * SWA_KLD_B + c8 * 16) = R.kk[i];
        LAS unsigned short* vt = (LAS unsigned short*)(Vl + (c8 * 8) * SWA_VLD_B + key * 2);
        const unsigned w_[4] = {R.vv[i].x, R.vv[i].y, R.vv[i].z, R.vv[i].w};
#pragma unroll
        for (int q = 0; q < 4; ++q) { vt[(2 * q) * (SWA_VLD_B / 2)] = (unsigned short)(w_[q] & 0xffffu); vt[(2 * q + 1) * (SWA_VLD_B / 2)] = (unsigned short)(w_[q] >> 16); }
    }
    LDS_BAR();
#pragma unroll
    for (int tb = 0; tb < 2; ++tb) {
        bf16* qrow = qrow0 + (size_t)tb * 32 * D;
        f32x16 sacc[6];
#pragma unroll
        for (int kb = 0; kb < 6; ++kb) {
            if (kb >= kb0) {
                f32x16 c = {0.f, 0.f, 0.f, 0.f, 0.f, 0.f, 0.f, 0.f, 0.f, 0.f, 0.f, 0.f, 0.f, 0.f, 0.f, 0.f};
                bf16x8 kf[4];
#pragma unroll
                for (int s = 0; s < 4; ++s) kf[s] = *(const LAS bf16x8*)(Kl + (kb * 32 + r32) * SWA_KLD_B + s * 32 + hi * 16);
#pragma unroll
                for (int s = 0; s < 4; ++s) c = __builtin_amdgcn_mfma_f32_32x32x16_bf16(kf[s], qf[tb][s], c, 0, 0, 0);
                sacc[kb] = c;
            }
        }
        if (tb == 0) {
#pragma unroll
            for (int s = 0; s < 4; ++s) qf[1][s] = *(const bf16x8*)(qrow0 + (size_t)32 * D + s * 16 + hi * 8);
        }
        float mx = sink2;
#pragma unroll
        for (int kb = 0; kb < 6; ++kb) if (kb >= kb0) {
#pragma unroll
            for (int r = 0; r < 16; ++r) mx = fmaxf(mx, sacc[kb][r]); }
        mx = fmaxf(mx, __shfl_xor(mx, 32));
        float l = 0.f;
#pragma unroll
        for (int kb = 0; kb < 6; ++kb) if (kb >= kb0) {
#pragma unroll
            for (int r = 0; r < 16; ++r) { const float p = fast_exp2(sacc[kb][r] - mx); sacc[kb][r] = p; l += p; } }
        l += __shfl_xor(l, 32); l += fast_exp2(sink2 - mx);
        f32x16 o[2];
#pragma unroll
        for (int db = 0; db < 2; ++db) o[db] = (f32x16){0.f, 0.f, 0.f, 0.f, 0.f, 0.f, 0.f, 0.f, 0.f, 0.f, 0.f, 0.f, 0.f, 0.f, 0.f, 0.f};
#pragma unroll
        for (int kb = 0; kb < 6; ++kb) if (kb >= kb0) {
            v2u vlo[2][2], vhi[2][2];
#pragma unroll
            for (int s2 = 0; s2 < 2; ++s2)
#pragma unroll
                for (int db = 0; db < 2; ++db) {
                    const LAS unsigned char* vp = Vl + (db * 32 + r32) * SWA_VLD_B + (kb * 32 + s2 * 16 + 4 * hi) * 2;
                    vlo[s2][db] = *(const LAS v2u*)vp; vhi[s2][db] = *(const LAS v2u*)(vp + 16);
                }
            bf16x8 pb[2];
#pragma unroll
            for (int s2 = 0; s2 < 2; ++s2) {
                v4u pw; pw.x = pk2(sacc[kb][8 * s2 + 0], sacc[kb][8 * s2 + 1]); pw.y = pk2(sacc[kb][8 * s2 + 2], sacc[kb][8 * s2 + 3]);
                pw.z = pk2(sacc[kb][8 * s2 + 4], sacc[kb][8 * s2 + 5]); pw.w = pk2(sacc[kb][8 * s2 + 6], sacc[kb][8 * s2 + 7]);
                pb[s2] = __builtin_bit_cast(bf16x8, pw);
            }
            asm volatile("s_waitcnt lgkmcnt(0)" ::: "memory"); __builtin_amdgcn_sched_barrier(0);
#pragma unroll
            for (int s2 = 0; s2 < 2; ++s2)
#pragma unroll
                for (int db = 0; db < 2; ++db) {
                    v4u av; av.x = vlo[s2][db].x; av.y = vlo[s2][db].y; av.z = vhi[s2][db].x; av.w = vhi[s2][db].y;
                    o[db] = __builtin_amdgcn_mfma_f32_32x32x16_bf16(__builtin_bit_cast(bf16x8, av), pb[s2], o[db], 0, 0, 0);
                }
            __builtin_amdgcn_sched_barrier(0);
        }
        const float inv = fast_rcp(l);
#pragma unroll
        for (int db = 0; db < 2; ++db)
#pragma unroll
            for (int g4 = 0; g4 < 4; ++g4) {
                v2u w; w.x = pk2(o[db][4 * g4 + 0] * inv, o[db][4 * g4 + 1] * inv); w.y = pk2(o[db][4 * g4 + 2] * inv, o[db][4 * g4 + 3] * inv);
                *(v2u*)(qrow + db * 32 + 8 * g4 + 4 * hi) = w;
            }
    }
}

constexpr int G1_GLR_OFF = 0, G1_TOT_OFF = 4096, G1_Q_OFF = 6144, G1_LD_B = 272, G1_K_OFF = G1_Q_OFF + 64 * G1_LD_B;
struct G1Regs { v4u qraw[2], kraw[2]; f32x4 gl; };
__device__ __forceinline__ void g1_load(G1Regs& R, const Args& a, int seq, int chunk, int h, int tid) {
    const bool samp = seq >= NB; const int b = samp ? seq - NB : seq;
    const int row0 = samp ? MP + b * DEC_T : b * SEQ + chunk * 64, L = samp ? DEC_T : 64;
    const bf16* QK = (const bf16*)(a.ws + WS_T0); const float* GLR = (const float*)(a.ws + WS_GLR);
#pragma unroll
    for (int j = 0; j < 2; ++j) { const int idx = tid + 512 * j, t = idx >> 4, c16 = idx & 15;
        R.qraw[j] = (v4u){0u, 0u, 0u, 0u}; R.kraw[j] = (v4u){0u, 0u, 0u, 0u};
        if (t < L) { const bf16* src = QK + (size_t)(row0 + t) * D + h * 128 + c16 * 8; R.qraw[j] = *(const v4u*)src; R.kraw[j] = *(const v4u*)(src + 512); } }
    R.gl = (f32x4){0.f, 0.f, 0.f, 0.f};
    if (tid < 256) { const int t = tid >> 2, c4 = tid & 3; if (t < L) R.gl = *(const f32x4*)(GLR + (size_t)(row0 + t) * 16 + c4 * 4); }
}
__device__ __forceinline__ void g1_compute(G1Regs& R, const float (&w)[16], float bias, const Args& a, Frame& F, int seq, int chunk, int h) {
    const int tid = F.tid, lane = F.lane, wave = F.wave, fr = lane & 15, fq = lane >> 4;
    const bool samp = seq >= NB; const int b = samp ? seq - NB : seq;
    const int row0 = samp ? MP + b * DEC_T : b * SEQ + chunk * 64, L = samp ? DEC_T : 64;
    const int uid = samp ? NB * 64 * GH + b * GH + h : (b * 64 + chunk) * GH + h;
    bf16* QK = (bf16*)(a.ws + WS_T0); bf16* KT = (bf16*)(a.ws + WS_T7); bf16* ABUF = (bf16*)(a.ws + WS_ABUF);
    float* gdec = (float*)(a.ws + WS_GDEC);
    LAS float* glr_l = (LAS float*)(F.lds + G1_GLR_OFF); LAS float* tot = (LAS float*)(F.lds + G1_TOT_OFF);
    LAS unsigned char* ql = F.lds + G1_Q_OFF; LAS unsigned char* kl = F.lds + G1_K_OFF;
    const int d = tid & 127, strip = tid >> 7, t0 = strip * 16;
    LDS_BAR();
#pragma unroll
    for (int j = 0; j < 2; ++j) { const int idx = tid + 512 * j, t = idx >> 4, c16 = idx & 15; *(LAS v4u*)(ql + t * G1_LD_B + c16 * 16) = R.qraw[j]; *(LAS v4u*)(kl + t * G1_LD_B + c16 * 16) = R.kraw[j]; }
    if (tid < 256) *(LAS f32x4*)(glr_l + (tid >> 2) * 16 + (tid & 3) * 4) = R.gl;
    LDS_BAR();
    float bc[16]; float run = 0.f;
#pragma unroll
    for (int i = 0; i < 16; ++i) {
        const int t = t0 + i; float lg = bias;
#pragma unroll
        for (int r4 = 0; r4 < 4; ++r4) { const f32x4 gv = *(const LAS f32x4*)(glr_l + t * 16 + r4 * 4); lg += gv[0] * w[r4 * 4] + gv[1] * w[r4 * 4 + 1] + gv[2] * w[r4 * 4 + 2] + gv[3] * w[r4 * 4 + 3]; }
        const float ls = fminf(lg, 0.f) - __logf(1.0f + __expf(-fabsf(lg)));
        run += (t < L) ? ls * (1.0f / 16.0f) : 0.f; bc[i] = run;
    }
    tot[strip * 128 + d] = run;
    LDS_BAR();
    float off = 0.f, bL = 0.f;
#pragma unroll
    for (int s = 0; s < 4; ++s) { const float tv = tot[s * 128 + d]; bL += tv; if (s < strip) off += tv; }
    unsigned short kp[16];
    const float ebL = __expf(bL);
#pragma unroll
    for (int i = 0; i < 16; ++i) {
        const int t = t0 + i; const float bt = bc[i] + off;
        LAS unsigned short* qe = (LAS unsigned short*)(ql + t * G1_LD_B + d * 2); LAS unsigned short* ke = (LAS unsigned short*)(kl + t * G1_LD_B + d * 2);
        const float q = bf2f(*qe), k = bf2f(*ke);
        const float eb = __expf(bt), ebi = fast_rcp(eb);
        kp[i] = f2bf(k * (ebL * ebi));
        *qe = f2bf(q * eb); *ke = f2bf(k * ebi);
    }
    { v4u o0, o1; o0.x = kp[0] | ((unsigned)kp[1] << 16); o0.y = kp[2] | ((unsigned)kp[3] << 16); o0.z = kp[4] | ((unsigned)kp[5] << 16); o0.w = kp[6] | ((unsigned)kp[7] << 16);
      o1.x = kp[8] | ((unsigned)kp[9] << 16); o1.y = kp[10] | ((unsigned)kp[11] << 16); o1.z = kp[12] | ((unsigned)kp[13] << 16); o1.w = kp[14] | ((unsigned)kp[15] << 16);
      v4u* kd = (v4u*)(KT + ((size_t)uid * 128 + d) * 64 + t0); kd[0] = o0; kd[1] = o1; }
    if (strip == 0) gdec[(size_t)uid * 128 + d] = ebL;
    LDS_BAR();
#pragma unroll
    for (int j = 0; j < 2; ++j) { const int idx = tid + 512 * j, t = idx >> 4, c16 = idx & 15;
        if (t < L) *(v4u*)(QK + (size_t)(row0 + t) * D + h * 128 + c16 * 8) = *(const LAS v4u*)(ql + t * G1_LD_B + c16 * 16); }
    const int sb = wave >> 1;
    bf16x8 kf[4];
#pragma unroll
    for (int kd = 0; kd < 4; ++kd) kf[kd] = *(const LAS bf16x8*)(kl + (sb * 16 + fr) * G1_LD_B + (kd * 32 + 8 * fq) * 2);
#pragma unroll
    for (int x = 0; x < 2; ++x) {
        const int tb = 2 * (wave & 1) + x;
        f32x4 c = {0.f, 0.f, 0.f, 0.f};
#pragma unroll
        for (int kd = 0; kd < 4; ++kd) { const bf16x8 qf = *(const LAS bf16x8*)(ql + (tb * 16 + fr) * G1_LD_B + (kd * 32 + 8 * fq) * 2); c = __builtin_amdgcn_mfma_f32_16x16x32_bf16(kf[kd], qf, c, 0, 0, 0); }
        const int t = tb * 16 + fr, s0 = sb * 16 + 4 * fq;
        float v[4];
#pragma unroll
        for (int j = 0; j < 4; ++j) v[j] = (t >= s0 + j) ? c[j] : 0.f;
        if (t < L) { v2u o; o.x = pk2(v[0], v[1]); o.y = pk2(v[2], v[3]); *(v2u*)(ABUF + (size_t)(row0 + t) * 256 + h * 64 + s0) = o; }
    }
}

constexpr int H2_A_OFF = 0, H2_A_LD = 160, H2_Q_OFF = 64 * H2_A_LD, H2_Q_LD = 288, H2_KT_OFF = H2_Q_OFF + 64 * H2_Q_LD, H2_KT_LD = 160, H2_VT_OFF = H2_KT_OFF + 128 * H2_KT_LD, H2_VT_LD = 160,
              H2_ST_OFF = H2_VT_OFF + 64 * H2_VT_LD, H2_ST_LD = 288, H2_END = H2_ST_OFF + 64 * H2_ST_LD;
constexpr int H2_BUF = 77824;
static_assert(H2_END <= H2_BUF && 2 * H2_BUF <= PHASE_LDS, "G2 LDS map");
struct H2Regs { v4u a; v4u q[2]; v4u kt[2]; v4u v; f32x4 g4; };
struct H2Off { unsigned a, q, k, v, g, o; };
template <bool SAMP> __device__ __forceinline__ void h2_load(H2Regs& R, const Args& a, const H2Off& O, int row0, int uid, int h, int es, int tid, int lane) {
    const char* bA = (const char*)(a.ws + WS_ABUF) + ((size_t)row0 * 256 + h * 64) * 2;
    const char* bQ = (const char*)(a.ws + WS_T0) + ((size_t)row0 * D + h * 128) * 2;
    const char* bK = (const char*)(a.ws + WS_T7) + (size_t)uid * 16384;
    const char* bV = (const char*)(a.ws + WS_T1) + ((size_t)row0 * D + h * 256 + es * 64) * 2;
    const char* bG = (const char*)(a.ws + WS_GDEC) + (size_t)uid * 512;
    const v4u z = {0u, 0u, 0u, 0u};
    R.a = z; if (!SAMP || (tid >> 3) < DEC_T) R.a = *(const v4u*)(bA + O.a);
#pragma unroll
    for (int j = 0; j < 2; ++j) { R.q[j] = z; if (!SAMP || j == 0) R.q[j] = *(const v4u*)(bQ + O.q + j * 65536); }
#pragma unroll
    for (int j = 0; j < 2; ++j) R.kt[j] = *(const v4u*)(bK + O.k + j * 8192);
    R.v = z; if (!SAMP || lane < DEC_T) R.v = *(const v4u*)(bV + O.v);
    R.g4 = *(const f32x4*)(bG + O.g);
}
__device__ __forceinline__ void h2_stage(const H2Regs& R, LAS unsigned char* lds, int tid, int lane, int wave) {
    { const int t = tid >> 3, ch = tid & 7; *(LAS v4u*)(lds + H2_A_OFF + t * H2_A_LD + ch * 16) = R.a; }
#pragma unroll
    for (int j = 0; j < 2; ++j) { const int p = tid + 512 * j; *(LAS v4u*)(lds + H2_Q_OFF + (p >> 4) * H2_Q_LD + (p & 15) * 16) = R.q[j]; *(LAS v4u*)(lds + H2_KT_OFF + (p >> 3) * H2_KT_LD + (p & 7) * 16) = R.kt[j]; }
    { LAS unsigned short* vt = (LAS unsigned short*)(lds + H2_VT_OFF + (wave * 8) * H2_VT_LD + lane * 2); const unsigned w_[4] = {R.v.x, R.v.y, R.v.z, R.v.w};
#pragma unroll
      for (int i = 0; i < 4; ++i) { vt[(2 * i) * (H2_VT_LD / 2)] = (unsigned short)(w_[i] & 0xffffu); vt[(2 * i + 1) * (H2_VT_LD / 2)] = (unsigned short)(w_[i] >> 16); } }
}
template <bool SAMP> __device__ __forceinline__ void g2_item(const Args& a, Frame& F, int bh, int es) {
    const int tid = F.tid, lane = F.lane, wave = F.wave, fr = lane & 15, fq = lane >> 4;
    constexpr int nch = SAMP ? 1 : 64; const int b = bh >> 2, h = bh & 3;
    const int tb = wave >> 1, eb0 = (wave & 1) * 2;
    bf16* OG = (bf16*)(a.ws + WS_T1);
    LAS unsigned char* lds0 = F.lds;
    H2Off OF; OF.a = (unsigned)((tid >> 3) * 512 + (tid & 7) * 16); OF.q = (unsigned)((tid >> 4) * 2048 + (tid & 15) * 16); OF.k = (unsigned)(tid * 16);
    OF.v = (unsigned)(lane * 2048 + wave * 16); OF.g = (unsigned)((16 * wave + 4 * fq) * 4); OF.o = (unsigned)(((tb * 16 + fr) * D + eb0 * 16 + 4 * fq) * 2);
    f32x4 S[4];
#pragma unroll
    for (int eb = 0; eb < 4; ++eb)
#pragma unroll
        for (int r = 0; r < 4; ++r) S[eb][r] = SAMP ? a.in[2][((size_t)bh * 128 + 16 * wave + 4 * fq + r) * 256 + es * 64 + eb * 16 + fr] : 0.f;
    H2Regs R0, R1, R2;
#define H2_LOADC(R, cc) do { const int c_ = (cc) < nch ? (cc) : nch - 1; \
        h2_load<SAMP>(R, a, OF, SAMP ? MP + b * DEC_T : b * SEQ + c_ * 64, SAMP ? NB * 64 * GH + bh : (b * 64 + c_) * GH + h, h, es, tid, lane); } while (0)
#define H2_STEP(R, NXT, cc, PAR) do { \
        const int row0 = SAMP ? MP + b * DEC_T : b * SEQ + (cc) * 64; \
        LAS unsigned char* lds = lds0 + (PAR) * H2_BUF; \
        asm volatile("" : "+v"(R.a), "+v"(R.q[0]), "+v"(R.q[1]), "+v"(R.kt[0]), "+v"(R.kt[1]), "+v"(R.v), "+v"(R.g4)); \
        h2_stage(R, lds, tid, lane, wave); \
        const f32x4 g4 = R.g4; \
        _Pragma("unroll") for (int eb = 0; eb < 4; ++eb) { v2u o; o.x = pk2(S[eb][0], S[eb][1]); o.y = pk2(S[eb][2], S[eb][3]); *(LAS v2u*)(lds + H2_ST_OFF + (eb * 16 + fr) * H2_ST_LD + (16 * wave + 4 * fq) * 2) = o; } \
        LDS_BAR(); \
        if (!SAMP) H2_LOADC(NXT, (cc) + 2); \
        { bf16x8 afr[2], qfr[4], vo[2][2], sf[2][4]; \
          _Pragma("unroll") for (int ks = 0; ks < 2; ++ks) afr[ks] = *(const LAS bf16x8*)(lds + H2_A_OFF + (tb * 16 + fr) * H2_A_LD + ks * 64 + fq * 16); \
          _Pragma("unroll") for (int kd = 0; kd < 4; ++kd) qfr[kd] = *(const LAS bf16x8*)(lds + H2_Q_OFF + (tb * 16 + fr) * H2_Q_LD + kd * 64 + fq * 16); \
          _Pragma("unroll") for (int j = 0; j < 2; ++j) { \
              _Pragma("unroll") for (int ks = 0; ks < 2; ++ks) vo[j][ks] = *(const LAS bf16x8*)(lds + H2_VT_OFF + ((eb0 + j) * 16 + fr) * H2_VT_LD + ks * 64 + fq * 16); \
              _Pragma("unroll") for (int kd = 0; kd < 4; ++kd) sf[j][kd] = *(const LAS bf16x8*)(lds + H2_ST_OFF + ((eb0 + j) * 16 + fr) * H2_ST_LD + kd * 64 + fq * 16); } \
          asm volatile("s_waitcnt lgkmcnt(0)" ::: "memory"); __builtin_amdgcn_sched_barrier(0); \
          f32x4 acc0 = {0.f, 0.f, 0.f, 0.f}, acc1 = {0.f, 0.f, 0.f, 0.f}; \
          _Pragma("unroll") for (int ks = 0; ks < 2; ++ks) { acc0 = __builtin_amdgcn_mfma_f32_16x16x32_bf16(vo[0][ks], afr[ks], acc0, 0, 0, 0); acc1 = __builtin_amdgcn_mfma_f32_16x16x32_bf16(vo[1][ks], afr[ks], acc1, 0, 0, 0); } \
          _Pragma("unroll") for (int kd = 0; kd < 4; ++kd) { acc0 = __builtin_amdgcn_mfma_f32_16x16x32_bf16(sf[0][kd], qfr[kd], acc0, 0, 0, 0); acc1 = __builtin_amdgcn_mfma_f32_16x16x32_bf16(sf[1][kd], qfr[kd], acc1, 0, 0, 0); } \
          __builtin_amdgcn_sched_barrier(0); \
          bf16x8 kfr[2], vb[4][2]; \
          _Pragma("unroll") for (int ks = 0; ks < 2; ++ks) kfr[ks] = *(const LAS bf16x8*)(lds + H2_KT_OFF + (16 * wave + fr) * H2_KT_LD + ks * 64 + fq * 16); \
          _Pragma("unroll") for (int eb = 0; eb < 4; ++eb) _Pragma("unroll") for (int ks = 0; ks < 2; ++ks) vb[eb][ks] = *(const LAS bf16x8*)(lds + H2_VT_OFF + (eb * 16 + fr) * H2_VT_LD + ks * 64 + fq * 16); \
          _Pragma("unroll") for (int eb = 0; eb < 4; ++eb) S[eb] = S[eb] * g4; \
          asm volatile("s_waitcnt lgkmcnt(0)" ::: "memory"); __builtin_amdgcn_sched_barrier(0); \
          _Pragma("unroll") for (int ks = 0; ks < 2; ++ks) _Pragma("unroll") for (int eb = 0; eb < 4; ++eb) S[eb] = __builtin_amdgcn_mfma_f32_16x16x32_bf16(kfr[ks], vb[eb][ks], S[eb], 0, 0, 0); \
          if (!SAMP || tb < 2) { v2u o; o.x = pk2(acc0[0], acc0[1]); o.y = pk2(acc0[2], acc0[3]); *(v2u*)((char*)OG + ((size_t)row0 * D + h * 256 + es * 64) * 2 + OF.o) = o; \
                                 o.x = pk2(acc1[0], acc1[1]); o.y = pk2(acc1[2], acc1[3]); *(v2u*)((char*)OG + ((size_t)row0 * D + h * 256 + es * 64) * 2 + OF.o + 32) = o; } } \
    } while (0)
    H2_LOADC(R0, 0); if (!SAMP) H2_LOADC(R1, 1);
    LDS_BAR();
    if (SAMP) { H2_STEP(R0, R2, 0, 0); }
    else {
        H2_STEP(R0, R2, 0, 0); H2_STEP(R1, R0, 1, 1);
        for (int c = 2; c < 62; c += 6) { H2_STEP(R2, R1, c, 0); H2_STEP(R0, R2, c + 1, 1); H2_STEP(R1, R0, c + 2, 0); H2_STEP(R2, R1, c + 3, 1); H2_STEP(R0, R2, c + 4, 0); H2_STEP(R1, R0, c + 5, 1); }
        H2_STEP(R2, R1, 62, 0); H2_STEP(R0, R2, 63, 1);
    }
#undef H2_STEP
#undef H2_LOADC
    float* so = a.out + (SAMP ? O_SGS : O_SGP);
#pragma unroll
    for (int eb = 0; eb < 4; ++eb)
#pragma unroll
        for (int r = 0; r < 4; ++r) so[((size_t)bh * 128 + 16 * wave + 4 * fq + r) * 256 + es * 64 + eb * 16 + fr] = S[eb][r];
}

template <int RM, int RN> struct SgT {
    static constexpr int TM = 64 * RM, TN = 32 * RN, NLD = (TM + TN) / 8, LPW = (NLD + 7) / 8, STAGE = (TM + TN) * 128, NST = (RM == 2 ? 6 : 12);
};
#define SG_ROW(i)   (8 * (F.wave + 8 * (i)) + (F.lane >> 3))
#define SG_KOFF(R)  (((F.lane & 7) ^ (((R) >> 1) & 7)) * 8)
template <int RM, int RN, class Hook>
__device__ __forceinline__ void sgemm(f32x4 (&c)[RM][RN], f32x4 (&cs)[RM][RN], LAS unsigned char* lds, int wave, int lane,
                                      const bf16* (&p0)[SgT<RM, RN>::LPW], const bf16* (&p1)[SgT<RM, RN>::LPW], int NC, int ks, Hook&& hook) {
    typedef SgT<RM, RN> T;
    constexpr int LPW = T::LPW, NST = T::NST, STAGE = T::STAGE, TM = T::TM;
    const int fr = lane & 15, fq = lane >> 4, wr4 = wave >> 1, wc2 = wave & 1;
    const bool full = (wave + 8 * (LPW - 1)) < T::NLD;
    unsigned aoff[RM][2], boff[RN][2];
#pragma unroll
    for (int r = 0; r < RM; ++r) { const int R = wr4 * 16 * RM + r * 16 + fr, g = (R >> 1) & 7;
#pragma unroll
        for (int j = 0; j < 2; ++j) aoff[r][j] = (unsigned)(R * 128 + (((4 * j + fq) ^ g) * 16)); }
#pragma unroll
    for (int n = 0; n < RN; ++n) { const int R = TM + wc2 * 16 * RN + n * 16 + fr, g = (R >> 1) & 7;
#pragma unroll
        for (int j = 0; j < 2; ++j) boff[n][j] = (unsigned)(R * 128 + (((4 * j + fq) ^ g) * 16)); }
    int kci = 0, si = 0, sr = 0;
#define SG_ISSUE() do { const int kk = kci < NC ? kci : NC - 1; LAS unsigned char* st = lds + si * STAGE; \
        _Pragma("unroll") for (int i = 0; i < LPW; ++i) if (i < LPW - 1 || full) { const bf16* src = kk < ks ? p0[i] + kk * 64 : p1[i] + (kk - ks) * 64; \
            __builtin_amdgcn_global_load_lds((const unsigned*)src, (LAS unsigned*)(st + (wave + 8 * i) * 1024), 16, 0, 0); } \
        ++kci; si = (si + 1 == NST) ? 0 : si + 1; } while (0)
#pragma unroll 1
    for (int i = 0; i < NST - 1; ++i) SG_ISSUE();
    hook();
#pragma unroll 1
    for (int kc = 0; kc < NC; ++kc) {
        if (full) asm volatile("s_waitcnt vmcnt(%0)" :: "n"((NST - 2) * LPW) : "memory"); else asm volatile("s_waitcnt vmcnt(%0)" :: "n"((NST - 2) * (LPW - 1)) : "memory");
        __builtin_amdgcn_s_barrier(); asm volatile("" ::: "memory");
        SG_ISSUE();
        if (kc == ks) {
#pragma unroll
            for (int r = 0; r < RM; ++r)
#pragma unroll
                for (int n = 0; n < RN; ++n) { cs[r][n] = c[r][n]; c[r][n] = (f32x4){0.f, 0.f, 0.f, 0.f}; }
        }
        const LAS unsigned char* st = lds + sr * STAGE; sr = (sr + 1 == NST) ? 0 : sr + 1;
        bf16x8 av[RM][2], bv[RN][2];
#pragma unroll
        for (int r = 0; r < RM; ++r) { av[r][0] = *(const LAS bf16x8*)(st + aoff[r][0]); av[r][1] = *(const LAS bf16x8*)(st + aoff[r][1]); }
#pragma unroll
        for (int n = 0; n < RN; ++n) { bv[n][0] = *(const LAS bf16x8*)(st + boff[n][0]); bv[n][1] = *(const LAS bf16x8*)(st + boff[n][1]); }
#pragma unroll
        for (int j = 0; j < 2; ++j)
#pragma unroll
            for (int r = 0; r < RM; ++r)
#pragma unroll
                for (int n = 0; n < RN; ++n) c[r][n] = __builtin_amdgcn_mfma_f32_16x16x32_bf16(bv[n][j], av[r][j], c[r][n], 0, 0, 0);
    }
    asm volatile("s_waitcnt vmcnt(0)" ::: "memory");
    __builtin_amdgcn_s_barrier(); asm volatile("" ::: "memory");
#undef SG_ISSUE
}
#define SG_UNITS(u, NU) const int sg_half = F.G >> 1, sg_nf = (NU) < sg_half ? (NU) : sg_half; \
    for (int u = (part == 0 ? ((F.vcu & 1) ? (F.vcu >> 1) : (NU)) : ((F.vcu & 1) ? (NU) : sg_nf + (F.vcu >> 1))); u < (part == 0 ? sg_nf : (NU)); u += sg_half)
__device__ __forceinline__ unsigned sg_touch(const bf16* p) { return *(const unsigned*)p; }
#define SG_SINK1(x) asm volatile("" :: "v"(x))
struct SgSsq { f32x4 a, b, c, d; };
__device__ __forceinline__ void sg_ssq_ld(SgSsq& q, const float* ssqs, int lr, int fq) { const f32x4* p = (const f32x4*)(ssqs + (size_t)lr * 64 + fq * 16); q.a = p[0]; q.b = p[1]; q.c = p[2]; q.d = p[3]; }
__device__ __forceinline__ float sg_ssq_rstd(const SgSsq& q) {
    float s = ((q.a.x + q.a.y) + (q.a.z + q.a.w)) + ((q.b.x + q.b.y) + (q.b.z + q.b.w)) + ((q.c.x + q.c.y) + (q.c.z + q.c.w)) + ((q.d.x + q.d.y) + (q.d.z + q.d.w));
    s += __shfl_xor(s, 16); s += __shfl_xor(s, 32);
    return __builtin_amdgcn_rsqf(s * (1.0f / D) + EPS);
}
__device__ __forceinline__ int sg_gate_row(int cg, int b) { const int blk = b >> 4, g0 = 16 * (2 * cg + (blk >> 1)); return 256 * (g0 >> 7) + (g0 & 127) + (blk & 1) * 128 + (b & 15); }
__device__ __forceinline__ void sg_swiglu(const Args& a, Frame& F, const bf16* Wt, const float* ssqs, int part) {
    const int fr = F.lane & 15, fq = F.lane >> 4, wr4 = F.wave >> 1, wc2 = F.wave & 1;
    const bf16* XB = (const bf16*)(a.ws + WS_XB); bf16* ACT = (bf16*)(a.ws + WS_ACT);
    SG_UNITS(u, 2 * (FF / 32)) {
        const int rh = u & 1, cg = u >> 1;
        const unsigned t0 = sg_touch(Wt + (size_t)sg_gate_row(cg, F.tid >> 4) * D + (F.tid & 15) * 64), t1 = sg_touch(Wt + (size_t)sg_gate_row(cg, 32 + (F.tid >> 4)) * D + (F.tid & 15) * 64);
        const bf16* p0[3]; const bf16* p1[3];
#pragma unroll
        for (int i = 0; i < 3; ++i) { const int R = SG_ROW(i), ko = SG_KOFF(R);
            p0[i] = R < 128 ? XB + (size_t)(MP + rh * 128 + R) * D + ko : Wt + (size_t)sg_gate_row(cg, R - 128) * D + ko; p1[i] = p0[i]; }
        SgSsq q[2]; float rsv[2] = {0.f, 0.f};
#pragma unroll
        for (int r = 0; r < 2; ++r) sg_ssq_ld(q[r], ssqs, rh * 128 + wr4 * 32 + r * 16 + fr, fq);
        f32x4 c[2][2], cs[2][2];
#pragma unroll
        for (int r = 0; r < 2; ++r) { c[r][0] = (f32x4){0.f, 0.f, 0.f, 0.f}; c[r][1] = (f32x4){0.f, 0.f, 0.f, 0.f}; }
        sgemm<2, 2>(c, cs, F.lds, F.wave, F.lane, p0, p1, D / 64, 1 << 30, [&] { rsv[0] = sg_ssq_rstd(q[0]); rsv[1] = sg_ssq_rstd(q[1]); });
        SG_SINK1(t0); SG_SINK1(t1);
#pragma unroll
        for (int r = 0; r < 2; ++r) {
            const int m = MP + rh * 128 + wr4 * 32 + r * 16 + fr; const float rs = rsv[r];
            float o[4];
#pragma unroll
            for (int j = 0; j < 4; ++j) o[j] = siluf_(c[r][0][j] * rs) * (c[r][1][j] * rs);
            v2u w; w.x = pk2(o[0], o[1]); w.y = pk2(o[2], o[3]);
            *(v2u*)(ACT + (size_t)m * FF + 16 * (2 * cg + wc2) + 4 * fq) = w;
        }
    }
}
__device__ __forceinline__ void sg_resid(const Args& a, Frame& F, const bf16* A, int lda, const bf16* Wt, int K, const float* res_f32, float alpha, float* ssqs_out, int part) {
    const int fr = F.lane & 15, fq = F.lane >> 4, wr4 = F.wave >> 1, wc2 = F.wave & 1;
    bf16* XB = (bf16*)(a.ws + WS_XB);
    const int NC = K >> 6;
    SG_UNITS(u, 4 * (D / 32)) {
        const int rq = u & 3, cg = u >> 2;
        unsigned t0 = 0u, t1 = 0u, t2 = 0u;
        if (F.tid < 32 * NC) t0 = sg_touch(Wt + (size_t)(32 * cg + (F.tid & 31)) * K + (F.tid >> 5) * 64);
        if (F.tid + 512 < 32 * NC) t1 = sg_touch(Wt + (size_t)(32 * cg + (F.tid & 31)) * K + ((F.tid + 512) >> 5) * 64);
        if (F.tid + 1024 < 32 * NC) t2 = sg_touch(Wt + (size_t)(32 * cg + (F.tid & 31)) * K + ((F.tid + 1024) >> 5) * 64);
        const bf16* p0[2]; const bf16* p1[2];
        { const int R = SG_ROW(0), ko = SG_KOFF(R); p0[0] = A + (size_t)(MP + rq * 64 + R) * lda + ko; p1[0] = p0[0]; }
        { const int R = SG_ROW(1), ko = SG_KOFF(R); p0[1] = Wt + (size_t)(32 * cg + ((R - 64) & 31)) * K + ko; p1[1] = p0[1]; }
        f32x4 c[1][1] = {{{0.f, 0.f, 0.f, 0.f}}}, cs[1][1];
        sgemm<1, 1>(c, cs, F.lds, F.wave, F.lane, p0, p1, NC, 1 << 30, [] {});
        SG_SINK1(t0); SG_SINK1(t1); SG_SINK1(t2);
        const int nb = 2 * cg + wc2, lr = rq * 64 + wr4 * 16 + fr, m = MP + lr, n0 = 16 * nb + 4 * fq;
        f32x4 rr;
        if (res_f32) rr = *(const f32x4*)(res_f32 + (size_t)lr * D + n0);
        else { const v2u rb = *(const v2u*)(XB + (size_t)m * D + n0); rr = (f32x4){bflo(rb.x), bfhi(rb.x), bflo(rb.y), bfhi(rb.y)}; }
        const f32x4 v = rr + c[0][0] * alpha;
        { v2u w; w.x = pk2(v[0], v[1]); w.y = pk2(v[2], v[3]); *(v2u*)(XB + (size_t)m * D + n0) = w; }
        if (ssqs_out) { float ss = (v[0] * v[0] + v[1] * v[1]) + (v[2] * v[2] + v[3] * v[3]); ss += __shfl_xor(ss, 16); ss += __shfl_xor(ss, 32); if (fq == 0) ssqs_out[(size_t)lr * 64 + nb] = ss; }
    }
}
__device__ __forceinline__ void sg_proj(const Args& a, Frame& F, int part) {
    const int fr = F.lane & 15, fq = F.lane >> 4, wr4 = F.wave >> 1, wc2 = F.wave & 1;
    unsigned char* ws = a.ws;
    const bf16* XB = (const bf16*)(ws + WS_XB); const bf16* Wt = (const bf16*)(ws + WS_WAT); const float* ssqs = (const float*)(ws + WS_SSQAS);
    constexpr int NBLK = (NA - 240) / 16, NCG = (NBLK + 3) / 4;
    static_assert(NCG * 64 <= NA, "the padded weight copy covers the last column group");
    SG_UNITS(u, 2 * NCG) {
        const int rh = u & 1, cg = u >> 1;
        const unsigned t0 = sg_touch(Wt + (size_t)(64 * cg + (F.tid >> 4)) * D + (F.tid & 15) * 64), t1 = sg_touch(Wt + (size_t)(64 * cg + 32 + (F.tid >> 4)) * D + (F.tid & 15) * 64);
        const bf16* p0[3]; const bf16* p1[3];
#pragma unroll
        for (int i = 0; i < 3; ++i) { const int R = SG_ROW(i), ko = SG_KOFF(R);
            p0[i] = R < 128 ? XB + (size_t)(MP + rh * 128 + R) * D + ko : Wt + (size_t)(64 * cg + (R - 128)) * D + ko; p1[i] = p0[i]; }
        SgSsq q[2]; float rsv[2] = {0.f, 0.f};
#pragma unroll
        for (int r = 0; r < 2; ++r) sg_ssq_ld(q[r], ssqs, rh * 128 + wr4 * 32 + r * 16 + fr, fq);
        f32x4 c[2][2], cs[2][2];
#pragma unroll
        for (int r = 0; r < 2; ++r) { c[r][0] = (f32x4){0.f, 0.f, 0.f, 0.f}; c[r][1] = (f32x4){0.f, 0.f, 0.f, 0.f}; }
        sgemm<2, 2>(c, cs, F.lds, F.wave, F.lane, p0, p1, D / 64, 1 << 30, [&] { rsv[0] = sg_ssq_rstd(q[0]); rsv[1] = sg_ssq_rstd(q[1]); });
        SG_SINK1(t0); SG_SINK1(t1);
#pragma unroll
        for (int r = 0; r < 2; ++r) {
            const int lr = rh * 128 + wr4 * 32 + r * 16 + fr, m = MP + lr;
            const float rs = rsv[r];
#pragma unroll
            for (int n = 0; n < 2; ++n) {
                const int nb = 4 * cg + 2 * wc2 + n, n0 = 16 * nb, nq = n0 + 4 * fq;
                if (nb >= NBLK) continue;
                f32x4 v = c[r][n] * rs;
                if (n0 >= 4352) {
                    *(f32x4*)((float*)(ws + WS_GLR) + (size_t)m * 16 + 4 * fq) = v;
                } else if (n0 >= 4096) {
                    v2u w; w.x = pk2(v[0], v[1]); w.y = pk2(v[2], v[3]);
                    *(v2u*)((bf16*)(ws + WS_SKV) + (size_t)m * 256 + (nq - 4096)) = w;
                    const int bs = lr >> 5, t = lr & 31;
                    *(f32x4*)(a.out + (nq < 4224 ? O_CKS : O_CVS) + ((size_t)(bs * WINDOW + 96 + t)) * 128 + ((nq - 4096) & 127)) = v;
                } else {
                    bf16* dst; int col;
                    if (n0 < 1024) { dst = (bf16*)(ws + WS_T0); col = nq; if (n0 < 512) v = v * 0.08838834764831845f; }
                    else if (n0 < 2048) { dst = (bf16*)(ws + WS_T1); col = nq - 1024; }
                    else if (n0 < 3072) { dst = (bf16*)(ws + WS_T2); col = nq - 2048; v = v * (0.125f * LOG2E); }
                    else { dst = (bf16*)(ws + WS_T8); col = nq - 3072;
#pragma unroll
                        for (int j = 0; j < 4; ++j) v[j] = siluf_(v[j]); }
                    v2u w; w.x = pk2(v[0], v[1]); w.y = pk2(v[2], v[3]);
                    *(v2u*)(dst + (size_t)m * D + col) = w;
                }
            }
        }
    }
}
__device__ __forceinline__ void sg_gates(const Args& a, Frame& F, int part) {
    const int fr = F.lane & 15, fq = F.lane >> 4, wr4 = F.wave >> 1, wc2 = F.wave & 1;
    unsigned char* ws = a.ws;
    const bf16* XB = (const bf16*)(ws + WS_XB); const bf16* Wt = (const bf16*)(ws + WS_WBT); const float* ssqs = (const float*)(ws + WS_SSQAS);
    bf16* R = (bf16*)(ws + WS_T0); bf16* SS = (bf16*)(ws + WS_T7);
    LAS f32x4* xch = (LAS f32x4*)F.lds;
    SG_UNITS(u, 4 * (D / 16)) {
        const int rq = u & 3, nb = u >> 2, n0 = 16 * nb, grow = 256 * (n0 >> 7) + (n0 & 127);
        const unsigned t0 = sg_touch(Wt + (size_t)(grow + ((F.tid >> 4) & 15) + (F.tid >> 8) * 128) * D + (F.tid & 15) * 64);
        const bf16* p0[2]; const bf16* p1[2];
        { const int Rr = SG_ROW(0), ko = SG_KOFF(Rr); p0[0] = XB + (size_t)(MP + rq * 64 + Rr) * D + ko; p1[0] = p0[0]; }
        { const int Rr = SG_ROW(1), ko = SG_KOFF(Rr), b = (Rr - 64) & 31; p0[1] = Wt + (size_t)(grow + (b >> 4) * 128 + (b & 15)) * D + ko; p1[1] = p0[1]; }
        SgSsq q; float rs = 0.f;
        if (wc2 == 0) sg_ssq_ld(q, ssqs, rq * 64 + wr4 * 16 + fr, fq);
        f32x4 c[1][1] = {{{0.f, 0.f, 0.f, 0.f}}}, cs[1][1];
        sgemm<1, 1>(c, cs, F.lds, F.wave, F.lane, p0, p1, D / 64, 1 << 30, [&] { if (wc2 == 0) rs = sg_ssq_rstd(q); });
        SG_SINK1(t0);
        if (wc2) xch[wr4 * 64 + F.lane] = c[0][0];
        __syncthreads();
        if (wc2 == 0) {
            const f32x4 cg = c[0][0], cs_ = xch[wr4 * 64 + F.lane];
            const int m = MP + rq * 64 + wr4 * 16 + fr;
            float rr[4], ss[4];
#pragma unroll
            for (int j = 0; j < 4; ++j) { const float eg = fast_exp(-cg[j] * rs), es = fast_exp(-cs_[j] * rs); ss[j] = fast_rcp(1.0f + es); rr[j] = (1.0f + es) * fast_rcp(1.0f + eg); }
            v2u w; w.x = pk2(rr[0], rr[1]); w.y = pk2(rr[2], rr[3]); *(v2u*)(R + (size_t)m * D + n0 + 4 * fq) = w;
            w.x = pk2(ss[0], ss[1]); w.y = pk2(ss[2], ss[3]); *(v2u*)(SS + (size_t)m * D + n0 + 4 * fq) = w;
        }
        __syncthreads();
    }
}
__device__ __forceinline__ void sg_branch(const Args& a, Frame& F, int part) {
    const int fr = F.lane & 15, fq = F.lane >> 4, wr4 = F.wave >> 1, wc2 = F.wave & 1;
    unsigned char* ws = a.ws;
    const bf16* Wt = (const bf16*)(ws + WS_WBRT);
    const bf16* GG = (const bf16*)(ws + WS_T0); const bf16* GS = (const bf16*)(ws + WS_T7); bf16* O = (bf16*)(ws + WS_T8);
    SG_UNITS(u, 4 * (D / 32)) {
        const int rq = u & 3, cg = u >> 2;
        const unsigned t0 = sg_touch(Wt + (size_t)(32 * cg + (F.tid & 31)) * (2 * D) + (F.tid >> 5) * 64), t1 = sg_touch(Wt + (size_t)(32 * cg + (F.tid & 31)) * (2 * D) + ((F.tid >> 5) + 16) * 64);
        const bf16* p0[2]; const bf16* p1[2];
        { const int R = SG_ROW(0), ko = SG_KOFF(R); p0[0] = (const bf16*)(ws + WS_T1) + (size_t)(MP + rq * 64 + R) * D + ko; p1[0] = (const bf16*)(ws + WS_T2) + (size_t)(MP + rq * 64 + R) * D + ko; }
        { const int R = SG_ROW(1), ko = SG_KOFF(R); p0[1] = Wt + (size_t)(32 * cg + ((R - 64) & 31)) * (2 * D) + ko; p1[1] = p0[1] + D; }
        f32x4 c[1][1] = {{{0.f, 0.f, 0.f, 0.f}}}, cs[1][1] = {{{0.f, 0.f, 0.f, 0.f}}};
        sgemm<1, 1>(c, cs, F.lds, F.wave, F.lane, p0, p1, 2 * D / 64, D / 64, [] {});
        SG_SINK1(t0); SG_SINK1(t1);
        const int m = MP + rq * 64 + wr4 * 16 + fr, n0 = 16 * (2 * cg + wc2) + 4 * fq;
        const f32x4 ca = cs[0][0], cb = c[0][0];
        const v2u g = *(const v2u*)(GG + (size_t)m * D + n0), sv = *(const v2u*)(GS + (size_t)m * D + n0);
        const float rr[4] = {bflo(g.x), bfhi(g.x), bflo(g.y), bfhi(g.y)}, ss[4] = {bflo(sv.x), bfhi(sv.x), bflo(sv.y), bfhi(sv.y)};
        v2u w; w.x = pk2((ca[0] * rr[0] + cb[0]) * ss[0], (ca[1] * rr[1] + cb[1]) * ss[1]); w.y = pk2((ca[2] * rr[2] + cb[2]) * ss[2], (ca[3] * rr[3] + cb[3]) * ss[3]);
        *(v2u*)(O + (size_t)m * D + n0) = w;
    }
}
#undef SG_ROW
#undef SG_KOFF

template <int K> __device__ __forceinline__ void run_phase(const Args& args, LAS unsigned char* ldsp) {
    Frame F;
    { int t = threadIdx.x; asm volatile("" : "+v"(t)); F.tid = t; }
    F.lds = ldsp; F.lane = F.tid & 63; F.wave = __builtin_amdgcn_readfirstlane(F.tid >> 6);
    F.G = gridDim.x; { const int bx = blockIdx.x; F.vcu = (F.G % 8 == 0) ? (bx % 8) * (F.G / 8) + bx / 8 : bx; }
    F.out = args.out; F.ws = args.ws;
    unsigned char* ws = args.ws;
    const int gw = F.vcu * NWAVES + F.wave, NGW = F.G * NWAVES;
    bf16* XB = (bf16*)(ws + WS_XB); bf16* ACT = (bf16*)(ws + WS_ACT);
    float* X = args.out + O_Y;
    (void)gw; (void)NGW; (void)XB; (void)ACT; (void)X;
    if constexpr (K == 0) { p0_prologue(args, F); }
    if constexpr (K == 1) {
        sg_swiglu(args, F, (const bf16*)(ws + WS_W1T), (const float*)(ws + WS_SSQ0S), 0);
        pg8::Gemm g{XB, XB, (const bf16*)(ws + WS_W1T), D, D, D, 1}; pg8::StaticOrder S; S.init(MP / 256, 2 * FF / 256, 1, F.G, (int)blockIdx.x);
        pg8::EpiSwiglu E{ACT, (const float*)(ws + WS_SSQ0)};
        pg8::gemm_phase<pg8::EpiSwiglu, true, true>(F.lds, g, S, E);
        sg_swiglu(args, F, (const bf16*)(ws + WS_W1T), (const float*)(ws + WS_SSQ0S), 1);
    }
    if constexpr (K == 2) {
        sg_resid(args, F, ACT, FF, (const bf16*)(ws + WS_W1OT), FF, nullptr, 0.5f, (float*)(ws + WS_SSQAS), 0);
        pg8::Gemm g{ACT, ACT, (const bf16*)(ws + WS_W1OT), FF, FF, FF, 1}; pg8::StaticOrder S; S.init(MP / 256, D / 256, 1, F.G, (int)blockIdx.x);
        pg8::EpiResid<true> E{nullptr, XB, (float*)(ws + WS_SSQA), 0.5f};
        pg8::gemm_phase<pg8::EpiResid<true>, true, true>(F.lds, g, S, E);
        sg_resid(args, F, ACT, FF, (const bf16*)(ws + WS_W1OT), FF, nullptr, 0.5f, (float*)(ws + WS_SSQAS), 1);
    }
    if constexpr (K == 3) {
        sg_proj(args, F, 0);
        pg8::Gemm g{XB, XB, (const bf16*)(ws + WS_WAT), D, D, D, 1}; pg8::StaticOrder S; S.init(MP / 256, NA / 256, 1, F.G, (int)blockIdx.x);
        pg8::EpiProjA E{(bf16*)(ws + WS_T0), (bf16*)(ws + WS_T1), (bf16*)(ws + WS_T2), (bf16*)(ws + WS_T8), (bf16*)(ws + WS_SKV), (float*)(ws + WS_GLR), args.out, (const float*)(ws + WS_SSQA)};
        pg8::gemm_phase<pg8::EpiProjA, true, true>(F.lds, g, S, E);
        sg_proj(args, F, 1);
    }
    if constexpr (K == 4) {
        constexpr int NUNIT_GP = NB * 64 * GH;
#define G1_SEQ(u) ((u) < NB * 64 * GH ? (u) >> 8 : NB + (((u) - NB * 64 * GH) >> 2))
#define G1_CHK(u) ((u) < NB * 64 * GH ? ((u) >> 2) & 63 : 0)
        const int hh = F.vcu & 3, dcol = F.tid & 127;
        float w[16];
#pragma unroll
        for (int r = 0; r < 16; ++r) w[r] = args.in[10][r * 512 + hh * 128 + dcol];
        const float bias = args.in[11][hh * 128 + dcol];
        G1Regs RA, RB;
        int u = F.vcu;
        if (u < NUNIT_GP) g1_load(RA, args, G1_SEQ(u), G1_CHK(u), hh, F.tid);
        while (u < NUNIT_GP) {
            const int u1 = u + F.G; if (u1 < NUNIT_GP) g1_load(RB, args, G1_SEQ(u1), G1_CHK(u1), hh, F.tid);
            g1_compute(RA, w, bias, args, F, G1_SEQ(u), G1_CHK(u), hh);
            if (u1 >= NUNIT_GP) break;
            const int u2 = u1 + F.G; if (u2 < NUNIT_GP) g1_load(RA, args, G1_SEQ(u2), G1_CHK(u2), hh, F.tid);
            g1_compute(RB, w, bias, args, F, G1_SEQ(u1), G1_CHK(u1), hh);
            u = u2;
        }
#undef G1_SEQ
#undef G1_CHK
    }
    if constexpr (K == 5) {
        const int nh = F.G >> 1;
        constexpr int NSWA_P = NB * 64 * SKV, NSWA_S = NB * SKV;
        unsigned* g1cnt = (unsigned*)(ws + WS_CTL) + CW_G1S;
        if ((F.vcu & 1) == 0) {
            for (int it = F.vcu >> 1; it < NB * GH * 4; it += nh) {
                g2_item<false>(args, F, it >> 2, it & 3);
                if (F.tid == 0) { unsigned spins = 0; while (__hip_atomic_load(g1cnt, __ATOMIC_RELAXED, __HIP_MEMORY_SCOPE_AGENT) < (unsigned)(NB * GH)) { __builtin_amdgcn_s_sleep(4); if (++spins > (1u << 22)) break; }
                                  __builtin_amdgcn_fence(__ATOMIC_ACQUIRE, "agent"); asm volatile("s_waitcnt vmcnt(0)" ::: "memory"); }
                __syncthreads();
                g2_item<true>(args, F, it >> 2, it & 3);
            }
        } else {
            for (int v = F.vcu >> 1; v < NB * GH; v += nh) {
                const int hh = v & 3, dcol = F.tid & 127;
                float w[16];
#pragma unroll
                for (int r = 0; r < 16; ++r) w[r] = args.in[10][r * 512 + hh * 128 + dcol];
                const float bias = args.in[11][hh * 128 + dcol];
                G1Regs RA;
                g1_load(RA, args, NB + (v >> 2), 0, hh, F.tid);
                g1_compute(RA, w, bias, args, F, NB + (v >> 2), 0, hh);
                asm volatile("s_waitcnt vmcnt(0)" ::: "memory");
                __syncthreads();
                if (F.tid == 0) { __builtin_amdgcn_fence(__ATOMIC_RELEASE, "agent"); asm volatile("s_waitcnt vmcnt(0)" ::: "memory"); __hip_atomic_fetch_add(g1cnt, 1u, __ATOMIC_RELAXED, __HIP_MEMORY_SCOPE_AGENT); }
            }
            __syncthreads();
            for (int us = F.vcu >> 1; us < NSWA_S; us += nh) swa_unit(args, F, NB + (us >> 1), 0, us & 1);
        }
    }
    if constexpr (K == 12) {
        constexpr int NSWA_P = NB * 64 * SKV;
        unsigned* qhead = (unsigned*)(ws + WS_CTL) + 12288;
        volatile LAS unsigned* qslot = (volatile LAS unsigned*)(F.lds + MISC_OFF) + 16;
        unsigned t0 = 0, t1 = 0;
        if (F.tid == 0) { t0 = __hip_atomic_fetch_add(qhead, 1u, __ATOMIC_RELAXED, __HIP_MEMORY_SCOPE_AGENT); t1 = __hip_atomic_fetch_add(qhead, 1u, __ATOMIC_RELAXED, __HIP_MEMORY_SCOPE_AGENT); qslot[0] = t0; qslot[1] = t1; }
        __syncthreads();
        int u = (int)qslot[0], u1 = (int)qslot[1];
        SwaRegs RA, RB;
        if (u < NSWA_P) swa_p_load(RA, args, u, F.tid);
        while (u < NSWA_P) {
            unsigned tn = 0;
            if (F.tid == 0) tn = __hip_atomic_fetch_add(qhead, 1u, __ATOMIC_RELAXED, __HIP_MEMORY_SCOPE_AGENT);
            if (u1 < NSWA_P) swa_p_load(RB, args, u1, F.tid);
            swa_p_compute(RA, args, F, u);
            if (F.tid == 0) qslot[2] = tn;
            LDS_BAR();
            const int u2 = (int)qslot[2];
            if (u1 >= NSWA_P) break;
            if (F.tid == 0) tn = __hip_atomic_fetch_add(qhead, 1u, __ATOMIC_RELAXED, __HIP_MEMORY_SCOPE_AGENT);
            if (u2 < NSWA_P) swa_p_load(RA, args, u2, F.tid);
            swa_p_compute(RB, args, F, u1);
            if (F.tid == 0) qslot[3] = tn;
            LDS_BAR();
            u = u2; u1 = (int)qslot[3];
        }
        if (F.vcu & 1) {
            LDS_BAR();
            LAS float* scr = (LAS float*)(F.lds + F.wave * 16384);
            for (int l = (F.vcu >> 1) * NWAVES + F.wave; l < P0_NLATE; l += (F.G >> 1) * NWAVES) p0_weight_item(args, P0_NEARLY + l, scr, F.lane);
        }
    }
    if constexpr (K == 6) {
        bf16* OG = (bf16*)(ws + WS_T1); const bf16* GR = (const bf16*)(ws + WS_T8);
#define G3_LOAD(O0, O1, G0, G1_, m) do { O0 = *(const v4u*)(OG + (size_t)(m) * D + 16 * F.lane); O1 = *(const v4u*)(OG + (size_t)(m) * D + 16 * F.lane + 8); \
            G0 = *(const v4u*)(GR + (size_t)(m) * D + 16 * F.lane); G1_ = *(const v4u*)(GR + (size_t)(m) * D + 16 * F.lane + 8); } while (0)
#define G3_DONE(o0, o1, g0, g1, m) do { \
            float ovf[16] = {bflo(o0.x), bfhi(o0.x), bflo(o0.y), bfhi(o0.y), bflo(o0.z), bfhi(o0.z), bflo(o0.w), bfhi(o0.w), bflo(o1.x), bfhi(o1.x), bflo(o1.y), bfhi(o1.y), bflo(o1.z), bfhi(o1.z), bflo(o1.w), bfhi(o1.w)}; \
            const float gvf[16] = {bflo(g0.x), bfhi(g0.x), bflo(g0.y), bfhi(g0.y), bflo(g0.z), bfhi(g0.z), bflo(g0.w), bfhi(g0.w), bflo(g1.x), bfhi(g1.x), bflo(g1.y), bfhi(g1.y), bflo(g1.z), bfhi(g1.z), bflo(g1.w), bfhi(g1.w)}; \
            float ss = 0.f; \
            _Pragma("unroll") for (int j = 0; j < 16; ++j) ss += ovf[j] * ovf[j]; \
            ss += __shfl_xor(ss, 1); ss += __shfl_xor(ss, 2); ss += __shfl_xor(ss, 4); ss += __shfl_xor(ss, 8); \
            const float rs = __builtin_amdgcn_rsqf(ss * (1.0f / GDV) + EPS); \
            _Pragma("unroll") for (int j = 0; j < 16; ++j) ovf[j] = ovf[j] * rs * gvf[j]; \
            v4u w0, w1; \
            w0.x = pk2(ovf[0], ovf[1]); w0.y = pk2(ovf[2], ovf[3]); w0.z = pk2(ovf[4], ovf[5]); w0.w = pk2(ovf[6], ovf[7]); \
            w1.x = pk2(ovf[8], ovf[9]); w1.y = pk2(ovf[10], ovf[11]); w1.z = pk2(ovf[12], ovf[13]); w1.w = pk2(ovf[14], ovf[15]); \
            *(v4u*)(OG + (size_t)(m) * D + 16 * F.lane) = w0; *(v4u*)(OG + (size_t)(m) * D + 16 * F.lane + 8) = w1; } while (0)
        const int ms = MP + gw; const bool hasS = ms < M;
        v4u so0, so1, sg0, sg1;
        if (hasS) G3_LOAD(so0, so1, sg0, sg1, ms);
        for (int m0 = 4 * gw; m0 < MP; m0 += 4 * NGW) {
            v4u ov[4][2], gv4[4][2];
#pragma unroll
            for (int r = 0; r < 4; ++r) G3_LOAD(ov[r][0], ov[r][1], gv4[r][0], gv4[r][1], m0 + r);
#pragma unroll
            for (int r = 0; r < 4; ++r) G3_DONE(ov[r][0], ov[r][1], gv4[r][0], gv4[r][1], m0 + r);
        }
        if (hasS) G3_DONE(so0, so1, sg0, sg1, ms);
        for (int m = ms + NGW; m < M; m += NGW) { v4u a0, a1, b0, b1; G3_LOAD(a0, a1, b0, b1, m); G3_DONE(a0, a1, b0, b1, m); }
#undef G3_LOAD
#undef G3_DONE
        __syncthreads();
        sg_gates(args, F, 0);
        pg8::Gemm g{XB, XB, (const bf16*)(ws + WS_WBT), D, D, D, 1}; pg8::StaticOrder S; S.init(MP / 256, NBP / 256, 1, F.G, (int)blockIdx.x);
        pg8::EpiProjB E{(bf16*)(ws + WS_T0), (bf16*)(ws + WS_T7), (const float*)(ws + WS_SSQA)};
        pg8::gemm_phase<pg8::EpiProjB, true, true>(F.lds, g, S, E);
        sg_gates(args, F, 1);
    }
    if constexpr (K == 7) {
        sg_branch(args, F, 0);
        pg8::Gemm g{(const bf16*)(ws + WS_T1), (const bf16*)(ws + WS_T2), (const bf16*)(ws + WS_WBRT), D, 2 * D, D, 2}; pg8::StaticOrder S; S.init(MP / 256, D / 256, 2, F.G, (int)blockIdx.x);
        pg8::EpiBranch E{(const bf16*)(ws + WS_T0), (const bf16*)(ws + WS_T7), (bf16*)(ws + WS_T8)};
        pg8::gemm_phase<pg8::EpiBranch, true>(F.lds, g, S, E);
        sg_branch(args, F, 1);
    }
    if constexpr (K == 8) {
        sg_resid(args, F, (const bf16*)(ws + WS_T8), D, (const bf16*)(ws + WS_WOUTT), D, nullptr, 1.0f, (float*)(ws + WS_SSQBS), 0);
        pg8::Gemm g{(const bf16*)(ws + WS_T8), (const bf16*)(ws + WS_T8), (const bf16*)(ws + WS_WOUTT), D, D, D, 1}; pg8::StaticOrder S; S.init(MP / 256, D / 256, 1, F.G, (int)blockIdx.x);
        pg8::EpiResid<true> E{nullptr, XB, (float*)(ws + WS_SSQB), 1.0f};
        pg8::gemm_phase<pg8::EpiResid<true>, true, true>(F.lds, g, S, E);
        sg_resid(args, F, (const bf16*)(ws + WS_T8), D, (const bf16*)(ws + WS_WOUTT), D, nullptr, 1.0f, (float*)(ws + WS_SSQBS), 1);
    }
    if constexpr (K == 9) {
        sg_swiglu(args, F, (const bf16*)(ws + WS_W2T), (const float*)(ws + WS_SSQBS), 0);
        pg8::Gemm g{XB, XB, (const bf16*)(ws + WS_W2T), D, D, D, 1}; pg8::StaticOrder S; S.init(MP / 256, 2 * FF / 256, 1, F.G, (int)blockIdx.x);
        pg8::EpiSwiglu E{ACT, (const float*)(ws + WS_SSQB)};
        pg8::gemm_phase<pg8::EpiSwiglu, true, true>(F.lds, g, S, E);
        sg_swiglu(args, F, (const bf16*)(ws + WS_W2T), (const float*)(ws + WS_SSQBS), 1);
    }
    if constexpr (K == 10) {
        sg_resid(args, F, ACT, FF, (const bf16*)(ws + WS_W2OT), FF, nullptr, 0.5f, nullptr, 0);
        pg8::Gemm g{ACT, ACT, (const bf16*)(ws + WS_W2OT), FF, FF, FF, 1}; pg8::StaticOrder S; S.init(MP / 256, D / 256, 1, F.G, (int)blockIdx.x);
        pg8::EpiFinal E{XB, X, args.in[20], (unsigned*)(ws + WS_XSLOT), (unsigned*)(ws + WS_CTL) + CW_PAN, 0.5f};
        pg8::gemm_phase<pg8::EpiFinal, true, true>(F.lds, g, S, E);
        sg_resid(args, F, ACT, FF, (const bf16*)(ws + WS_W2OT), FF, nullptr, 0.5f, nullptr, 1);
    }
    if constexpr (K == 11) {
        const f32x4* gf = (const f32x4*)args.in[20];
        f32x4 g4[4];
#pragma unroll
        for (int q = 0; q < 4; ++q) g4[q] = gf[4 * F.lane + q];
        for (int m0 = MP + gw; m0 < M; m0 += 4 * NGW) {
            v4u xv[4][2];
#pragma unroll
            for (int r = 0; r < 4; ++r) { const int m = m0 + r * NGW; if (m < M) { xv[r][0] = *(const v4u*)(XB + (size_t)m * D + 16 * F.lane); xv[r][1] = *(const v4u*)(XB + (size_t)m * D + 16 * F.lane + 8); } }
#pragma unroll
            for (int r = 0; r < 4; ++r) { const int m = m0 + r * NGW; if (m < M) {
                const v4u x0 = xv[r][0], x1 = xv[r][1];
                float v[16] = {bflo(x0.x), bfhi(x0.x), bflo(x0.y), bfhi(x0.y), bflo(x0.z), bfhi(x0.z), bflo(x0.w), bfhi(x0.w), bflo(x1.x), bfhi(x1.x), bflo(x1.y), bfhi(x1.y), bflo(x1.z), bfhi(x1.z), bflo(x1.w), bfhi(x1.w)};
                float s2 = 0.f;
#pragma unroll
                for (int j = 0; j < 16; ++j) s2 += v[j] * v[j];
                const float rs = __builtin_amdgcn_rsqf(wave_sum(s2) * (1.0f / D) + EPS);
                f32x4* yr = (f32x4*)(X + (size_t)m * D + 16 * F.lane);
#pragma unroll
                for (int q = 0; q < 4; ++q) yr[q] = (f32x4){v[4 * q] * rs * g4[q][0], v[4 * q + 1] * rs * g4[q][1], v[4 * q + 2] * rs * g4[q][2], v[4 * q + 3] * rs * g4[q][3]}; } }
        }
    }
}

#ifndef MK_SEQ
#define MK_SEQ P(0) S P(1) S P(2) S P(3) S P(4) S P(5) P(12) S P(6) S P(7) S P(8) S P(9) S P(10) S P(11)
#endif
__global__ void __launch_bounds__(NWAVES * 64, 2) mk_fwd(Args args) {
    extern __shared__ __attribute__((aligned(16))) unsigned char lds[];
    LAS unsigned char* ldsp = (LAS unsigned char*)lds;
    volatile LAS unsigned* MISC = (volatile LAS unsigned*)(ldsp + MISC_OFF);
    if (threadIdx.x < 32) MISC[threadIdx.x] = 0u;
    __syncthreads();
    XcdBarrier bar = xcd_barrier_post((unsigned*)(args.ws + WS_CTL) + 4096, MISC + 8);
#define P(k) if (args.ph_hi > (k)) run_phase<k>(args, ldsp);
#define S xcd_barrier(bar);
    MK_SEQ
#undef P
#undef S
}

extern "C" void kernel_launch(void* const* d_in, const int* in_sizes, int n_in, void* d_out, int out_size, void* d_ws, size_t ws_size, hipStream_t stream) {
    static int grid = 0;
    if (grid == 0) {
        if (n_in != 21 || in_sizes[0] != MP * D || (size_t)out_size != O_END || ws_size < WS_END) { fprintf(stderr, "kernel_launch: unexpected shapes (n_in %d in0 %d out %d ws %zu need %zu)\n", n_in, n_in > 0 ? in_sizes[0] : -1, out_size, ws_size, (size_t)WS_END); grid = -1; return; }
        int dev = 0, cus = 0, per_cu = 0;
        if (hipGetDevice(&dev) != hipSuccess || hipDeviceGetAttribute(&cus, hipDeviceAttributeMultiprocessorCount, dev) != hipSuccess) { grid = -1; return; }
        if (hipFuncSetAttribute((const void*)mk_fwd, hipFuncAttributeMaxDynamicSharedMemorySize, LDS_BYTES) != hipSuccess) { fprintf(stderr, "kernel_launch: hipFuncSetAttribute failed\n"); grid = -1; return; }
        if (hipOccupancyMaxActiveBlocksPerMultiprocessor(&per_cu, (const void*)mk_fwd, NWAVES * 64, LDS_BYTES) != hipSuccess || per_cu < 1) { fprintf(stderr, "kernel_launch: occupancy query says %d\n", per_cu); per_cu = 1; }
        (void)hipGetLastError();
        grid = cus;
    }
    if (grid < 0) return;
    Args a{};
    for (int i = 0; i < 21; ++i) a.in[i] = (const float*)d_in[i];
    a.out = (float*)d_out; a.ws = (unsigned char*)d_ws;
    if (hipMemsetAsync((char*)d_ws + WS_CTL, 0, 65536, stream) != hipSuccess) { fprintf(stderr, "kernel_launch: memset failed\n"); return; }
    a.ph_lo = 0; a.ph_hi = 13;
    void* kargs[] = {&a};
    hipError_t e = hipLaunchCooperativeKernel((const void*)mk_fwd, dim3(grid), dim3(NWAVES * 64), kargs, LDS_BYTES, stream);
    if (e != hipSuccess) fprintf(stderr, "kernel_launch: cooperative launch failed: %s\n", hipGetErrorString(e));
}
```
